# Optimizing an MI355X kernel written in HIP

```python
import jax
import jax.numpy as jnp
from jax import lax
import numpy as np

D_MODEL = 2048
BATCH = 4
SEQ = 2048
DEPTH = 4

GRID_W = 64
CTX_LEN = 256
N_MIXERS = 3
EXPAND = 2
D_INNER = EXPAND * D_MODEL
HEAD_DIM = 128
N_HEADS = D_INNER // HEAD_DIM
WIN_H = 8
WIN_W = 16
RPB_H = 2 * WIN_H - 1
RPB_W = 2 * WIN_W - 1
POOL_SIZES = (2, 4, 8, 16)
N_POOL_GROUPS = len(POOL_SIZES)
POOL_GROUP = D_INNER // N_POOL_GROUPS
HGRN_HEADS = D_INNER // HEAD_DIM
HGRN_KDIM = 128
FORGET_DIM = HGRN_HEADS * HGRN_KDIM
CHUNK = 32
N_NA = (DEPTH + 2) // 3
N_POOL = (DEPTH + 1) // 3
N_HGRN = DEPTH // 3
EPS = 1e-6
MOD_STD = 0.5

kernel_name = 'hybrid_na_pool_hgrn2_dit_trunk'


def rmsnorm(x, g):
    xf = x.astype(jnp.float32)
    y = xf * lax.rsqrt(jnp.mean(xf * xf, axis=-1, keepdims=True) + EPS)
    return (y * g.astype(jnp.float32)).astype(x.dtype)


def _heads(t):
    b, n, _ = t.shape
    return t.reshape(b, n, -1, HEAD_DIM).transpose(0, 2, 1, 3)


def na_mixer(h, hc, w_in, rpb, w_out, need_ctx):
    B, T, _ = h.shape
    rows = T // GRID_W
    wh = min(WIN_H, rows)
    q, k, v, z = jnp.split(h @ w_in, 4, axis=-1)
    qc, kc, vc, zc = jnp.split(hc @ w_in, 4, axis=-1)
    sc = HEAD_DIM ** -0.5
    grid = (B, N_HEADS, rows, GRID_W, HEAD_DIM)
    qg = (_heads(q) * sc).reshape(grid)
    kg = _heads(k).reshape(grid)
    vg = _heads(v).reshape(grid)
    kch, vch = _heads(kc), _heads(vc)
    col = jnp.arange(GRID_W)
    c0 = jnp.clip(col - WIN_W // 2, 0, GRID_W - WIN_W)
    dcol = col[None, :] - col[:, None]
    col_in = (col[None, :] >= c0[:, None]) & (col[None, :] < c0[:, None] + WIN_W)
    rpb_c = rpb[:, :, jnp.clip(dcol, -(WIN_W - 1), WIN_W - 1) + (WIN_W - 1)]
    n_lat = wh * GRID_W

    def row_block(args):
        r, q_r = args
        r0 = jnp.clip(r - wh // 2, 0, rows - wh)
        k_b = lax.dynamic_slice_in_dim(kg, r0, wh, axis=2)
        v_b = lax.dynamic_slice_in_dim(vg, r0, wh, axis=2)
        drow = r0 + jnp.arange(wh) - r + (WIN_H - 1)
        bias = jnp.take(rpb_c, drow, axis=1).transpose(0, 2, 1, 3)
        s_lat = jnp.einsum('bhqd,bhrkd->bhqrk', q_r, k_b).astype(jnp.float32) + bias.astype(jnp.float32)
        s_lat = jnp.where(col_in[:, None, :], s_lat, -jnp.inf).reshape(B, N_HEADS, GRID_W, n_lat)
        s_ctx = jnp.einsum('bhqd,bhmd->bhqm', q_r, kch).astype(jnp.float32)
        p = jax.nn.softmax(jnp.concatenate([s_lat, s_ctx], axis=-1), axis=-1).astype(v_b.dtype)
        p_lat = p[..., :n_lat].reshape(B, N_HEADS, GRID_W, wh, GRID_W)
        return (jnp.einsum('bhqrk,bhrkd->bhqd', p_lat, v_b)
                + jnp.einsum('bhqm,bhmd->bhqd', p[..., n_lat:], vch))

    o = lax.map(row_block, (jnp.arange(rows), qg.transpose(2, 0, 1, 3, 4)))
    o = o.transpose(1, 0, 3, 2, 4).reshape(B, T, D_INNER)
    y = (o * jax.nn.silu(z)) @ w_out
    yc = None
    if need_ctx:
        qch = _heads(qc) * sc
        pc = jax.nn.softmax(jnp.einsum('bhqd,bhkd->bhqk', qch, kch).astype(jnp.float32), axis=-1)
        oc = jnp.einsum('bhqk,bhkd->bhqd', pc.astype(vch.dtype), vch)
        oc = oc.transpose(0, 2, 1, 3).reshape(B, -1, D_INNER)
        yc = (oc * jax.nn.silu(zc)) @ w_out
    return y, yc


def centred_mean(u, w):
    T = u.shape[1]
    cs = jnp.cumsum(u.astype(jnp.float32), axis=1)
    cs = jnp.pad(cs, ((0, 0), (1, 0), (0, 0)))
    t = jnp.arange(T)
    lo = jnp.clip(t - w // 2, 0, T)
    hi = jnp.clip(t + w - w // 2, 0, T)
    cnt = (hi - lo).astype(jnp.float32)
    return ((cs[:, hi] - cs[:, lo]) / cnt[None, :, None]).astype(u.dtype)


def _pool_branch(t, w_in, w_grp, scale, w_out):
    u, z = jnp.split(t @ w_in, 2, axis=-1)
    ug = u.reshape(u.shape[0], u.shape[1], N_POOL_GROUPS, POOL_GROUP)
    pooled = jnp.stack([centred_mean(ug[:, :, g, :], POOL_SIZES[g]) for g in range(N_POOL_GROUPS)], axis=2) - ug
    y = jnp.einsum('btgc,gce->btge', pooled, w_grp).reshape(u.shape) * scale
    return (y * jax.nn.silu(z)) @ w_out


def pool_mixer(h, hc, w_in, w_grp, scale, w_out, need_ctx):
    y = _pool_branch(h, w_in, w_grp, scale, w_out)
    yc = _pool_branch(hc, w_in, w_grp, scale, w_out) if need_ctx else None
    return y, yc


def hgrn_scan(q, k, v, logf, s0):
    B, H, N, _ = q.shape
    dv = v.shape[-1]
    nc = N // CHUNK

    def chunks(t):
        return t.astype(jnp.float32).reshape(B, H, nc, CHUNK, t.shape[-1]).transpose(2, 0, 1, 3, 4)

    lower = jnp.tril(jnp.ones((CHUNK, CHUNK), dtype=bool))[:, :, None]

    def step(S, inp):
        qc, kc, vc, lf = inp
        b = jnp.cumsum(lf, axis=2)
        diff = b[:, :, :, None, :] - b[:, :, None, :, :]
        decay = jnp.exp(jnp.where(lower, diff, -jnp.inf))
        att = jnp.einsum('bhtsk,bhsk->bhts', qc[:, :, :, None, :] * decay, kc)
        o = jnp.einsum('bhts,bhsv->bhtv', att, vc) + jnp.einsum('bhtk,bhkv->bhtv', qc * jnp.exp(b), S)
        b_end = b[:, :, -1:, :]
        S = (jnp.exp(b_end[:, :, 0, :])[..., None] * S
             + jnp.einsum('bhsk,bhsv->bhkv', kc * jnp.exp(b_end - b), vc))
        return S, o

    S, o = lax.scan(step, s0, (chunks(q), chunks(k), chunks(v), chunks(logf)))
    return o.transpose(1, 2, 0, 3, 4).reshape(B, H, N, dv), S


def _hgrn_project(t, w_in, lb):
    Bn, N, _ = t.shape
    F = FORGET_DIM
    q, a_f, a_b, v, z = jnp.split(t @ w_in, [F, 2 * F, 3 * F, 3 * F + D_INNER], axis=-1)

    def hd(a, d):
        return a.reshape(Bn, N, HGRN_HEADS, d).transpose(0, 2, 1, 3)

    f_f = lb[0] + (1.0 - lb[0]) * jax.nn.sigmoid(a_f.astype(jnp.float32))
    f_b = lb[1] + (1.0 - lb[1]) * jax.nn.sigmoid(a_b.astype(jnp.float32))
    return (hd(jax.nn.silu(q), HGRN_KDIM), hd(1.0 - f_f, HGRN_KDIM), hd(jnp.log(f_f), HGRN_KDIM),
            hd(1.0 - f_b, HGRN_KDIM), hd(jnp.log(f_b), HGRN_KDIM), hd(v, HEAD_DIM), z)


def _hgrn_out(o, z, g, w_out):
    B, H, N, dv = o.shape
    o = o.transpose(0, 2, 1, 3)
    o = o * lax.rsqrt(jnp.mean(o * o, axis=-1, keepdims=True) + EPS)
    o = (o.reshape(B, N, H * dv) * g.astype(jnp.float32)).astype(z.dtype)
    return (o * jax.nn.silu(z)) @ w_out


def hgrn_mixer(h, hc, layer, w_in, lb_raw, g_norm, w_out, need_ctx):
    probs = jax.nn.softmax(lb_raw.astype(jnp.float32), axis=1)
    lb = (jnp.cumsum(probs, axis=1) - probs[:, :1])[:, layer]
    q, kf, lff, kb, lfb, v, z = _hgrn_project(h, w_in, lb)
    qc, kfc, lffc, kbc, lfbc, vc, zc = _hgrn_project(hc, w_in, lb)
    s0 = jnp.zeros((h.shape[0], HGRN_HEADS, HGRN_KDIM, HEAD_DIM), jnp.float32)

    def flip(t):
        return jnp.flip(t, axis=2)

    oc_f, s_f = hgrn_scan(qc, kfc, vc, lffc, s0)
    oc_b, s_b = hgrn_scan(flip(qc), flip(kbc), flip(vc), flip(lfbc), s0)
    o_f, _ = hgrn_scan(q, kf, v, lff, s_f)
    o_b, _ = hgrn_scan(flip(q), flip(kb), flip(v), flip(lfb), s_b)
    y = _hgrn_out(o_f + flip(o_b), z, g_norm, w_out)
    yc = _hgrn_out(oc_f + flip(oc_b), zc, g_norm, w_out) if need_ctx else None
    return y, yc


def setup_inputs(seed: int = 0) -> dict:
    key = jax.random.key(seed)
    ks = jax.random.split(key, 20)
    f32 = jnp.float32

    def nrm(k, shape, s):
        return jax.random.normal(k, shape, f32) * s

    return {
        'x': nrm(ks[0], (BATCH, SEQ, D_MODEL), 1.0),
        'c': nrm(ks[1], (BATCH, D_MODEL), 1.0),
        'ctx': nrm(ks[2], (BATCH, CTX_LEN, D_MODEL), 1.0),
        'c_ctx': nrm(ks[3], (D_MODEL,), 1.0),
        'w_mod': nrm(ks[4], (DEPTH, D_MODEL, 3 * D_MODEL), MOD_STD * D_MODEL ** -0.5),
        'b_mod': nrm(ks[5], (DEPTH, 3 * D_MODEL), 0.02),
        'g_pre': 1.0 + nrm(ks[6], (DEPTH, D_MODEL), 0.02),
        'g_post': 1.0 + nrm(ks[7], (DEPTH, D_MODEL), 0.02),
        'na_w_in': nrm(ks[8], (N_NA, D_MODEL, 4 * D_INNER), D_MODEL ** -0.5),
        'na_rpb': nrm(ks[9], (N_NA, N_HEADS, RPB_H, RPB_W), 0.1),
        'na_w_out': nrm(ks[10], (N_NA, D_INNER, D_MODEL), D_INNER ** -0.5),
        'pool_w_in': nrm(ks[11], (N_POOL, D_MODEL, 2 * D_INNER), D_MODEL ** -0.5),
        'pool_w_grp': nrm(ks[12], (N_POOL, N_POOL_GROUPS, POOL_GROUP, POOL_GROUP), POOL_GROUP ** -0.5),
        'pool_scale': 1.0 + nrm(ks[13], (N_POOL, D_INNER), 0.02),
        'pool_w_out': nrm(ks[14], (N_POOL, D_INNER, D_MODEL), D_INNER ** -0.5),
        'hgrn_w_in': nrm(ks[15], (N_HGRN, D_MODEL, 3 * FORGET_DIM + 2 * D_INNER), D_MODEL ** -0.5),
        'hgrn_lb': nrm(ks[16], (2, DEPTH, FORGET_DIM), 0.1),
        'hgrn_gnorm': 1.0 + nrm(ks[17], (N_HGRN, D_INNER), 0.02),
        'hgrn_w_out': nrm(ks[18], (N_HGRN, D_INNER, D_MODEL), D_INNER ** -0.5),
    }


def reference(x, c, ctx, c_ctx, w_mod, b_mod, g_pre, g_post, na_w_in, na_rpb, na_w_out,
              pool_w_in, pool_w_grp, pool_scale, pool_w_out, hgrn_w_in, hgrn_lb, hgrn_gnorm, hgrn_w_out):
    xc = ctx
    for i in range(DEPTH):
        kind, j = i % N_MIXERS, i // N_MIXERS
        need_ctx = i < DEPTH - 1
        mod = jax.nn.silu(c) @ w_mod[i] + b_mod[i]
        shift, scale, gate = jnp.split(mod[:, None, :], 3, axis=-1)
        modc = jax.nn.silu(c_ctx) @ w_mod[i] + b_mod[i]
        shift_c, scale_c, gate_c = jnp.split(modc, 3, axis=-1)
        h = rmsnorm(x, g_pre[i]) * (1.0 + scale) + shift
        hc = rmsnorm(xc, g_pre[i]) * (1.0 + scale_c) + shift_c
        if kind == 0:
            y, yc = na_mixer(h, hc, na_w_in[j], na_rpb[j], na_w_out[j], need_ctx)
        elif kind == 1:
            y, yc = pool_mixer(h, hc, pool_w_in[j], pool_w_grp[j], pool_scale[j], pool_w_out[j], need_ctx)
        else:
            y, yc = hgrn_mixer(h, hc, i, hgrn_w_in[j], hgrn_lb, hgrn_gnorm[j], hgrn_w_out[j], need_ctx)
        x = x + gate * rmsnorm(y, g_post[i])
        if need_ctx:
            xc = xc + gate_c * rmsnorm(yc, g_post[i])
    return x
```

```cpp
#ifndef DBG_NL
#define DBG_NL 4
#endif
#include <hip/hip_runtime.h>
#include <hip/hip_cooperative_groups.h>
#include <cstdio>
#include <cstdint>
namespace cg = cooperative_groups;

#define LAS __attribute__((address_space(3)))
typedef unsigned short bf16_t;
typedef short bf16x8 __attribute__((ext_vector_type(8)));
typedef float f32x4 __attribute__((ext_vector_type(4)));
typedef unsigned u32x4 __attribute__((ext_vector_type(4)));
typedef unsigned u32x2 __attribute__((ext_vector_type(2)));

constexpr int DM = 2048, NB = 4, SEQ = 2048, CTX = 256, DI = 4096;
constexpr int MLAT = NB * SEQ, MCTX = NB * CTX, MTOT = MLAT + MCTX;
constexpr float EPS = 1e-6f;
constexpr int NTHR = 512, NWAVES = 8;
constexpr int LDS_BYTES = 147456;

constexpr size_t MiB = 1u << 20;
constexpr size_t WS_MOD = 1 * MiB;
constexpr size_t WS_LB = WS_MOD + 512 * 1024;
constexpr size_t WS_XC = 2 * MiB;
constexpr size_t WS_H = 10 * MiB;
constexpr size_t WS_WIN = 46 * MiB;
constexpr size_t WS_WOUT = 126 * MiB;
constexpr size_t WS_WG = 142 * MiB;
constexpr size_t WS_S0 = 150 * MiB;
constexpr size_t SLOT = 72 * MiB;
constexpr size_t WS_END = WS_S0 + 9 * SLOT;

typedef __bf16 bf2_t __attribute__((ext_vector_type(2)));
__device__ __forceinline__ unsigned pk2(float lo, float hi) { bf2_t v; v.x = (__bf16)lo; v.y = (__bf16)hi; return __builtin_bit_cast(unsigned, v); }
__device__ __forceinline__ float bflo(unsigned w) { return __uint_as_float(w << 16); }
__device__ __forceinline__ float bfhi(unsigned w) { return __uint_as_float(w & 0xffff0000u); }
__device__ __forceinline__ float fast_exp(float x) { return __expf(x); }
__device__ __forceinline__ float silu_f(float x) { return x * __builtin_amdgcn_rcpf(1.0f + __expf(-x)); }
__device__ __forceinline__ float wave_sum(float v) {
#pragma unroll
    for (int o = 1; o < 64; o <<= 1) v += __shfl_xor(v, o);
    return v;
}
#define LDS_WAIT() asm volatile("s_waitcnt lgkmcnt(0)" ::: "memory")
#define LAUNDER_V(x) asm volatile("" : "+v"(x))
#define LAUNDER_S(x) asm volatile("" : "+s"(x))
__device__ __forceinline__ int my_tid() { int t = threadIdx.x; LAUNDER_V(t); return t; }

namespace pg8 {
constexpr int BM = 256, BK = 64, HALF = 128, HTB = HALF * BK * 2, STAGE_BYTES = 8 * HTB, NXCD = 8, WGM = 8;
__device__ __forceinline__ int lds_byte(int r, int c) { const int st = (r >> 4) * 2 + (c >> 5), rr = r & 15, cc = c & 31, ob = rr * 64 + cc * 2; return st * 1024 + (ob ^ (((ob >> 9) & 1) << 5)); }
__device__ __forceinline__ void stage_rc(int b, int& R, int& C) { const int st = b / 1024, sb = b % 1024, swz = sb ^ (((sb >> 9) & 1) << 5); R = (st >> 1) * 16 + swz / 64; C = (st & 1) * 32 + (swz % 64) / 2; }
__device__ __forceinline__ int perm32(int rho) { const int n = rho >> 4, i = rho & 15; return 8 * (i >> 2) + 4 * n + (i & 3); }

struct Job {
    const bf16_t* A; const bf16_t* Bt; int nM, nN; int agdiv; size_t agstride;
    int segw; int acts; void* o0; void* o1; void* o2; void* o3; int ldo;
    const float* aux_f; const bf16_t* aux_b;
    int nt, ksplit, kofs, ostride;
};
__device__ __forceinline__ void job_write(LAS unsigned char* p, const Job& J) {
    *(LAS unsigned long long*)(p + 0) = (unsigned long long)J.A; *(LAS unsigned long long*)(p + 8) = (unsigned long long)J.Bt;
    *(LAS int*)(p + 16) = J.nM; *(LAS int*)(p + 20) = J.nN; *(LAS int*)(p + 24) = J.agdiv; *(LAS int*)(p + 28) = J.ldo;
    *(LAS unsigned long long*)(p + 32) = (unsigned long long)J.agstride; *(LAS int*)(p + 40) = J.segw; *(LAS int*)(p + 44) = J.acts;
    *(LAS unsigned long long*)(p + 48) = (unsigned long long)J.o0; *(LAS unsigned long long*)(p + 56) = (unsigned long long)J.o1;
    *(LAS unsigned long long*)(p + 64) = (unsigned long long)J.o2; *(LAS unsigned long long*)(p + 72) = (unsigned long long)J.o3;
    *(LAS unsigned long long*)(p + 80) = (unsigned long long)J.aux_f; *(LAS unsigned long long*)(p + 88) = (unsigned long long)J.aux_b;
    *(LAS int*)(p + 108) = J.nt; *(LAS int*)(p + 112) = J.ksplit; *(LAS int*)(p + 116) = J.kofs; *(LAS int*)(p + 120) = J.ostride;
}
__device__ __forceinline__ int jl_i(const LAS unsigned char* p) { return __builtin_amdgcn_readfirstlane(*(const LAS int*)p); }
__device__ __forceinline__ unsigned long long jl_p(const LAS unsigned char* p) {
    const unsigned lo = (unsigned)__builtin_amdgcn_readfirstlane(*(const LAS int*)p), hi = (unsigned)__builtin_amdgcn_readfirstlane(*(const LAS int*)(p + 4));
    return ((unsigned long long)hi << 32) | lo;
}
struct Unit { int job, pm, pn, ks, nt; };

__device__ __forceinline__ void decode_tile(int l, int nM, int nN, int& pm, int& pn) {
    const int nwg = nM * nN; int wgid = l;
    { const int q = nwg / NXCD, r = nwg % NXCD, xcd = wgid % NXCD, off = wgid / NXCD; wgid = (xcd < r ? xcd * (q + 1) : r * (q + 1) + (xcd - r) * q) + off; }
    const int nig = WGM * nN, gid = wgid / nig, fm = gid * WGM, gsz = (nM - fm) < WGM ? (nM - fm) : WGM;
    pm = fm + ((wgid % nig) % gsz); pn = (wgid % nig) / gsz;
}

__device__ __forceinline__ void store_bf8(bf16_t* p, const f32x4& v0, const f32x4& v1) {
    u32x4 w; w.x = pk2(v0[0], v0[1]); w.y = pk2(v0[2], v0[3]); w.z = pk2(v1[0], v1[1]); w.w = pk2(v1[2], v1[3]);
    *(u32x4*)p = w;
}

__device__ __forceinline__ void epilogue(const f32x4 (&acc)[2][2][4][2], const LAS unsigned char* jt, const Unit& u, int wr, int wc, int fr_, int fq_) {
    int fr = fr_, fq = fq_; asm volatile("" : "+v"(fr), "+v"(fq));
    const LAS unsigned char* jp = jt + u.job * 128;
    const int segw = jl_i(jp + 40), acts = jl_i(jp + 44);
    const int colt = u.pn * BM; const int seg = colt / segw; const int act = (acts >> (4 * seg)) & 15;
    void* op = (void*)jl_p(jp + 48 + 8 * seg);
    const int col0 = colt - seg * segw + wc * 32 + 8 * fq;
    const int row0 = u.pm * BM + wr * 64 + fr;
    const int ldo = jl_i(jp + 28);
    const float* aux_f = (const float*)jl_p(jp + 80); const bf16_t* aux_b = (const bf16_t*)jl_p(jp + 88);
    if (act <= 2) {
        bf16_t* O = (bf16_t*)op + (size_t)u.ks * jl_i(jp + 120);
#pragma unroll
        for (int ai = 0; ai < 2; ++ai)
#pragma unroll
            for (int m = 0; m < 4; ++m) {
                bf16_t* rowp = O + (size_t)(row0 + ai * HALF + m * 16) * ldo + col0;
#pragma unroll
                for (int bj = 0; bj < 2; ++bj) {
                    f32x4 v0 = acc[ai][bj][m][0], v1 = acc[ai][bj][m][1];
                    if (act == 1) { v0 *= 0.08838834764831845f; v1 *= 0.08838834764831845f; }
                    if (act == 2) {
#pragma unroll
                        for (int j = 0; j < 4; ++j) { v0[j] = silu_f(v0[j]); v1[j] = silu_f(v1[j]); }
                    }
                    store_bf8(rowp + bj * HALF, v0, v1);
                }
            }
    } else if (act == 7) {
        bf16_t* O = (bf16_t*)op;
#pragma unroll
        for (int ai = 0; ai < 2; ++ai)
#pragma unroll
            for (int m = 0; m < 4; ++m) {
                const int token = row0 + ai * HALF + m * 16;
#pragma unroll
                for (int bj = 0; bj < 2; ++bj) {
                    const int col = col0 + bj * HALF, hd = col >> 7, d0 = col & 127;
                    store_bf8(O + ((size_t)(token >> 3) * 32 + hd) * 1024 + (d0 >> 4) * 128 + (token & 7) * 16 + ((d0 >> 3) & 1) * 8, acc[ai][bj][m][0], acc[ai][bj][m][1]);
                }
            }
    } else if (act == 8) {
        bf16_t* O = (bf16_t*)op;
#pragma unroll
        for (int ai = 0; ai < 2; ++ai)
#pragma unroll
            for (int m = 0; m < 4; ++m) {
                const int rr = row0 + ai * HALF + m * 16;
#pragma unroll
                for (int bj = 0; bj < 2; ++bj) {
                    const int t0 = col0 + bj * HALF;
                    store_bf8(O + ((size_t)(t0 >> 3) * 32 + (rr >> 7)) * 1024 + (rr & 127) * 8, acc[ai][bj][m][0], acc[ai][bj][m][1]);
                }
            }
    } else if (act == 3 || act == 4) {
        float* O = (float*)op;
        const float* lbp = aux_f + (act - 3) * 4096 + col0;
#pragma unroll
        for (int bj = 0; bj < 2; ++bj) {
            const f32x4 l0 = *(const f32x4*)(lbp + bj * HALF), l1 = *(const f32x4*)(lbp + bj * HALF + 4);
#pragma unroll
            for (int ai = 0; ai < 2; ++ai)
#pragma unroll
                for (int m = 0; m < 4; ++m) {
                    float* rowp = O + (size_t)(row0 + ai * HALF + m * 16) * ldo + col0 + bj * HALF;
                    f32x4 v0 = acc[ai][bj][m][0], v1 = acc[ai][bj][m][1];
#pragma unroll
                    for (int j = 0; j < 4; ++j) {
                        const float s0 = __builtin_amdgcn_rcpf(1.0f + __expf(-v0[j])), s1 = __builtin_amdgcn_rcpf(1.0f + __expf(-v1[j]));
                        v0[j] = __logf(l0[j] + (1.0f - l0[j]) * s0); v1[j] = __logf(l1[j] + (1.0f - l1[j]) * s1);
                    }
                    *(f32x4*)rowp = v0; *(f32x4*)(rowp + 4) = v1;
                }
        }
    } else if (act == 5) {
        float* O = (float*)op;
#pragma unroll
        for (int ai = 0; ai < 2; ++ai)
#pragma unroll
            for (int m = 0; m < 4; ++m) {
                float* rowp = O + (size_t)(row0 + ai * HALF + m * 16) * ldo + col0;
#pragma unroll
                for (int bj = 0; bj < 2; ++bj) { *(f32x4*)(rowp + bj * HALF) = acc[ai][bj][m][0]; *(f32x4*)(rowp + bj * HALF + 4) = acc[ai][bj][m][1]; }
            }
    } else {
        bf16_t* O = (bf16_t*)op;
#pragma unroll
        for (int bj = 0; bj < 2; ++bj) {
            const f32x4 s0 = *(const f32x4*)(aux_f + col0 + bj * HALF), s1 = *(const f32x4*)(aux_f + col0 + bj * HALF + 4);
#pragma unroll
            for (int ai = 0; ai < 2; ++ai)
#pragma unroll
                for (int m = 0; m < 4; ++m) {
                    const size_t off = (size_t)(row0 + ai * HALF + m * 16) * ldo + col0 + bj * HALF;
                    const u32x4 z = *(const u32x4*)(aux_b + off);
                    f32x4 v0 = acc[ai][bj][m][0] * s0, v1 = acc[ai][bj][m][1] * s1;
                    v0[0] *= bflo(z.x); v0[1] *= bfhi(z.x); v0[2] *= bflo(z.y); v0[3] *= bfhi(z.y);
                    v1[0] *= bflo(z.z); v1[1] *= bfhi(z.z); v1[2] *= bflo(z.w); v1[3] *= bfhi(z.w);
                    store_bf8(O + off, v0, v1);
                }
        }
    }
}

__device__ __forceinline__ bool next_unit(int i, int G, int c, const LAS unsigned char* jt, int n0, int n1, Unit& u) {
    const int L = i * G + c; if (L >= n0 + n1) return false;
    const int job = L < n0 ? 0 : 1; const LAS unsigned char* jp = jt + job * 128;
    const int l = job ? L - n0 : L, ksplit = jl_i(jp + 112);
    u.job = job; u.ks = l % ksplit; u.nt = jl_i(jp + 108); decode_tile(l / ksplit, jl_i(jp + 16), jl_i(jp + 20), u.pm, u.pn);
    return true;
}
__device__ __forceinline__ const char* unit_a(const LAS unsigned char* jt, const Unit& u, size_t tstep) {
    const LAS unsigned char* jp = jt + u.job * 128;
    return (const char*)jl_p(jp + 0) + (size_t)(u.pn / jl_i(jp + 24)) * jl_p(jp + 32) * 2 + (size_t)u.pm * tstep + (size_t)(u.ks * jl_i(jp + 116));
}
__device__ __forceinline__ const char* unit_b(const LAS unsigned char* jt, const Unit& u, size_t tstep) {
    const LAS unsigned char* jp = jt + u.job * 128;
    return (const char*)jl_p(jp + 8) + (size_t)u.pn * tstep + (size_t)(u.ks * jl_i(jp + 116));
}

__device__ __forceinline__ void gemm_phase(LAS unsigned char* lds, const LAS unsigned char* jt, const int K  , const int n0, const int n1, const int G, const int c) {
    int tid_ = threadIdx.x; asm volatile("" : "+v"(tid_));
    const int tid = tid_, wid = __builtin_amdgcn_readfirstlane(tid >> 6), lane = tid & 63, wr = wid >> 2, wc = wid & 3, fr = lane & 15, fq = lane >> 4;
    unsigned voffA[2], voffB[2];
#pragma unroll
    for (int i = 0; i < 2; ++i) { int R, C; stage_rc(tid * 16 + i * 8192, R, C); const int Rb = (R & ~31) + perm32(R & 31);
        voffA[i] = (unsigned)(R * K + C) * 2u; voffB[i] = (unsigned)(Rb * K + C) * 2u; }
    const size_t kstep = (size_t)(BK * 2);
    const size_t hstep = (size_t)HALF * K * 2;
    const size_t tstep = 2 * hstep;
    const unsigned ldsw = (unsigned)wid * 1024u;
    const int aoff = lds_byte(wr * 64 + fr, fq * 8), boff = lds_byte(wc * 32 + fr, fq * 8);
#define PG8_SA(b, h) (((b) * 2 + (h)) * HTB)
#define PG8_SB(b, h) ((4 + (b) * 2 + (h)) * HTB)
#define PG8_STAGE(bufoff, gbase, voff) do { _Pragma("unroll") for (int _i = 0; _i < 2; ++_i) \
        __builtin_amdgcn_global_load_lds((const unsigned*)((const char*)(gbase) + (voff)[_i]), (LAS unsigned*)(lds + (bufoff) + ldsw + _i * 8192), 16, 0, 0); } while (0)
#define PG8_LDA(dst, b, h) do { _Pragma("unroll") for (int m = 0; m < 4; ++m) _Pragma("unroll") for (int k = 0; k < 2; ++k) dst[m][k] = *(const LAS bf16x8*)(lds + PG8_SA(b, h) + aoff + m * 2048 + k * 1024); } while (0)
#define PG8_LDB(dst, b, h) do { _Pragma("unroll") for (int n = 0; n < 2; ++n) _Pragma("unroll") for (int k = 0; k < 2; ++k) dst[n][k] = *(const LAS bf16x8*)(lds + PG8_SB(b, h) + boff + n * 2048 + k * 1024); } while (0)
#define PG8_MMA(ai, bj, At, Bt) do { __builtin_amdgcn_s_setprio(1); _Pragma("unroll") for (int m = 0; m < 4; ++m) _Pragma("unroll") for (int n = 0; n < 2; ++n) _Pragma("unroll") for (int k = 0; k < 2; ++k) \
        acc[ai][bj][m][n] = __builtin_amdgcn_mfma_f32_16x16x32_bf16(Bt[n][k], At[m][k], acc[ai][bj][m][n], 0, 0, 0); __builtin_amdgcn_s_setprio(0); } while (0)
#define PG8_WAIT_V(n) asm volatile("s_waitcnt vmcnt(" #n ")" ::: "memory")
#define PG8_WAIT_L(n) asm volatile("s_waitcnt lgkmcnt(" #n ")" ::: "memory")
#define PG8_BAR __builtin_amdgcn_s_barrier()
#define PG8_SCHED __builtin_amdgcn_sched_barrier(0)
#define PG8_UA(u) unit_a(jt, (u), tstep)
#define PG8_UB(u) unit_b(jt, (u), tstep)
    Unit cur, nxt; int ui = 0;
    if (!next_unit(0, G, c, jt, n0, n1, cur)) return;
    f32x4 acc[2][2][4][2];
#pragma unroll
    for (int a = 0; a < 2; ++a)
#pragma unroll
        for (int b = 0; b < 2; ++b)
#pragma unroll
            for (int m = 0; m < 4; ++m)
#pragma unroll
                for (int n = 0; n < 2; ++n) acc[a][b][m][n] = (f32x4){0.f, 0.f, 0.f, 0.f};
    bf16x8 At[4][2], B0[2][2], B1[2][2];
    const char* cA = PG8_UA(cur); const char* cB = PG8_UB(cur);
    PG8_STAGE(PG8_SB(0, 0), cB, voffB); PG8_STAGE(PG8_SB(0, 1), cB + hstep, voffB); PG8_STAGE(PG8_SA(0, 0), cA, voffA); PG8_STAGE(PG8_SA(0, 1), cA + hstep, voffA);
    if (wr == 1) PG8_BAR;
    PG8_WAIT_V(2); PG8_BAR;
    PG8_STAGE(PG8_SB(1, 0), cB + kstep, voffB); PG8_STAGE(PG8_SA(1, 0), cA + kstep, voffA); PG8_STAGE(PG8_SB(1, 1), cB + hstep + kstep, voffB);
    PG8_WAIT_V(6); PG8_BAR;
    for (;;) {
        const bool has_next = next_unit(ui + 1, G, c, jt, n0, n1, nxt);
        const char* nA = cA; const char* nB = cB;
        if (has_next) { nA = PG8_UA(nxt); nB = PG8_UB(nxt); }
        const int nt = cur.nt;
        for (int t = 0; t < nt; t += 2) {
            const bool last = (t == nt - 2);
            const char* a1 = cA + (size_t)(t + 1) * kstep;
            const char* a2 = last ? nA : cA + (size_t)(t + 2) * kstep; const char* b2 = last ? nB : cB + (size_t)(t + 2) * kstep;
            const char* a3 = a2 + kstep; const char* b3 = b2 + kstep;
            PG8_LDB(B0, 0, 0); PG8_LDB(B1, 0, 1); PG8_SCHED; PG8_LDA(At, 0, 0); PG8_STAGE(PG8_SA(1, 1), a1 + hstep, voffA);
            PG8_WAIT_V(8); PG8_WAIT_L(0); PG8_BAR; PG8_MMA(0, 0, At, B0); PG8_MMA(0, 1, At, B1); PG8_BAR; PG8_SCHED;
            PG8_LDA(At, 0, 1); PG8_STAGE(PG8_SB(0, 0), b2, voffB); PG8_STAGE(PG8_SB(0, 1), b2 + hstep, voffB); PG8_STAGE(PG8_SA(0, 0), a2, voffA);
            PG8_WAIT_V(8); PG8_WAIT_L(0); PG8_BAR; PG8_MMA(1, 0, At, B0); PG8_MMA(1, 1, At, B1); PG8_BAR; PG8_SCHED;
            PG8_LDB(B0, 1, 0); PG8_LDB(B1, 1, 1); PG8_SCHED; PG8_LDA(At, 1, 0); PG8_STAGE(PG8_SA(0, 1), a2 + hstep, voffA);
            PG8_WAIT_V(8); PG8_WAIT_L(0); PG8_BAR; PG8_MMA(0, 0, At, B0); PG8_MMA(0, 1, At, B1); PG8_BAR; PG8_SCHED;
            PG8_LDA(At, 1, 1); PG8_STAGE(PG8_SB(1, 0), b3, voffB); PG8_STAGE(PG8_SB(1, 1), b3 + hstep, voffB); PG8_STAGE(PG8_SA(1, 0), a3, voffA);
            PG8_WAIT_V(8); PG8_WAIT_L(0); PG8_BAR; PG8_MMA(1, 0, At, B0); PG8_MMA(1, 1, At, B1); PG8_BAR; PG8_SCHED;
        }
        if (wr == 0) PG8_BAR;
        epilogue(acc, jt, cur, wr, wc, fr, fq);
        if (!has_next) break;
#pragma unroll
        for (int a = 0; a < 2; ++a)
#pragma unroll
            for (int b = 0; b < 2; ++b)
#pragma unroll
                for (int m = 0; m < 4; ++m)
#pragma unroll
                    for (int n = 0; n < 2; ++n) acc[a][b][m][n] = (f32x4){0.f, 0.f, 0.f, 0.f};
        cur = nxt; cA = nA; cB = nB; ++ui;
        if (wr == 1) PG8_BAR;
    }
    PG8_WAIT_V(0);
    PG8_BAR;
#undef PG8_SA
#undef PG8_SB
#undef PG8_STAGE
#undef PG8_LDA
#undef PG8_LDB
#undef PG8_MMA
#undef PG8_WAIT_V
#undef PG8_WAIT_L
#undef PG8_BAR
#undef PG8_SCHED
#undef PG8_UA
#undef PG8_UB
}
}

struct Args {
    const float* in[19]; float* out; unsigned char* ws;
};

__device__ __forceinline__ void tr_item(const float* __restrict__ W, int K, int N, bf16_t* WT, int segperm, LAS float* scr, int item, int lane) {
    const int nblk = N >> 6, kb = item / nblk, nb = item - kb * nblk, k0 = kb << 6, n0 = nb << 6;
    const float* src = W + (size_t)k0 * N + n0 + lane;
#pragma unroll 16
    for (int i = 0; i < 64; ++i) scr[i * 65 + lane] = src[(size_t)i * N];
    LDS_WAIT();
    const int seg = n0 >> 12, dseg = (segperm >> (4 * seg)) & 15, drow0 = n0 + (dseg - seg) * 4096;
    const int c = lane & 7;
#pragma unroll
    for (int j = 0; j < 8; ++j) {
        const int n = (lane >> 3) + 8 * j; const LAS float* s = scr + (8 * c) * 65 + n;
        u32x4 o; o.x = pk2(s[0], s[65]); o.y = pk2(s[130], s[195]); o.z = pk2(s[260], s[325]); o.w = pk2(s[390], s[455]);
        *(u32x4*)(WT + (size_t)(drow0 + n) * K + k0 + 8 * c) = o;
    }
    LDS_WAIT();
}

__device__ __forceinline__ void transpose_layer(const Args& a, int layer, LAS unsigned char* lds, int gw, int NGW, int wave, int lane) {
    LAS float* scr = (LAS float*)(lds + wave * 16640);
    bf16_t* WIN = (bf16_t*)(a.ws + WS_WIN); bf16_t* WOUT = (bf16_t*)(a.ws + WS_WOUT); bf16_t* WG = (bf16_t*)(a.ws + WS_WG);
    const int kind = layer % 3, j = layer / 3;
    if (kind == 0) {
        const float* win = a.in[8] + (size_t)j * DM * 16384; const float* wout = a.in[10] + (size_t)j * DI * DM;
        const int n_in = (DM / 64) * (16384 / 64), n_out = (DI / 64) * (DM / 64);
        for (int it = gw; it < n_in + n_out; it += NGW) {
            if (it < n_in) tr_item(win, DM, 16384, WIN, 0x2310, scr, it, lane);
            else tr_item(wout, DI, DM, WOUT, 0x43210, scr, it - n_in, lane);
        }
    } else if (kind == 1) {
        const float* win = a.in[11]; const float* wg = a.in[12]; const float* wout = a.in[14];
        const int n_in = (DM / 64) * (8192 / 64), n_g = 16 * 16, n_out = (DI / 64) * (DM / 64);
        for (int it = gw; it < n_in + 4 * n_g + n_out; it += NGW) {
            if (it < n_in) tr_item(win, DM, 8192, WIN, 0x43210, scr, it, lane);
            else if (it < n_in + 4 * n_g) { const int g = (it - n_in) / n_g, r = (it - n_in) % n_g; tr_item(wg + (size_t)g * 1024 * 1024, 1024, 1024, WG + (size_t)g * 1024 * 1024, 0x43210, scr, r, lane); }
            else tr_item(wout, DI, DM, WOUT, 0x43210, scr, it - n_in - 4 * n_g, lane);
        }
    } else {
        const float* win = a.in[15]; const float* wout = a.in[18];
        const int n_in = (DM / 64) * (20480 / 64), n_out = (DI / 64) * (DM / 64);
        for (int it = gw; it < n_in + n_out; it += NGW) {
            if (it < n_in) tr_item(win, DM, 20480, WIN, 0x34210, scr, it, lane);
            else tr_item(wout, DI, DM, WOUT, 0x43210, scr, it - n_in, lane);
        }
    }
}

__device__ __forceinline__ void row_phase(const Args& a, int li, int gw, int NGW, int lane) {
    const float* MOD = (const float*)(a.ws + WS_MOD);
    float* XC = (float*)(a.ws + WS_XC); bf16_t* H = (bf16_t*)(a.ws + WS_H);
    const bf16_t* Y = (const bf16_t*)(a.ws + WS_S0 + 5 * SLOT);
    const int nrows = (li == 4) ? MLAT : MTOT;
    for (int row = gw; row < nrows; row += NGW) {
        const bool lat = row < MLAT;
        const int mr = lat ? (row >> 11) : 4;
        float* xrow = lat ? a.out + (size_t)row * DM : XC + (size_t)(row - MLAT) * DM;
        f32x4 xv[8];
        if (li == 0) {
            const float* src = lat ? a.in[0] + (size_t)row * DM : a.in[2] + (size_t)(row - MLAT) * DM;
#pragma unroll
            for (int j = 0; j < 8; ++j) xv[j] = *(const f32x4*)(src + 4 * lane + 256 * j);
#pragma unroll
            for (int j = 0; j < 8; ++j) *(f32x4*)(xrow + 4 * lane + 256 * j) = xv[j];
        } else {
            const bool upd = !(li == 4 && !lat);
#pragma unroll
            for (int j = 0; j < 8; ++j) xv[j] = *(const f32x4*)(xrow + 4 * lane + 256 * j);
            if (upd) {
                const bf16_t* yrow = Y + (size_t)row * DM;
                const float* gate = MOD + (size_t)((li - 1) * 5 + mr) * 6144 + 4096;
                const float* gpost = a.in[7] + (size_t)(li - 1) * DM;
                f32x4 yv[8]; float ss = 0.f;
#pragma unroll
                for (int j = 0; j < 8; ++j) {
                    if (lat) { const u32x2 yw = *(const u32x2*)(yrow + 4 * lane + 256 * j); yv[j] = (f32x4){bflo(yw.x), bfhi(yw.x), bflo(yw.y), bfhi(yw.y)}; }
                    else {
                        const bf16_t* pr = (const bf16_t*)(a.ws + WS_S0 + 7 * SLOT) + (size_t)(row - MLAT) * DM + 4 * lane + 256 * j;
                        yv[j] = (f32x4){0.f, 0.f, 0.f, 0.f};
#pragma unroll
                        for (int ks = 0; ks < 8; ++ks) { const u32x2 yw = *(const u32x2*)(pr + (size_t)ks * MCTX * DM); yv[j] += (f32x4){bflo(yw.x), bfhi(yw.x), bflo(yw.y), bfhi(yw.y)}; }
                    }
                    ss += (yv[j].x * yv[j].x + yv[j].y * yv[j].y) + (yv[j].z * yv[j].z + yv[j].w * yv[j].w); }
                const float rstd = rsqrtf(wave_sum(ss) * (1.0f / DM) + EPS);
#pragma unroll
                for (int j = 0; j < 8; ++j) {
                    const f32x4 g = *(const f32x4*)(gate + 4 * lane + 256 * j), gp = *(const f32x4*)(gpost + 4 * lane + 256 * j);
                    xv[j] += g * (yv[j] * rstd * gp);
                    *(f32x4*)(xrow + 4 * lane + 256 * j) = xv[j];
                }
            }
        }
        if (li < 4) {
            float ss = 0.f;
#pragma unroll
            for (int j = 0; j < 8; ++j) ss += (xv[j].x * xv[j].x + xv[j].y * xv[j].y) + (xv[j].z * xv[j].z + xv[j].w * xv[j].w);
            const float rstd = rsqrtf(wave_sum(ss) * (1.0f / DM) + EPS);
            const float* shift = MOD + (size_t)(li * 5 + mr) * 6144; const float* scale = shift + 2048;
            const float* gpre = a.in[6] + (size_t)li * DM;
            bf16_t* hrow = H + (size_t)row * DM;
#pragma unroll
            for (int j = 0; j < 8; ++j) {
                const f32x4 sh = *(const f32x4*)(shift + 4 * lane + 256 * j), sc = *(const f32x4*)(scale + 4 * lane + 256 * j), gp = *(const f32x4*)(gpre + 4 * lane + 256 * j);
                const f32x4 hv = (xv[j] * rstd * gp) * (1.0f + sc) + sh;
                u32x2 w; w.x = pk2(hv.x, hv.y); w.y = pk2(hv.z, hv.w);
                *(u32x2*)(hrow + 4 * lane + 256 * j) = w;
            }
        }
    }
}

__device__ __forceinline__ void init_phase(const Args& a, LAS unsigned char* lds, int G) {
    LAS float* sc = (LAS float*)lds;
    LAS float* red = sc + 5 * 2048;
    const int tid = my_tid();
    float* MOD = (float*)(a.ws + WS_MOD); float* LB = (float*)(a.ws + WS_LB);
    for (int e = tid; e < 5 * 2048; e += NTHR) { const int r = e >> 11, k = e & 2047; const float v = r < 4 ? a.in[1][r * 2048 + k] : a.in[3][k]; sc[e] = silu_f(v); }
    __syncthreads();
    for (int item = blockIdx.x; item < 384; item += G) {
        const int layer = item / 96, n0 = (item % 96) * 64, ks = tid >> 6, nn = tid & 63;
        float acc0 = 0.f, acc1 = 0.f, acc2 = 0.f, acc3 = 0.f, acc4 = 0.f;
        const float* wp = a.in[4] + ((size_t)layer * 2048 + ks * 256) * 6144 + n0 + nn;
        const LAS float* sp = sc + ks * 256;
#pragma unroll 32
        for (int kk = 0; kk < 256; ++kk) {
            const float w = wp[(size_t)kk * 6144];
            acc0 += sp[kk] * w; acc1 += sp[2048 + kk] * w; acc2 += sp[4096 + kk] * w; acc3 += sp[6144 + kk] * w; acc4 += sp[8192 + kk] * w;
        }
        red[(ks * 5 + 0) * 64 + nn] = acc0; red[(ks * 5 + 1) * 64 + nn] = acc1; red[(ks * 5 + 2) * 64 + nn] = acc2; red[(ks * 5 + 3) * 64 + nn] = acc3; red[(ks * 5 + 4) * 64 + nn] = acc4;
        __syncthreads();
        if (tid < 320) {
            const int r = tid >> 6, n2 = tid & 63; float s = 0.f;
#pragma unroll
            for (int k8 = 0; k8 < 8; ++k8) s += red[(k8 * 5 + r) * 64 + n2];
            MOD[(size_t)(layer * 5 + r) * 6144 + n0 + n2] = s + a.in[5][layer * 6144 + n0 + n2];
        }
        __syncthreads();
    }
    const int gt = blockIdx.x * NTHR + tid;
    if (gt < 2 * 4096) {
        const int d = gt >> 12, f = gt & 4095; const float* p = a.in[16] + (size_t)d * 4 * 4096 + f;
        const float l0 = p[0], l1 = p[4096], l2 = p[8192], l3 = p[12288];
        const float mx = fmaxf(fmaxf(l0, l1), fmaxf(l2, l3));
        const float e0 = expf(l0 - mx), e1 = expf(l1 - mx), e2 = expf(l2 - mx), e3 = expf(l3 - mx);
        LB[gt] = (e1 + e2) / (e0 + e1 + e2 + e3);
    }
}

typedef float f32x16 __attribute__((ext_vector_type(16)));
__device__ __forceinline__ void attn_phase(const Args& a, int layer, LAS unsigned char* lds, int G, int need_ctx) {
    const int tid = my_tid(), wave = __builtin_amdgcn_readfirstlane(tid >> 6), lane = tid & 63, q = lane & 31, hh = lane >> 5;
    const bf16_t* Q = (const bf16_t*)(a.ws + WS_S0); const bf16_t* Kp = (const bf16_t*)(a.ws + WS_S0 + SLOT);
    const bf16_t* SZ = (const bf16_t*)(a.ws + WS_S0 + 2 * SLOT); const bf16_t* Vt = (const bf16_t*)(a.ws + WS_S0 + 3 * SLOT);
    bf16_t* GT = (bf16_t*)(a.ws + WS_S0 + 4 * SLOT);
    const float* rpb = a.in[9] + (size_t)(layer / 3) * 32 * 465;
    LAS float* rp = (LAS float*)(lds + wave * 2048);
    const int gw = blockIdx.x * NWAVES + wave, NGW = G * NWAVES;
    const int nlat = 8192, ntask = nlat + (need_ctx ? 1024 : 0);
    const int sig = (q & 19) | ((q & 8) >> 1) | ((q & 4) << 1);
    for (int task = gw; task < ntask; task += NGW) {
        const bool lat = task < nlat;
        int b, h, r = 0, j = 0, qtok;
        if (lat) { j = task & 3; r = 2 * ((task >> 2) & 15); h = (task >> 6) & 31; b = task >> 11; qtok = b * SEQ + (r + (q >> 4)) * 64 + 16 * j + (q & 15); }
        else { const int t2 = task - nlat; h = (t2 >> 3) & 31; b = t2 >> 8; qtok = MLAT + b * CTX + 32 * (t2 & 7) + q; }
        bf16x8 qf[8];
#pragma unroll
        for (int c = 0; c < 8; ++c) qf[c] = *(const bf16x8*)(Q + (size_t)qtok * DI + h * 128 + 16 * c + 8 * hh);
        if (lat) {
            LDS_WAIT();
            for (int e = lane; e < 465; e += 64) rp[e] = rpb[h * 465 + e];
            LDS_WAIT();
        }
        const int r0a = min(max(r - 4, 0), 24), r0b = min(max(r - 3, 0), 24), nband = lat ? (r0b + 8 - r0a) : 0;
        const int qr = r + (q >> 4), myr0 = (q >> 4) ? r0b : r0a;
        const int cw = min(max(16 * j - 8, 0), 32), qcol = 16 * j + (q & 15), c0 = min(max(qcol - 8, 0), 48);
        const int nst = nband + 8;
        const int kb_lat = b * SEQ + r0a * 64 + cw, kb_ctx = MLAT + b * CTX;
        const bf16_t* kbase = Kp + (size_t)h * 1024 + (size_t)(sig >> 3) * 32768 + (sig & 7) * 16 + 8 * hh;
        const bf16_t* vbase = Vt + (size_t)h * 1024 + (size_t)hh * 32768 + q * 8;
        float m_run = -1e30f, l_run = 0.f;
        f32x16 OT[4];
#pragma unroll
        for (int d = 0; d < 4; ++d)
#pragma unroll
            for (int t = 0; t < 16; ++t) OT[d][t] = 0.f;
        bf16x8 kreg[8], vreg[8];
        { const int kb0 = nband ? kb_lat : kb_ctx;
#pragma unroll
          for (int c = 0; c < 8; ++c) kreg[c] = *(const bf16x8*)(kbase + (size_t)(kb0 >> 3) * 32768 + 128 * c); }
        for (int st = 0; st < nst; ++st) {
            const bool isl = st < nband;
            const int keybase = isl ? kb_lat + st * 64 : kb_ctx + 32 * (st - nband);
#pragma unroll
            for (int d = 0; d < 4; ++d)
#pragma unroll
                for (int s2 = 0; s2 < 2; ++s2) vreg[d * 2 + s2] = *(const bf16x8*)(vbase + (size_t)(keybase >> 3) * 32768 + s2 * 65536 + d * 256);
            f32x16 sc;
#pragma unroll
            for (int t = 0; t < 16; ++t) sc[t] = 0.f;
#pragma unroll
            for (int c = 0; c < 8; ++c) sc = __builtin_amdgcn_mfma_f32_32x32x16_bf16(kreg[c], qf[c], sc, 0, 0, 0);
            if (st + 1 < nst) {
                const int kn = (st + 1 < nband) ? kb_lat + (st + 1) * 64 : kb_ctx + 32 * (st + 1 - nband);
#pragma unroll
                for (int c = 0; c < 8; ++c) kreg[c] = *(const bf16x8*)(kbase + (size_t)(kn >> 3) * 32768 + 128 * c);
            }
            if (isl) {
                const int kr = r0a + st; const bool rowok = (kr >= myr0) && (kr < myr0 + 8);
                const int brow = (kr - qr + 7) * 31 - qcol + 15;
#pragma unroll
                for (int t = 0; t < 16; ++t) {
                    const int kc = cw + 16 * (t >> 3) + 8 * hh + (t & 7); const bool valid = rowok && (kc >= c0) && (kc < c0 + 16);
                    const float bias = rp[valid ? (brow + kc) : 0];
                    sc[t] = valid ? sc[t] + bias : -3.0e38f;
                }
            }
            float mx = sc[0];
#pragma unroll
            for (int t = 1; t < 16; ++t) mx = fmaxf(mx, sc[t]);
            mx = fmaxf(mx, __shfl_xor(mx, 32));
            const float m_new = fmaxf(m_run, mx), alpha = __expf(m_run - m_new);
            float rs = 0.f;
#pragma unroll
            for (int t = 0; t < 16; ++t) { sc[t] = __expf(sc[t] - m_new); rs += sc[t]; }
            rs += __shfl_xor(rs, 32);
            l_run = l_run * alpha + rs; m_run = m_new;
            union { u32x4 u; bf16x8 v; } P0, P1;
            P0.u.x = pk2(sc[0], sc[1]); P0.u.y = pk2(sc[2], sc[3]); P0.u.z = pk2(sc[4], sc[5]); P0.u.w = pk2(sc[6], sc[7]);
            P1.u.x = pk2(sc[8], sc[9]); P1.u.y = pk2(sc[10], sc[11]); P1.u.z = pk2(sc[12], sc[13]); P1.u.w = pk2(sc[14], sc[15]);
#pragma unroll
            for (int d = 0; d < 4; ++d) {
#pragma unroll
                for (int t = 0; t < 16; ++t) OT[d][t] *= alpha;
                OT[d] = __builtin_amdgcn_mfma_f32_32x32x16_bf16(vreg[d * 2 + 0], P0.v, OT[d], 0, 0, 0);
                OT[d] = __builtin_amdgcn_mfma_f32_32x32x16_bf16(vreg[d * 2 + 1], P1.v, OT[d], 0, 0, 0);
            }
        }
        const float inv = 1.0f / l_run;
        const size_t obase = (size_t)qtok * DI + h * 128 + 4 * hh;
#pragma unroll
        for (int d = 0; d < 4; ++d)
#pragma unroll
            for (int g4 = 0; g4 < 4; ++g4) {
                const size_t o = obase + 32 * d + 8 * g4;
                const u32x2 z = *(const u32x2*)(SZ + o);
                u32x2 w; w.x = pk2(OT[d][4 * g4 + 0] * inv * bflo(z.x), OT[d][4 * g4 + 1] * inv * bfhi(z.x)); w.y = pk2(OT[d][4 * g4 + 2] * inv * bflo(z.y), OT[d][4 * g4 + 3] * inv * bfhi(z.y));
                *(u32x2*)(GT + o) = w;
            }
    }
}

__device__ __forceinline__ void pool_phase(const Args& a, int G) {
    const bf16_t* U = (const bf16_t*)(a.ws + WS_S0); bf16_t* Pg = (bf16_t*)(a.ws + WS_S0 + SLOT);
    const int gt = blockIdx.x * NTHR + my_tid(), gsz = G * NTHR;
    for (int idx = gt; idx < MTOT * 512; idx += gsz) {
        const int row = idx >> 9, cv = idx & 511, col = cv * 8, g = col >> 10, hw = 1 << g;
        int t, T, base;
        if (row < MLAT) { t = row & 2047; T = SEQ; base = row - t; } else { const int r2 = row - MLAT; t = r2 & 255; T = CTX; base = row - t; }
        const int lo = max(t - hw, 0), hi = min(t + hw, T);
        float acc[8];
#pragma unroll
        for (int e = 0; e < 8; ++e) acc[e] = 0.f;
        for (int tt = lo; tt < hi; ++tt) {
            const u32x4 v = *(const u32x4*)(U + (size_t)(base + tt) * DI + col);
            acc[0] += bflo(v.x); acc[1] += bfhi(v.x); acc[2] += bflo(v.y); acc[3] += bfhi(v.y); acc[4] += bflo(v.z); acc[5] += bfhi(v.z); acc[6] += bflo(v.w); acc[7] += bfhi(v.w);
        }
        const float ic = 1.0f / (float)(hi - lo);
        const u32x4 c = *(const u32x4*)(U + (size_t)row * DI + col);
        u32x4 o; o.x = pk2(acc[0] * ic - bflo(c.x), acc[1] * ic - bfhi(c.x)); o.y = pk2(acc[2] * ic - bflo(c.y), acc[3] * ic - bfhi(c.y));
        o.z = pk2(acc[4] * ic - bflo(c.z), acc[5] * ic - bfhi(c.z)); o.w = pk2(acc[6] * ic - bflo(c.w), acc[7] * ic - bfhi(c.w));
        *(u32x4*)(Pg + ((size_t)g * MTOT + row) * 1024 + (col & 1023)) = o;
    }
}

__device__ __forceinline__ void hgate_phase(const Args& a, int G) {
    const bf16_t* Of = (const bf16_t*)(a.ws + WS_S0 + SLOT); const bf16_t* Ob = (const bf16_t*)(a.ws + WS_S0 + 4 * SLOT);
    const bf16_t* SZ = (const bf16_t*)(a.ws + WS_S0 + 2 * SLOT); bf16_t* GT = (bf16_t*)(a.ws + WS_S0);
    const float* gn = a.in[17];
    const int gt = blockIdx.x * NTHR + my_tid(), gsz = G * NTHR;
    for (int idx = gt; idx < MTOT * 512; idx += gsz) {
        const int row = idx >> 9, col = (idx & 511) * 8; const size_t off = (size_t)row * DI + col;
        const u32x4 f = *(const u32x4*)(Of + off), bk = *(const u32x4*)(Ob + off), z = *(const u32x4*)(SZ + off);
        float o[8];
        o[0] = bflo(f.x) + bflo(bk.x); o[1] = bfhi(f.x) + bfhi(bk.x); o[2] = bflo(f.y) + bflo(bk.y); o[3] = bfhi(f.y) + bfhi(bk.y);
        o[4] = bflo(f.z) + bflo(bk.z); o[5] = bfhi(f.z) + bfhi(bk.z); o[6] = bflo(f.w) + bflo(bk.w); o[7] = bfhi(f.w) + bfhi(bk.w);
        float ss = 0.f;
#pragma unroll
        for (int e = 0; e < 8; ++e) ss += o[e] * o[e];
        ss += __shfl_xor(ss, 1); ss += __shfl_xor(ss, 2); ss += __shfl_xor(ss, 4); ss += __shfl_xor(ss, 8);
        const float rstd = rsqrtf(ss * (1.0f / 128.0f) + EPS);
        const f32x4 g0 = *(const f32x4*)(gn + col), g1 = *(const f32x4*)(gn + col + 4);
        u32x4 w;
        w.x = pk2(o[0] * rstd * g0.x * bflo(z.x), o[1] * rstd * g0.y * bfhi(z.x)); w.y = pk2(o[2] * rstd * g0.z * bflo(z.y), o[3] * rstd * g0.w * bfhi(z.y));
        w.z = pk2(o[4] * rstd * g1.x * bflo(z.z), o[5] * rstd * g1.y * bfhi(z.z)); w.w = pk2(o[6] * rstd * g1.z * bflo(z.w), o[7] * rstd * g1.w * bfhi(z.w));
        *(u32x4*)(GT + off) = w;
    }
}

constexpr int SC_QT = 0, SC_KT = 8704, SC_KH = 17408, SC_DEC = 27648, SC_BUF = 28160, SC_TOT = 2 * SC_BUF;
struct ScanRaw { float lf[8]; unsigned short qs[8]; };

__device__ __forceinline__ void scan_chunk_t0(int cj, int b, int dir, int& t0) {
    const bool isctx = cj < 8;
    const int cc = isctx ? (dir ? 7 - cj : cj) : (dir ? 71 - cj : cj - 8);
    t0 = isctx ? MLAT + b * CTX + 32 * cc : b * SEQ + 32 * cc;
}

__device__ __forceinline__ void scan_phase(const Args& a, LAS unsigned char* lds, int G) {
    const int tid = my_tid(), wave = tid >> 6, lane = tid & 63, fr = lane & 15, fq = lane >> 4;
    const bf16_t* QS = (const bf16_t*)(a.ws + WS_S0); const bf16_t* Vt = (const bf16_t*)(a.ws + WS_S0 + 3 * SLOT);
    const int kch = tid & 127, part = tid >> 7;
    for (int sidx = blockIdx.x; sidx < 256; sidx += G) {
        const int dir = sidx & 1, h = (sidx >> 1) & 31, b = sidx >> 6;
        const float* LF = (const float*)(a.ws + WS_S0 + (dir ? 7 : 5) * SLOT);
        bf16_t* O = (bf16_t*)(a.ws + WS_S0 + (dir ? 4 : 1) * SLOT);
        f32x4 S[8];
#pragma unroll
        for (int k = 0; k < 8; ++k) S[k] = (f32x4){0.f, 0.f, 0.f, 0.f};
        float rlf[8]; unsigned short rqs[8]; bf16x8 vfn;
#define SCAN_RAW(cj) do { int _t0; scan_chunk_t0((cj), b, dir, _t0); \
        _Pragma("unroll") for (int e = 0; e < 8; ++e) { const int tau = 8 * part + e; const int tok = dir ? _t0 + 31 - tau : _t0 + tau; \
            rlf[e] = LF[(size_t)tok * DI + h * 128 + kch]; rqs[e] = QS[(size_t)tok * DI + h * 128 + kch]; } \
        vfn = *(const bf16x8*)(Vt + (size_t)(h * 128 + 16 * wave + fr) * MTOT + (dir ? _t0 + 24 - 8 * fq : _t0 + 8 * fq)); } while (0)
#define SCAN_PREP(bufp) do { LAS unsigned char* _B = (bufp); LAS float* TOT = (LAS float*)(lds + SC_TOT); \
        float cs[8]; float run = 0.f; \
        _Pragma("unroll") for (int e = 0; e < 8; ++e) { run += rlf[e]; cs[e] = run; } \
        TOT[part * 128 + kch] = run; __syncthreads(); \
        float off = 0.f, bend = 0.f; \
        _Pragma("unroll") for (int p = 0; p < 4; ++p) { const float tv = TOT[p * 128 + kch]; off += (p < part) ? tv : 0.f; bend += tv; } \
        unsigned kh[8]; \
        _Pragma("unroll") for (int e = 0; e < 8; ++e) { const int tau = 8 * part + e; const float bt = off + cs[e]; const float kf = 1.0f - __expf(rlf[e]); \
            const float qv = __uint_as_float(((unsigned)rqs[e]) << 16) * __expf(bt); const float kt = kf * __expf(-bt); const float kk = kf * __expf(bend - bt); \
            ((LAS bf16_t*)(_B + SC_QT))[tau * 136 + kch] = (bf16_t)(pk2(qv, 0.f) & 0xffffu); ((LAS bf16_t*)(_B + SC_KT))[tau * 136 + kch] = (bf16_t)(pk2(kt, 0.f) & 0xffffu); kh[e] = pk2(kk, 0.f) & 0xffffu; } \
        u32x4 kw; kw.x = kh[0] | (kh[1] << 16); kw.y = kh[2] | (kh[3] << 16); kw.z = kh[4] | (kh[5] << 16); kw.w = kh[6] | (kh[7] << 16); \
        *(LAS u32x4*)(_B + SC_KH + kch * 80 + part * 16) = kw; \
        if (part == 0) ((LAS float*)(_B + SC_DEC))[kch] = __expf(bend); } while (0)

        SCAN_RAW(0);
        SCAN_PREP(lds);
        bf16x8 vf = vfn;
        SCAN_RAW(1);
        __syncthreads();
        for (int ci = 0; ci < 72; ++ci) {
            LAS unsigned char* B = lds + (ci & 1) * SC_BUF;
            bf16x8 vf_next = vfn;
            if (ci + 1 < 72) { SCAN_PREP(lds + ((ci + 1) & 1) * SC_BUF); }
            if (ci + 2 < 72) { SCAN_RAW(ci + 2); }
            int t0; scan_chunk_t0(ci, b, dir, t0);
            bf16x8 vcur = vf;
            if (dir) { bf16x8 t = vf; vcur[0] = t[7]; vcur[1] = t[6]; vcur[2] = t[5]; vcur[3] = t[4]; vcur[4] = t[3]; vcur[5] = t[2]; vcur[6] = t[1]; vcur[7] = t[0]; }
            bf16x8 qb[2][4];
#pragma unroll
            for (int tb = 0; tb < 2; ++tb)
#pragma unroll
                for (int c = 0; c < 4; ++c) qb[tb][c] = *(const LAS bf16x8*)(B + SC_QT + ((16 * tb + fr) * 136 + 32 * c + 8 * fq) * 2);
            f32x4 att[2][2];
#pragma unroll
            for (int sb = 0; sb < 2; ++sb) {
                att[sb][0] = (f32x4){0.f, 0.f, 0.f, 0.f}; att[sb][1] = (f32x4){0.f, 0.f, 0.f, 0.f};
                const int srow = 8 * (fr >> 2) + 4 * sb + (fr & 3);
#pragma unroll
                for (int c = 0; c < 4; ++c) {
                    const bf16x8 ka = *(const LAS bf16x8*)(B + SC_KT + (srow * 136 + 32 * c + 8 * fq) * 2);
                    att[sb][0] = __builtin_amdgcn_mfma_f32_16x16x32_bf16(ka, qb[0][c], att[sb][0], 0, 0, 0);
                    att[sb][1] = __builtin_amdgcn_mfma_f32_16x16x32_bf16(ka, qb[1][c], att[sb][1], 0, 0, 0);
                }
            }
            f32x4 OT[2];
#pragma unroll
            for (int tb = 0; tb < 2; ++tb) {
                const int t = 16 * tb + fr;
#pragma unroll
                for (int sb = 0; sb < 2; ++sb)
#pragma unroll
                    for (int i = 0; i < 4; ++i) { const int sa = 8 * fq + 4 * sb + i; att[sb][tb][i] = (sa <= t) ? att[sb][tb][i] : 0.f; }
                union { u32x4 u; bf16x8 v; } P; P.u.x = pk2(att[0][tb][0], att[0][tb][1]); P.u.y = pk2(att[0][tb][2], att[0][tb][3]); P.u.z = pk2(att[1][tb][0], att[1][tb][1]); P.u.w = pk2(att[1][tb][2], att[1][tb][3]);
                OT[tb] = __builtin_amdgcn_mfma_f32_16x16x32_bf16(vcur, P.v, (f32x4){0.f, 0.f, 0.f, 0.f}, 0, 0, 0);
            }
#pragma unroll
            for (int c = 0; c < 4; ++c) {
                union { u32x4 u; bf16x8 v; } SF; SF.u.x = pk2(S[2 * c][0], S[2 * c][1]); SF.u.y = pk2(S[2 * c][2], S[2 * c][3]); SF.u.z = pk2(S[2 * c + 1][0], S[2 * c + 1][1]); SF.u.w = pk2(S[2 * c + 1][2], S[2 * c + 1][3]);
                OT[0] = __builtin_amdgcn_mfma_f32_16x16x32_bf16(SF.v, qb[0][c], OT[0], 0, 0, 0);
                OT[1] = __builtin_amdgcn_mfma_f32_16x16x32_bf16(SF.v, qb[1][c], OT[1], 0, 0, 0);
            }
#pragma unroll
            for (int kb = 0; kb < 8; ++kb) {
                const int krow = 32 * (kb >> 1) + 8 * (fr >> 2) + 4 * (kb & 1) + (fr & 3);
                const bf16x8 ka = *(const LAS bf16x8*)(B + SC_KH + krow * 80 + fq * 16);
                const f32x4 dc = *(const LAS f32x4*)(B + SC_DEC + (32 * (kb >> 1) + 8 * fq + 4 * (kb & 1)) * 4);
                S[kb] = __builtin_amdgcn_mfma_f32_16x16x32_bf16(ka, vcur, S[kb] * dc, 0, 0, 0);
            }
#pragma unroll
            for (int tb = 0; tb < 2; ++tb) {
                const int tau = 16 * tb + fr; const int tok = dir ? t0 + 31 - tau : t0 + tau;
                u32x2 w; w.x = pk2(OT[tb][0], OT[tb][1]); w.y = pk2(OT[tb][2], OT[tb][3]);
                *(u32x2*)(O + (size_t)tok * DI + h * 128 + 16 * wave + 4 * fq) = w;
            }
            vf = vf_next;
            __syncthreads();
        }
#undef SCAN_RAW
#undef SCAN_PREP
    }
}

#define XB_TMO      128
#define XB_XCNT(j)  (256  + 64 * (j))
#define XB_XSUB(j)  (1280 + 64 * (j))
#define XB_XGEN(j)  (2304 + 64 * (j))
#define XB_TOP      3328
#define XB_TOPGEN   3392
#define XCD_BAR_WORDS 3456
#define XB_SPIN_CAP (1u << 18)

__device__ __forceinline__ unsigned xb_ld(unsigned* p)              { return __hip_atomic_load(p, __ATOMIC_RELAXED, __HIP_MEMORY_SCOPE_AGENT); }
__device__ __forceinline__ unsigned xb_add(unsigned* p, unsigned v) { return __hip_atomic_fetch_add(p, v, __ATOMIC_RELAXED, __HIP_MEMORY_SCOPE_AGENT); }
__device__ __forceinline__ unsigned xb_xcc_id() { return (unsigned)__builtin_amdgcn_s_getreg((3 << 11) | 20) & 0xFu; }
#define XB_SPIN(cond, bar) do { unsigned _sp = 0; while (cond) { __builtin_amdgcn_s_sleep(1); \
    if ((++_sp & 255u) == 0u) { if (xb_ld(&(bar)[XB_TMO])) break; if (_sp > XB_SPIN_CAP) { atomicAdd(&(bar)[XB_TMO], 1u); break; } } } } while (0)

struct XcdBarrier {
    unsigned* bar; unsigned x;
    volatile LAS unsigned* st;
};

__device__ __forceinline__ XcdBarrier xcd_barrier_post(unsigned* bar, volatile LAS unsigned* st) {
    XcdBarrier b; b.bar = bar; b.x = xb_xcc_id(); b.st = st;
    if (threadIdx.x == 0) (void)xb_add(&bar[XB_XCNT(b.x)], 1u);
    return b;
}
__device__ __forceinline__ void xcd_barrier_complete(unsigned* bar, unsigned x, unsigned& nloc, unsigned& nx) {
    const unsigned G = gridDim.x * gridDim.y * gridDim.z;
    unsigned sum, cnt, mine, sp = 0u;
    for (;;) {
        sum = 0u; cnt = 0u; mine = 0u;
#pragma unroll
        for (unsigned j = 0; j < 16; ++j) { const unsigned c = xb_ld(&bar[XB_XCNT(j)]); sum += c; cnt += (c > 0u) ? 1u : 0u; mine = (j == x) ? c : mine; }
        if (sum == G) break;
        __builtin_amdgcn_s_sleep(1);
        if ((++sp & 255u) == 0u) { if (xb_ld(&bar[XB_TMO])) break; if (sp > XB_SPIN_CAP) { atomicAdd(&bar[XB_TMO], 1u); break; } }
    }
    nloc = mine > 0u ? mine : 1u; nx = cnt > 0u ? cnt : 1u;
}

__device__ __forceinline__ void xcd_barrier(const XcdBarrier& b) {
    asm volatile("s_waitcnt vmcnt(0)" ::: "memory");
    __syncthreads();
    if (threadIdx.x == 0) {
        unsigned* bar = b.bar;
        __builtin_amdgcn_s_waitcnt(0);
        unsigned nloc = b.st[0], nx = b.st[1];
        if (nloc == 0u) { xcd_barrier_complete(bar, b.x, nloc, nx); b.st[0] = nloc; b.st[1] = nx; }
        const unsigned old = xb_add(&bar[XB_XSUB(b.x)], 1u);
        const unsigned gen = old / nloc;
        if (old + 1u == (gen + 1u) * nloc) {
            __builtin_amdgcn_fence(__ATOMIC_RELEASE, "agent");
            asm volatile("s_waitcnt vmcnt(0)" ::: "memory");
            const unsigned og = xb_add(&bar[XB_TOP], 1u);
            const unsigned tg = og / nx;
            if (og + 1u == (tg + 1u) * nx) xb_add(&bar[XB_TOPGEN], 1u);
            else XB_SPIN(xb_ld(&bar[XB_TOPGEN]) == tg, bar);
            __builtin_amdgcn_fence(__ATOMIC_ACQUIRE, "agent");
            xb_add(&bar[XB_XGEN(b.x)], 1u);
            asm volatile("s_waitcnt vmcnt(0)" ::: "memory");
        } else {
            XB_SPIN(xb_ld(&bar[XB_XGEN(b.x)]) == gen, bar);
            __builtin_amdgcn_fence(__ATOMIC_ACQUIRE, "agent");
            asm volatile("s_waitcnt vmcnt(0)" ::: "memory");
        }
    }
    __syncthreads();
}


enum { OP_INIT = 0, OP_ROW = 1, OP_G1 = 2, OP_ATT = 3, OP_POOL = 4, OP_GG = 5, OP_SCAN = 6, OP_GATE = 7, OP_G2 = 8, OP_FINAL = 9 };
constexpr int NPHASE = 20;
constexpr int JOB_OFF = LDS_BYTES - 4096;
constexpr int BAR_ST_OFF = LDS_BYTES - 16;

__global__ void __launch_bounds__(NTHR, 2) fwd_mega(Args a0) {
    extern __shared__ __attribute__((aligned(16))) unsigned char lds_raw[];
    LAS unsigned char* lds = (LAS unsigned char*)lds_raw;
    cg::grid_group grid = cg::this_grid();
    const int G = gridDim.x, bid = blockIdx.x;
    if (a0.ws == nullptr) grid.sync();
    if (threadIdx.x == 0) {
        unsigned char* ws = a0.ws;
        bf16_t* H = (bf16_t*)(ws + WS_H); bf16_t* WIN = (bf16_t*)(ws + WS_WIN); bf16_t* WOUT = (bf16_t*)(ws + WS_WOUT); bf16_t* WG = (bf16_t*)(ws + WS_WG);
        const float* LB = (const float*)(ws + WS_LB);
        const int BIG = 1 << 30;
#define SLW(i) (ws + WS_S0 + (size_t)(i) * SLOT)
#define JW(gi, J0, J1, K, n0, n1) do { LAS unsigned char* p_ = lds + JOB_OFF + (gi) * 256; pg8::job_write(p_, J0); pg8::job_write(p_ + 128, J1); *(LAS int*)(p_ + 96) = (K); *(LAS int*)(p_ + 100) = (n0); *(LAS int*)(p_ + 104) = (n1); } while (0)
        const pg8::Job na0{H, WIN, 36, 48, BIG, 0, 4096, 0x271, SLW(0), SLW(1), SLW(2), nullptr, DI, nullptr, nullptr, 32, 1, 0, 0};
        const pg8::Job na1{WIN + (size_t)12288 * DM, H, 16, 36, BIG, 0, BIG, 0x8, SLW(3), nullptr, nullptr, nullptr, MTOT, nullptr, nullptr, 32, 1, 0, 0};
        const pg8::Job g2a{(const bf16_t*)SLW(4), WOUT, 32, 8, BIG, 0, BIG, 0x0, SLW(5), nullptr, nullptr, nullptr, DM, nullptr, nullptr, 64, 1, 0, 0};
        const pg8::Job g2c{(const bf16_t*)SLW(0), WOUT, 32, 8, BIG, 0, BIG, 0x0, SLW(5), nullptr, nullptr, nullptr, DM, nullptr, nullptr, 64, 1, 0, 0};
        const pg8::Job g2l{(const bf16_t*)SLW(4), WOUT, 32, 8, BIG, 0, BIG, 0x0, SLW(5), nullptr, nullptr, nullptr, DM, nullptr, nullptr, 64, 1, 0, 0};
        const pg8::Job g2xa{(const bf16_t*)SLW(4) + (size_t)MLAT * DI, WOUT, 4, 8, BIG, 0, BIG, 0x0, SLW(7), nullptr, nullptr, nullptr, DM, nullptr, nullptr, 8, 8, 1024, MCTX * DM};
        const pg8::Job g2xc{(const bf16_t*)SLW(0) + (size_t)MLAT * DI, WOUT, 4, 8, BIG, 0, BIG, 0x0, SLW(7), nullptr, nullptr, nullptr, DM, nullptr, nullptr, 8, 8, 1024, MCTX * DM};
        const pg8::Job p0{H, WIN, 36, 32, BIG, 0, 4096, 0x20, SLW(0), SLW(2), nullptr, nullptr, DI, nullptr, nullptr, 32, 1, 0, 0};
        const pg8::Job pg{(const bf16_t*)SLW(1), WG, 36, 16, 4, (size_t)MTOT * 1024, BIG, 0x6, SLW(4), nullptr, nullptr, nullptr, DI, a0.in[13], (const bf16_t*)SLW(2), 16, 1, 0, 0};
        const pg8::Job h0{H, WIN, 36, 64, BIG, 0, 4096, 0x2432, SLW(0), SLW(5), SLW(7), SLW(2), DI, LB, nullptr, 32, 1, 0, 0};
        const pg8::Job h1{WIN + (size_t)16384 * DM, H, 16, 36, BIG, 0, BIG, 0x0, SLW(3), nullptr, nullptr, nullptr, MTOT, nullptr, nullptr, 32, 1, 0, 0};
        JW(0, na0, na1, DM, 36 * 48, 16 * 36); JW(1, g2a, g2xa, DI, 32 * 8, 256);
        JW(2, p0, p0, DM, 36 * 32, 0); JW(3, pg, pg, 1024, 36 * 16, 0); JW(4, g2a, g2xa, DI, 32 * 8, 256);
        JW(5, h0, h1, DM, 36 * 64, 16 * 36); JW(6, g2c, g2xc, DI, 32 * 8, 256);
        JW(7, na0, na1, DM, 36 * 48, 16 * 36); JW(8, g2l, g2l, DI, 32 * 8, 0);
#undef JW
#undef SLW
    }
    {
        volatile LAS unsigned* st0 = (volatile LAS unsigned*)(lds + BAR_ST_OFF);
        if (threadIdx.x < 2) st0[threadIdx.x] = 0u;
        __syncthreads();
    }
    const XcdBarrier xbar = xcd_barrier_post((unsigned*)a0.ws, (volatile LAS unsigned*)(lds + BAR_ST_OFF));
#define SL(i) (ws + WS_S0 + (size_t)(i) * SLOT)
    const int BIG = 1 << 30;

    for (int ph = 0; ph < NPHASE; ++ph) {
        int li, op;
        if (ph == 0) { li = 0; op = OP_INIT; }
        else if (ph < 5) { li = 0; const int k = ph - 1; op = k == 0 ? OP_ROW : (k == 1 ? OP_G1 : (k == 2 ? OP_ATT : OP_G2)); }
        else if (ph < 10) { li = 1; const int k = ph - 5; op = k == 0 ? OP_ROW : (k == 1 ? OP_G1 : (k == 2 ? OP_POOL : (k == 3 ? OP_GG : OP_G2))); }
        else if (ph < 15) { li = 2; const int k = ph - 10; op = k == 0 ? OP_ROW : (k == 1 ? OP_G1 : (k == 2 ? OP_SCAN : (k == 3 ? OP_GATE : OP_G2))); }
        else if (ph < 19) { li = 3; const int k = ph - 15; op = k == 0 ? OP_ROW : (k == 1 ? OP_G1 : (k == 2 ? OP_ATT : OP_G2)); }
        else { li = 4; op = OP_FINAL; }
        const int kind = li % 3; const bool need_ctx = li < 3;
#if DBG_NL < 4
        if (li > DBG_NL || (li == DBG_NL && op != OP_ROW)) continue;
#endif
        Args a = a0;
#pragma unroll
        for (int i = 0; i < 19; ++i) LAUNDER_S(a.in[i]);
        LAUNDER_S(a.out); LAUNDER_S(a.ws);
        unsigned char* ws = a.ws;
        int tid_ = threadIdx.x; asm volatile("" : "+v"(tid_));
        const int tid = tid_, wave = __builtin_amdgcn_readfirstlane(tid >> 6), lane = tid & 63;
        const int gw = bid * NWAVES + wave, NGW = G * NWAVES;
        int gK = 0, gn0 = 0, gn1 = 0; const LAS unsigned char* jt = lds + JOB_OFF;
        if (op == OP_INIT) {
#ifdef ZERO_WS
            {
                u32x4* p = (u32x4*)(ws + WS_MOD); const size_t n16 = (WS_END - WS_MOD) / 16;
                for (size_t i = (size_t)bid * NTHR + tid; i < n16; i += (size_t)G * NTHR) p[i] = (u32x4){0u, 0u, 0u, 0u};
            }
#endif
#ifndef NO_MISC
            init_phase(a, lds, G);
            __syncthreads();
            transpose_layer(a, 0, lds, gw, NGW, wave, lane);
#ifdef PROBE_TR
            transpose_layer(a, 0, lds, gw, NGW, wave, lane);
#endif
#endif
        } else if (op == OP_ROW || op == OP_FINAL) {
#ifndef NO_MISC
            row_phase(a, li, gw, NGW, lane);
            if (li > 0 && li < 4) transpose_layer(a, li, lds, gw, NGW, wave, lane);
#ifdef PROBE_TR
            if (li > 0 && li < 4) transpose_layer(a, li, lds, gw, NGW, wave, lane);
#endif
#endif
        } else if (op == OP_ATT) {
#ifndef NO_ATTN
            attn_phase(a, li, lds, G, need_ctx ? 1 : 0);
#ifdef PROBE_ATT
            attn_phase(a, li, lds, G, need_ctx ? 1 : 0);
#endif
#endif
        } else if (op == OP_POOL) {
#ifndef NO_MISC
            pool_phase(a, G);
#endif
        } else if (op == OP_SCAN) {
#ifndef NO_SCAN
            scan_phase(a, lds, G);
#ifdef PROBE_SCAN
            scan_phase(a, lds, G);
#endif
#endif
        } else if (op == OP_GATE) {
#ifndef NO_MISC
            hgate_phase(a, G);
#endif
        } else {
            const int gi = li == 0 ? (op == OP_G1 ? 0 : 1) : (li == 1 ? (op == OP_G1 ? 2 : (op == OP_GG ? 3 : 4)) : (li == 2 ? (op == OP_G1 ? 5 : 6) : (op == OP_G1 ? 7 : 8)));
            jt = lds + JOB_OFF + gi * 256;
            gK = pg8::jl_i(jt + 96); gn0 = pg8::jl_i(jt + 100); gn1 = pg8::jl_i(jt + 104);
        }
#ifndef NO_GEMM
        if (gK) pg8::gemm_phase(lds, jt, gK, gn0, gn1, G, bid);
#ifdef PROBE_G2
        if (gK && op == OP_G2) { __syncthreads(); pg8::gemm_phase(lds, jt, gK, gn0, gn1, G, bid); }
#endif
#endif
        if (ph + 1 < NPHASE) xcd_barrier(xbar);
    }
#undef SL
}

extern "C" void kernel_launch(void* const* d_in, const int* in_sizes, int n_in, void* d_out, int out_size, void* d_ws, size_t ws_size, hipStream_t stream) {
    static int grid = 0;
    if (grid == 0) {
        if (n_in != 19 || out_size != MLAT * DM || ws_size < WS_END) { fprintf(stderr, "kernel_launch: unexpected shapes n_in %d out %d ws %zu (need %zu)\n", n_in, out_size, ws_size, (size_t)WS_END); grid = -1; return; }
        int dev = 0, cus = 0, per_cu = 0;
        (void)hipGetDevice(&dev);
        (void)hipDeviceGetAttribute(&cus, hipDeviceAttributeMultiprocessorCount, dev);
        (void)hipFuncSetAttribute((const void*)fwd_mega, hipFuncAttributeMaxDynamicSharedMemorySize, LDS_BYTES);
        (void)hipOccupancyMaxActiveBlocksPerMultiprocessor(&per_cu, (const void*)fwd_mega, NTHR, LDS_BYTES);
        fprintf(stderr, "cus %d per_cu %d ws %zu\n", cus, per_cu, ws_size);
        grid = cus > 0 ? cus : 256;
    }
    if (grid < 0) return;
    (void)hipMemsetAsync(d_ws, 0, 65536, stream);
    Args a{};
    for (int i = 0; i < 19; ++i) a.in[i] = (const float*)d_in[i];
    a.out = (float*)d_out; a.ws = (unsigned char*)d_ws;
    void* args[] = {&a};
    hipError_t e = hipLaunchCooperativeKernel((const void*)fwd_mega, dim3(grid), dim3(NTHR), args, LDS_BYTES, stream);
    if (e != hipSuccess) fprintf(stderr, "cooperative launch failed: %s (grid %d)\n", hipGetErrorString(e), grid);
}
```

```cpp
#ifndef DBG_NL
#define DBG_NL 4
#endif
#include <hip/hip_runtime.h>
#include <hip/hip_cooperative_groups.h>
#include <cstdio>
#include <cstdint>
namespace cg = cooperative_groups;

#define LAS __attribute__((address_space(3)))
#define GAS __attribute__((address_space(1)))
typedef unsigned short bf16_t;
typedef short bf16x8 __attribute__((ext_vector_type(8)));
typedef float f32x4 __attribute__((ext_vector_type(4)));
typedef unsigned u32x4 __attribute__((ext_vector_type(4)));
typedef unsigned u32x2 __attribute__((ext_vector_type(2)));

constexpr int DM = 2048, NB = 4, SEQ = 2048, CTX = 256, DI = 4096;
constexpr int MLAT = NB * SEQ, MCTX = NB * CTX, MTOT = MLAT + MCTX;
constexpr float EPS = 1e-6f;
constexpr int NTHR = 512, NWAVES = 8;
constexpr int LDS_BYTES = 147456;

constexpr size_t MiB = 1u << 20;
constexpr size_t WS_MOD = 1 * MiB;
constexpr size_t WS_LB = WS_MOD + 512 * 1024;
constexpr size_t WS_XC = 2 * MiB;
constexpr size_t WS_H = 10 * MiB;
constexpr size_t WS_WIN = 46 * MiB;
constexpr size_t WS_WOUT = 126 * MiB;
constexpr size_t WS_WG = 142 * MiB;
constexpr size_t WS_S0 = 150 * MiB;
constexpr size_t SLOT = 72 * MiB;
constexpr size_t WS_END = WS_S0 + 9 * SLOT;

typedef __bf16 bf2_t __attribute__((ext_vector_type(2)));
__device__ __forceinline__ unsigned pk2(float lo, float hi) { bf2_t v; v.x = (__bf16)lo; v.y = (__bf16)hi; return __builtin_bit_cast(unsigned, v); }
__device__ __forceinline__ float bflo(unsigned w) { return __uint_as_float(w << 16); }
__device__ __forceinline__ float bfhi(unsigned w) { return __uint_as_float(w & 0xffff0000u); }
__device__ __forceinline__ float fast_exp(float x) { return __expf(x); }
__device__ __forceinline__ float silu_f(float x) { return x * __builtin_amdgcn_rcpf(1.0f + __expf(-x)); }
__device__ __forceinline__ float wave_sum(float v) {
#pragma unroll
    for (int o = 1; o < 64; o <<= 1) v += __shfl_xor(v, o);
    return v;
}
#define LDS_WAIT() asm volatile("s_waitcnt lgkmcnt(0)" ::: "memory")
#define LAUNDER_V(x) asm volatile("" : "+v"(x))
#define LAUNDER_S(x) asm volatile("" : "+s"(x))
__device__ __forceinline__ int my_tid() { int t = threadIdx.x; LAUNDER_V(t); return t; }

namespace pg8 {
constexpr int BM = 256, BK = 64, HALF = 128, HTB = HALF * BK * 2, STAGE_BYTES = 8 * HTB, NXCD = 8, WGM = 8;
__device__ __forceinline__ int lds_byte(int r, int c) { const int st = (r >> 4) * 2 + (c >> 5), rr = r & 15, cc = c & 31, ob = rr * 64 + cc * 2; return st * 1024 + (ob ^ (((ob >> 9) & 1) << 5)); }
__device__ __forceinline__ void stage_rc(int b, int& R, int& C) { const int st = b / 1024, sb = b % 1024, swz = sb ^ (((sb >> 9) & 1) << 5); R = (st >> 1) * 16 + swz / 64; C = (st & 1) * 32 + (swz % 64) / 2; }
__device__ __forceinline__ int perm32(int rho) { const int n = rho >> 4, i = rho & 15; return 8 * (i >> 2) + 4 * n + (i & 3); }

struct Job {
    const bf16_t* A; const bf16_t* Bt; int nM, nN; int agdiv; size_t agstride;
    int segw; int acts; void* o0; void* o1; void* o2; void* o3; int ldo;
    const float* aux_f; const bf16_t* aux_b;
};
__device__ __forceinline__ void job_write(LAS unsigned char* p, const Job& J) {
    *(LAS unsigned long long*)(p + 0) = (unsigned long long)J.A; *(LAS unsigned long long*)(p + 8) = (unsigned long long)J.Bt;
    *(LAS int*)(p + 16) = J.nM; *(LAS int*)(p + 20) = J.nN; *(LAS int*)(p + 24) = J.agdiv; *(LAS int*)(p + 28) = J.ldo;
    *(LAS unsigned long long*)(p + 32) = (unsigned long long)J.agstride; *(LAS int*)(p + 40) = J.segw; *(LAS int*)(p + 44) = J.acts;
    *(LAS unsigned long long*)(p + 48) = (unsigned long long)J.o0; *(LAS unsigned long long*)(p + 56) = (unsigned long long)J.o1;
    *(LAS unsigned long long*)(p + 64) = (unsigned long long)J.o2; *(LAS unsigned long long*)(p + 72) = (unsigned long long)J.o3;
    *(LAS unsigned long long*)(p + 80) = (unsigned long long)J.aux_f; *(LAS unsigned long long*)(p + 88) = (unsigned long long)J.aux_b;
}
__device__ __forceinline__ int jl_i(const LAS unsigned char* p) { return __builtin_amdgcn_readfirstlane(*(const LAS int*)p); }
__device__ __forceinline__ unsigned long long jl_p(const LAS unsigned char* p) {
    const unsigned lo = (unsigned)__builtin_amdgcn_readfirstlane(*(const LAS int*)p), hi = (unsigned)__builtin_amdgcn_readfirstlane(*(const LAS int*)(p + 4));
    return ((unsigned long long)hi << 32) | lo;
}
struct Unit { int job, pm, pn; };

__device__ __forceinline__ void decode_tile(int l, int nM, int nN, int& pm, int& pn) {
    const int nwg = nM * nN; int wgid = l;
    { const int q = nwg / NXCD, r = nwg % NXCD, xcd = wgid % NXCD, off = wgid / NXCD; wgid = (xcd < r ? xcd * (q + 1) : r * (q + 1) + (xcd - r) * q) + off; }
    const int nig = WGM * nN, gid = wgid / nig, fm = gid * WGM, gsz = (nM - fm) < WGM ? (nM - fm) : WGM;
    pm = fm + ((wgid % nig) % gsz); pn = (wgid % nig) / gsz;
}

__device__ __forceinline__ void store_bf8(GAS bf16_t* p, const f32x4& v0, const f32x4& v1) {
    u32x4 w; w.x = pk2(v0[0], v0[1]); w.y = pk2(v0[2], v0[3]); w.z = pk2(v1[0], v1[1]); w.w = pk2(v1[2], v1[3]);
    *(GAS u32x4*)p = w;
}

__device__ __forceinline__ void epilogue(const f32x4 (&acc)[2][2][4][2], const LAS unsigned char* jt, const Unit& u, int wr, int wc, int fr_, int fq_) {
    int fr = fr_, fq = fq_; asm volatile("" : "+v"(fr), "+v"(fq));
    const LAS unsigned char* jp = jt + u.job * 128;
    const int segw = jl_i(jp + 40), acts = jl_i(jp + 44);
    const int colt = u.pn * BM; const int seg = colt / segw; const int act = (acts >> (4 * seg)) & 15;
    GAS unsigned char* op = (GAS unsigned char*)jl_p(jp + 48 + 8 * seg);
    const int col0 = colt - seg * segw + wc * 32 + 8 * fq;
    const int row0 = u.pm * BM + wr * 64 + fr;
    const int ldo = jl_i(jp + 28);
    const GAS float* aux_f = (const GAS float*)jl_p(jp + 80); const GAS bf16_t* aux_b = (const GAS bf16_t*)jl_p(jp + 88);
    if (act <= 2) {
        GAS bf16_t* O = (GAS bf16_t*)op;
#pragma unroll
        for (int ai = 0; ai < 2; ++ai)
#pragma unroll
            for (int m = 0; m < 4; ++m) {
                GAS bf16_t* rowp = O + (size_t)(row0 + ai * HALF + m * 16) * ldo + col0;
#pragma unroll
                for (int bj = 0; bj < 2; ++bj) {
                    f32x4 v0 = acc[ai][bj][m][0], v1 = acc[ai][bj][m][1];
                    if (act == 1) { v0 *= 0.08838834764831845f; v1 *= 0.08838834764831845f; }
                    if (act == 2) {
#pragma unroll
                        for (int j = 0; j < 4; ++j) { v0[j] = silu_f(v0[j]); v1[j] = silu_f(v1[j]); }
                    }
                    store_bf8(rowp + bj * HALF, v0, v1);
                }
            }
    } else if (act == 7) {
        GAS bf16_t* O = (GAS bf16_t*)op;
#pragma unroll
        for (int ai = 0; ai < 2; ++ai)
#pragma unroll
            for (int m = 0; m < 4; ++m) {
                const int token = row0 + ai * HALF + m * 16;
#pragma unroll
                for (int bj = 0; bj < 2; ++bj) {
                    const int col = col0 + bj * HALF, hd = col >> 7, d0 = col & 127;
                    store_bf8(O + ((size_t)(token >> 3) * 32 + hd) * 1024 + (d0 >> 4) * 128 + (token & 7) * 16 + ((d0 >> 3) & 1) * 8, acc[ai][bj][m][0], acc[ai][bj][m][1]);
                }
            }
    } else if (act == 8) {
        GAS bf16_t* O = (GAS bf16_t*)op;
#pragma unroll
        for (int ai = 0; ai < 2; ++ai)
#pragma unroll
            for (int m = 0; m < 4; ++m) {
                const int rr = row0 + ai * HALF + m * 16;
#pragma unroll
                for (int bj = 0; bj < 2; ++bj) {
                    const int t0 = col0 + bj * HALF;
                    store_bf8(O + ((size_t)(t0 >> 3) * 32 + (rr >> 7)) * 1024 + (rr & 127) * 8, acc[ai][bj][m][0], acc[ai][bj][m][1]);
                }
            }
    } else if (act == 3 || act == 4) {
        GAS float* O = (GAS float*)op;
        const GAS float* lbp = aux_f + (act - 3) * 4096 + col0;
#pragma unroll
        for (int bj = 0; bj < 2; ++bj) {
            const f32x4 l0 = *(const GAS f32x4*)(lbp + bj * HALF), l1 = *(const GAS f32x4*)(lbp + bj * HALF + 4);
#pragma unroll
            for (int ai = 0; ai < 2; ++ai)
#pragma unroll
                for (int m = 0; m < 4; ++m) {
                    GAS float* rowp = O + (size_t)(row0 + ai * HALF + m * 16) * ldo + col0 + bj * HALF;
                    f32x4 v0 = acc[ai][bj][m][0], v1 = acc[ai][bj][m][1];
#pragma unroll
                    for (int j = 0; j < 4; ++j) {
                        const float s0 = __builtin_amdgcn_rcpf(1.0f + __expf(-v0[j])), s1 = __builtin_amdgcn_rcpf(1.0f + __expf(-v1[j]));
                        v0[j] = __logf(l0[j] + (1.0f - l0[j]) * s0); v1[j] = __logf(l1[j] + (1.0f - l1[j]) * s1);
                    }
                    *(GAS f32x4*)rowp = v0; *(GAS f32x4*)(rowp + 4) = v1;
                }
        }
    } else if (act == 5) {
        GAS float* O = (GAS float*)op;
#pragma unroll
        for (int ai = 0; ai < 2; ++ai)
#pragma unroll
            for (int m = 0; m < 4; ++m) {
                GAS float* rowp = O + (size_t)(row0 + ai * HALF + m * 16) * ldo + col0;
#pragma unroll
                for (int bj = 0; bj < 2; ++bj) { *(GAS f32x4*)(rowp + bj * HALF) = acc[ai][bj][m][0]; *(GAS f32x4*)(rowp + bj * HALF + 4) = acc[ai][bj][m][1]; }
            }
    } else {
        GAS bf16_t* O = (GAS bf16_t*)op;
#pragma unroll
        for (int bj = 0; bj < 2; ++bj) {
            const f32x4 s0 = *(const GAS f32x4*)(aux_f + col0 + bj * HALF), s1 = *(const GAS f32x4*)(aux_f + col0 + bj * HALF + 4);
#pragma unroll
            for (int ai = 0; ai < 2; ++ai)
#pragma unroll
                for (int m = 0; m < 4; ++m) {
                    const size_t off = (size_t)(row0 + ai * HALF + m * 16) * ldo + col0 + bj * HALF;
                    const u32x4 z = *(const GAS u32x4*)(aux_b + off);
                    f32x4 v0 = acc[ai][bj][m][0] * s0, v1 = acc[ai][bj][m][1] * s1;
                    v0[0] *= bflo(z.x); v0[1] *= bfhi(z.x); v0[2] *= bflo(z.y); v0[3] *= bfhi(z.y);
                    v1[0] *= bflo(z.z); v1[1] *= bfhi(z.z); v1[2] *= bflo(z.w); v1[3] *= bfhi(z.w);
                    store_bf8(O + off, v0, v1);
                }
        }
    }
}

__device__ __forceinline__ bool next_unit(int i, int G, int c, const LAS unsigned char* jt, int n0, int n1, Unit& u) {
    const int L = i * G + c; if (L >= n0 + n1) return false;
    const int job = L < n0 ? 0 : 1; const LAS unsigned char* jp = jt + job * 128;
    u.job = job; decode_tile(job ? L - n0 : L, jl_i(jp + 16), jl_i(jp + 20), u.pm, u.pn);
    return true;
}
__device__ __forceinline__ const char* unit_a(const LAS unsigned char* jt, const Unit& u, size_t tstep) {
    const LAS unsigned char* jp = jt + u.job * 128;
    return (const char*)jl_p(jp + 0) + (size_t)(u.pn / jl_i(jp + 24)) * jl_p(jp + 32) * 2 + (size_t)u.pm * tstep;
}
__device__ __forceinline__ const char* unit_b(const LAS unsigned char* jt, const Unit& u, size_t tstep) {
    const LAS unsigned char* jp = jt + u.job * 128;
    return (const char*)jl_p(jp + 8) + (size_t)u.pn * tstep;
}

__device__ __forceinline__ void gemm_phase(LAS unsigned char* lds, const LAS unsigned char* jt, const int K, const int n0, const int n1, const int G, const int c) {
    int tid_ = threadIdx.x; asm volatile("" : "+v"(tid_));
    const int tid = tid_, wid = __builtin_amdgcn_readfirstlane(tid >> 6), lane = tid & 63, wr = wid >> 2, wc = wid & 3, fr = lane & 15, fq = lane >> 4;
    const int nt = K / BK;
    unsigned voffA[2], voffB[2];
#pragma unroll
    for (int i = 0; i < 2; ++i) { int R, C; stage_rc(tid * 16 + i * 8192, R, C); const int Rb = (R & ~31) + perm32(R & 31);
        voffA[i] = (unsigned)(R * K + C) * 2u; voffB[i] = (unsigned)(Rb * K + C) * 2u; }
    const size_t kstep = (size_t)(BK * 2);
    const size_t hstep = (size_t)HALF * K * 2;
    const size_t tstep = 2 * hstep;
    const unsigned ldsw = (unsigned)wid * 1024u;
    const int aoff = lds_byte(wr * 64 + fr, fq * 8), boff = lds_byte(wc * 32 + fr, fq * 8);
#define PG8_SA(b, h) (((b) * 2 + (h)) * HTB)
#define PG8_SB(b, h) ((4 + (b) * 2 + (h)) * HTB)
#define PG8_STAGE(bufoff, gbase, voff) do { _Pragma("unroll") for (int _i = 0; _i < 2; ++_i) \
        __builtin_amdgcn_global_load_lds((const unsigned*)((const char*)(gbase) + (voff)[_i]), (LAS unsigned*)(lds + (bufoff) + ldsw + _i * 8192), 16, 0, 0); } while (0)
#define PG8_LDA(dst, b, h) do { _Pragma("unroll") for (int m = 0; m < 4; ++m) _Pragma("unroll") for (int k = 0; k < 2; ++k) dst[m][k] = *(const LAS bf16x8*)(lds + PG8_SA(b, h) + aoff + m * 2048 + k * 1024); } while (0)
#define PG8_LDB(dst, b, h) do { _Pragma("unroll") for (int n = 0; n < 2; ++n) _Pragma("unroll") for (int k = 0; k < 2; ++k) dst[n][k] = *(const LAS bf16x8*)(lds + PG8_SB(b, h) + boff + n * 2048 + k * 1024); } while (0)
#define PG8_MMA(ai, bj, At, Bt) do { __builtin_amdgcn_s_setprio(1); _Pragma("unroll") for (int m = 0; m < 4; ++m) _Pragma("unroll") for (int n = 0; n < 2; ++n) _Pragma("unroll") for (int k = 0; k < 2; ++k) \
        acc[ai][bj][m][n] = __builtin_amdgcn_mfma_f32_16x16x32_bf16(Bt[n][k], At[m][k], acc[ai][bj][m][n], 0, 0, 0); __builtin_amdgcn_s_setprio(0); } while (0)
#define PG8_WAIT_V(n) asm volatile("s_waitcnt vmcnt(" #n ")" ::: "memory")
#define PG8_WAIT_L(n) asm volatile("s_waitcnt lgkmcnt(" #n ")" ::: "memory")
#define PG8_BAR __builtin_amdgcn_s_barrier()
#define PG8_SCHED __builtin_amdgcn_sched_barrier(0)
#define PG8_UA(u) unit_a(jt, (u), tstep)
#define PG8_UB(u) unit_b(jt, (u), tstep)
    Unit cur, nxt; int ui = 0;
    if (!next_unit(0, G, c, jt, n0, n1, cur)) return;
    f32x4 acc[2][2][4][2];
#pragma unroll
    for (int a = 0; a < 2; ++a)
#pragma unroll
        for (int b = 0; b < 2; ++b)
#pragma unroll
            for (int m = 0; m < 4; ++m)
#pragma unroll
                for (int n = 0; n < 2; ++n) acc[a][b][m][n] = (f32x4){0.f, 0.f, 0.f, 0.f};
    bf16x8 At[4][2], B0[2][2], B1[2][2];
    const char* cA = PG8_UA(cur); const char* cB = PG8_UB(cur);
    PG8_STAGE(PG8_SB(0, 0), cB, voffB); PG8_STAGE(PG8_SB(0, 1), cB + hstep, voffB); PG8_STAGE(PG8_SA(0, 0), cA, voffA); PG8_STAGE(PG8_SA(0, 1), cA + hstep, voffA);
    if (wr == 1) PG8_BAR;
    PG8_WAIT_V(2); PG8_BAR;
    PG8_STAGE(PG8_SB(1, 0), cB + kstep, voffB); PG8_STAGE(PG8_SA(1, 0), cA + kstep, voffA); PG8_STAGE(PG8_SB(1, 1), cB + hstep + kstep, voffB);
    PG8_WAIT_V(6); PG8_BAR;
    for (;;) {
        const bool has_next = next_unit(ui + 1, G, c, jt, n0, n1, nxt);
        const char* nA = cA; const char* nB = cB;
        if (has_next) { nA = PG8_UA(nxt); nB = PG8_UB(nxt); }
        for (int t = 0; t < nt; t += 2) {
            const bool last = (t == nt - 2);
            const char* a1 = cA + (size_t)(t + 1) * kstep;
            const char* a2 = last ? nA : cA + (size_t)(t + 2) * kstep; const char* b2 = last ? nB : cB + (size_t)(t + 2) * kstep;
            const char* a3 = a2 + kstep; const char* b3 = b2 + kstep;
            PG8_LDB(B0, 0, 0); PG8_LDB(B1, 0, 1); PG8_SCHED; PG8_LDA(At, 0, 0); PG8_STAGE(PG8_SA(1, 1), a1 + hstep, voffA);
            PG8_WAIT_V(8); PG8_WAIT_L(0); PG8_BAR; PG8_MMA(0, 0, At, B0); PG8_MMA(0, 1, At, B1); PG8_BAR; PG8_SCHED;
            PG8_LDA(At, 0, 1); PG8_STAGE(PG8_SB(0, 0), b2, voffB); PG8_STAGE(PG8_SB(0, 1), b2 + hstep, voffB); PG8_STAGE(PG8_SA(0, 0), a2, voffA);
            PG8_WAIT_V(8); PG8_WAIT_L(0); PG8_BAR; PG8_MMA(1, 0, At, B0); PG8_MMA(1, 1, At, B1); PG8_BAR; PG8_SCHED;
            PG8_LDB(B0, 1, 0); PG8_LDB(B1, 1, 1); PG8_SCHED; PG8_LDA(At, 1, 0); PG8_STAGE(PG8_SA(0, 1), a2 + hstep, voffA);
            PG8_WAIT_V(8); PG8_WAIT_L(0); PG8_BAR; PG8_MMA(0, 0, At, B0); PG8_MMA(0, 1, At, B1); PG8_BAR; PG8_SCHED;
            PG8_LDA(At, 1, 1); PG8_STAGE(PG8_SB(1, 0), b3, voffB); PG8_STAGE(PG8_SB(1, 1), b3 + hstep, voffB); PG8_STAGE(PG8_SA(1, 0), a3, voffA);
            PG8_WAIT_V(8); PG8_WAIT_L(0); PG8_BAR; PG8_MMA(1, 0, At, B0); PG8_MMA(1, 1, At, B1); PG8_BAR; PG8_SCHED;
        }
        if (wr == 0) PG8_BAR;
        epilogue(acc, jt, cur, wr, wc, fr, fq);
        if (!has_next) break;
#pragma unroll
        for (int a = 0; a < 2; ++a)
#pragma unroll
            for (int b = 0; b < 2; ++b)
#pragma unroll
                for (int m = 0; m < 4; ++m)
#pragma unroll
                    for (int n = 0; n < 2; ++n) acc[a][b][m][n] = (f32x4){0.f, 0.f, 0.f, 0.f};
        cur = nxt; cA = nA; cB = nB; ++ui;
        if (wr == 1) PG8_BAR;
    }
    PG8_WAIT_V(0);
    PG8_BAR;
#undef PG8_SA
#undef PG8_SB
#undef PG8_STAGE
#undef PG8_LDA
#undef PG8_LDB
#undef PG8_MMA
#undef PG8_WAIT_V
#undef PG8_WAIT_L
#undef PG8_BAR
#undef PG8_SCHED
#undef PG8_UA
#undef PG8_UB
}
}

struct Args {
    const float* in[19]; float* out; unsigned char* ws;
};

__device__ __forceinline__ void tr_item(const float* __restrict__ W, int K, int N, bf16_t* WT, int segperm, LAS float* scr, int item, int lane) {
    const int nblk = N >> 6, kb = item / nblk, nb = item - kb * nblk, k0 = kb << 6, n0 = nb << 6;
    const float* src = W + (size_t)k0 * N + n0 + lane;
#pragma unroll 16
    for (int i = 0; i < 64; ++i) scr[i * 65 + lane] = src[(size_t)i * N];
    LDS_WAIT();
    const int seg = n0 >> 12, dseg = (segperm >> (4 * seg)) & 15, drow0 = n0 + (dseg - seg) * 4096;
    const int c = lane & 7;
#pragma unroll
    for (int j = 0; j < 8; ++j) {
        const int n = (lane >> 3) + 8 * j; const LAS float* s = scr + (8 * c) * 65 + n;
        u32x4 o; o.x = pk2(s[0], s[65]); o.y = pk2(s[130], s[195]); o.z = pk2(s[260], s[325]); o.w = pk2(s[390], s[455]);
        *(u32x4*)(WT + (size_t)(drow0 + n) * K + k0 + 8 * c) = o;
    }
    LDS_WAIT();
}

__device__ __forceinline__ void transpose_layer(const Args& a, int layer, LAS unsigned char* lds, int gw, int NGW, int wave, int lane) {
    LAS float* scr = (LAS float*)(lds + wave * 16640);
    bf16_t* WIN = (bf16_t*)(a.ws + WS_WIN); bf16_t* WOUT = (bf16_t*)(a.ws + WS_WOUT); bf16_t* WG = (bf16_t*)(a.ws + WS_WG);
    const int kind = layer % 3, j = layer / 3;
    if (kind == 0) {
        const float* win = a.in[8] + (size_t)j * DM * 16384; const float* wout = a.in[10] + (size_t)j * DI * DM;
        const int n_in = (DM / 64) * (16384 / 64), n_out = (DI / 64) * (DM / 64);
        for (int it = gw; it < n_in + n_out; it += NGW) {
            if (it < n_in) tr_item(win, DM, 16384, WIN, 0x2310, scr, it, lane);
            else tr_item(wout, DI, DM, WOUT, 0x43210, scr, it - n_in, lane);
        }
    } else if (kind == 1) {
        const float* win = a.in[11]; const float* wg = a.in[12]; const float* wout = a.in[14];
        const int n_in = (DM / 64) * (8192 / 64), n_g = 16 * 16, n_out = (DI / 64) * (DM / 64);
        for (int it = gw; it < n_in + 4 * n_g + n_out; it += NGW) {
            if (it < n_in) tr_item(win, DM, 8192, WIN, 0x43210, scr, it, lane);
            else if (it < n_in + 4 * n_g) { const int g = (it - n_in) / n_g, r = (it - n_in) % n_g; tr_item(wg + (size_t)g * 1024 * 1024, 1024, 1024, WG + (size_t)g * 1024 * 1024, 0x43210, scr, r, lane); }
            else tr_item(wout, DI, DM, WOUT, 0x43210, scr, it - n_in - 4 * n_g, lane);
        }
    } else {
        const float* win = a.in[15]; const float* wout = a.in[18];
        const int n_in = (DM / 64) * (20480 / 64), n_out = (DI / 64) * (DM / 64);
        for (int it = gw; it < n_in + n_out; it += NGW) {
            if (it < n_in) tr_item(win, DM, 20480, WIN, 0x34210, scr, it, lane);
            else tr_item(wout, DI, DM, WOUT, 0x43210, scr, it - n_in, lane);
        }
    }
}

__device__ __forceinline__ void row_phase(const Args& a, int li, int gw, int NGW, int lane) {
    const float* MOD = (const float*)(a.ws + WS_MOD);
    float* XC = (float*)(a.ws + WS_XC); bf16_t* H = (bf16_t*)(a.ws + WS_H);
    const bf16_t* Y = (const bf16_t*)(a.ws + WS_S0 + 5 * SLOT);
    const int nrows = (li == 4) ? MLAT : MTOT;
    for (int row = gw; row < nrows; row += NGW) {
        const bool lat = row < MLAT;
        const int mr = lat ? (row >> 11) : 4;
        float* xrow = lat ? a.out + (size_t)row * DM : XC + (size_t)(row - MLAT) * DM;
        f32x4 xv[8];
        if (li == 0) {
            const float* src = lat ? a.in[0] + (size_t)row * DM : a.in[2] + (size_t)(row - MLAT) * DM;
#pragma unroll
            for (int j = 0; j < 8; ++j) xv[j] = *(const f32x4*)(src + 4 * lane + 256 * j);
#pragma unroll
            for (int j = 0; j < 8; ++j) *(f32x4*)(xrow + 4 * lane + 256 * j) = xv[j];
        } else {
            const bool upd = !(li == 4 && !lat);
#pragma unroll
            for (int j = 0; j < 8; ++j) xv[j] = *(const f32x4*)(xrow + 4 * lane + 256 * j);
            if (upd) {
                const bf16_t* yrow = Y + (size_t)row * DM;
                const float* gate = MOD + (size_t)((li - 1) * 5 + mr) * 6144 + 4096;
                const float* gpost = a.in[7] + (size_t)(li - 1) * DM;
                f32x4 yv[8]; float ss = 0.f;
#pragma unroll
                for (int j = 0; j < 8; ++j) { const u32x2 yw = *(const u32x2*)(yrow + 4 * lane + 256 * j); yv[j] = (f32x4){bflo(yw.x), bfhi(yw.x), bflo(yw.y), bfhi(yw.y)}; ss += (yv[j].x * yv[j].x + yv[j].y * yv[j].y) + (yv[j].z * yv[j].z + yv[j].w * yv[j].w); }
                const float rstd = rsqrtf(wave_sum(ss) * (1.0f / DM) + EPS);
#pragma unroll
                for (int j = 0; j < 8; ++j) {
                    const f32x4 g = *(const f32x4*)(gate + 4 * lane + 256 * j), gp = *(const f32x4*)(gpost + 4 * lane + 256 * j);
                    xv[j] += g * (yv[j] * rstd * gp);
                    *(f32x4*)(xrow + 4 * lane + 256 * j) = xv[j];
                }
            }
        }
        if (li < 4) {
            float ss = 0.f;
#pragma unroll
            for (int j = 0; j < 8; ++j) ss += (xv[j].x * xv[j].x + xv[j].y * xv[j].y) + (xv[j].z * xv[j].z + xv[j].w * xv[j].w);
            const float rstd = rsqrtf(wave_sum(ss) * (1.0f / DM) + EPS);
            const float* shift = MOD + (size_t)(li * 5 + mr) * 6144; const float* scale = shift + 2048;
            const float* gpre = a.in[6] + (size_t)li * DM;
            bf16_t* hrow = H + (size_t)row * DM;
#pragma unroll
            for (int j = 0; j < 8; ++j) {
                const f32x4 sh = *(const f32x4*)(shift + 4 * lane + 256 * j), sc = *(const f32x4*)(scale + 4 * lane + 256 * j), gp = *(const f32x4*)(gpre + 4 * lane + 256 * j);
                const f32x4 hv = (xv[j] * rstd * gp) * (1.0f + sc) + sh;
                u32x2 w; w.x = pk2(hv.x, hv.y); w.y = pk2(hv.z, hv.w);
                *(u32x2*)(hrow + 4 * lane + 256 * j) = w;
            }
        }
    }
}

__device__ __forceinline__ void init_phase(const Args& a, LAS unsigned char* lds, int G) {
    LAS float* sc = (LAS float*)lds;
    LAS float* red = sc + 5 * 2048;
    const int tid = my_tid();
    float* MOD = (float*)(a.ws + WS_MOD); float* LB = (float*)(a.ws + WS_LB);
    for (int e = tid; e < 5 * 2048; e += NTHR) { const int r = e >> 11, k = e & 2047; const float v = r < 4 ? a.in[1][r * 2048 + k] : a.in[3][k]; sc[e] = silu_f(v); }
    __syncthreads();
    for (int item = blockIdx.x; item < 384; item += G) {
        const int layer = item / 96, n0 = (item % 96) * 64, ks = tid >> 6, nn = tid & 63;
        float acc0 = 0.f, acc1 = 0.f, acc2 = 0.f, acc3 = 0.f, acc4 = 0.f;
        const float* wp = a.in[4] + ((size_t)layer * 2048 + ks * 256) * 6144 + n0 + nn;
        const LAS float* sp = sc + ks * 256;
#pragma unroll 32
        for (int kk = 0; kk < 256; ++kk) {
            const float w = wp[(size_t)kk * 6144];
            acc0 += sp[kk] * w; acc1 += sp[2048 + kk] * w; acc2 += sp[4096 + kk] * w; acc3 += sp[6144 + kk] * w; acc4 += sp[8192 + kk] * w;
        }
        red[(ks * 5 + 0) * 64 + nn] = acc0; red[(ks * 5 + 1) * 64 + nn] = acc1; red[(ks * 5 + 2) * 64 + nn] = acc2; red[(ks * 5 + 3) * 64 + nn] = acc3; red[(ks * 5 + 4) * 64 + nn] = acc4;
        __syncthreads();
        if (tid < 320) {
            const int r = tid >> 6, n2 = tid & 63; float s = 0.f;
#pragma unroll
            for (int k8 = 0; k8 < 8; ++k8) s += red[(k8 * 5 + r) * 64 + n2];
            MOD[(size_t)(layer * 5 + r) * 6144 + n0 + n2] = s + a.in[5][layer * 6144 + n0 + n2];
        }
        __syncthreads();
    }
    const int gt = blockIdx.x * NTHR + tid;
    if (gt < 2 * 4096) {
        const int d = gt >> 12, f = gt & 4095; const float* p = a.in[16] + (size_t)d * 4 * 4096 + f;
        const float l0 = p[0], l1 = p[4096], l2 = p[8192], l3 = p[12288];
        const float mx = fmaxf(fmaxf(l0, l1), fmaxf(l2, l3));
        const float e0 = expf(l0 - mx), e1 = expf(l1 - mx), e2 = expf(l2 - mx), e3 = expf(l3 - mx);
        LB[gt] = (e1 + e2) / (e0 + e1 + e2 + e3);
    }
}

typedef float f32x16 __attribute__((ext_vector_type(16)));
__device__ __forceinline__ void attn_phase(const Args& a, int layer, LAS unsigned char* lds, int G, int need_ctx) {
    const int tid = my_tid(), wave = __builtin_amdgcn_readfirstlane(tid >> 6), lane = tid & 63, q = lane & 31, hh = lane >> 5;
    const bf16_t* Q = (const bf16_t*)(a.ws + WS_S0); const bf16_t* Kp = (const bf16_t*)(a.ws + WS_S0 + SLOT);
    const bf16_t* SZ = (const bf16_t*)(a.ws + WS_S0 + 2 * SLOT); const bf16_t* Vt = (const bf16_t*)(a.ws + WS_S0 + 3 * SLOT);
    bf16_t* GT = (bf16_t*)(a.ws + WS_S0 + 4 * SLOT);
    const float* rpb = a.in[9] + (size_t)(layer / 3) * 32 * 465;
    LAS float* rp = (LAS float*)(lds + wave * 2048);
    const int gw = blockIdx.x * NWAVES + wave, NGW = G * NWAVES;
    const int nlat = 8192, ntask = nlat + (need_ctx ? 1024 : 0);
    const int sig = (q & 19) | ((q & 8) >> 1) | ((q & 4) << 1);
    for (int task = gw; task < ntask; task += NGW) {
        const bool lat = task < nlat;
        int b, h, r = 0, j = 0, qtok;
        if (lat) { j = task & 3; r = 2 * ((task >> 2) & 15); h = (task >> 6) & 31; b = task >> 11; qtok = b * SEQ + (r + (q >> 4)) * 64 + 16 * j + (q & 15); }
        else { const int t2 = task - nlat; h = (t2 >> 3) & 31; b = t2 >> 8; qtok = MLAT + b * CTX + 32 * (t2 & 7) + q; }
        bf16x8 qf[8];
#pragma unroll
        for (int c = 0; c < 8; ++c) qf[c] = *(const bf16x8*)(Q + (size_t)qtok * DI + h * 128 + 16 * c + 8 * hh);
        if (lat) {
            LDS_WAIT();
            for (int e = lane; e < 465; e += 64) rp[e] = rpb[h * 465 + e];
            LDS_WAIT();
        }
        const int r0a = min(max(r - 4, 0), 24), r0b = min(max(r - 3, 0), 24), nband = lat ? (r0b + 8 - r0a) : 0;
        const int qr = r + (q >> 4), myr0 = (q >> 4) ? r0b : r0a;
        const int cw = min(max(16 * j - 8, 0), 32), qcol = 16 * j + (q & 15), c0 = min(max(qcol - 8, 0), 48);
        const int nst = nband + 8;
        const int kb_lat = b * SEQ + r0a * 64 + cw, kb_ctx = MLAT + b * CTX;
        const bf16_t* kbase = Kp + (size_t)h * 1024 + (size_t)(sig >> 3) * 32768 + (sig & 7) * 16 + 8 * hh;
        const bf16_t* vbase = Vt + (size_t)h * 1024 + (size_t)hh * 32768 + q * 8;
        float m_run = -1e30f, l_run = 0.f;
        f32x16 OT[4];
#pragma unroll
        for (int d = 0; d < 4; ++d)
#pragma unroll
            for (int t = 0; t < 16; ++t) OT[d][t] = 0.f;
        bf16x8 kreg[8], vreg[8];
        { const int kb0 = nband ? kb_lat : kb_ctx;
#pragma unroll
          for (int c = 0; c < 8; ++c) kreg[c] = *(const bf16x8*)(kbase + (size_t)(kb0 >> 3) * 32768 + 128 * c); }
        for (int st = 0; st < nst; ++st) {
            const bool isl = st < nband;
            const int keybase = isl ? kb_lat + st * 64 : kb_ctx + 32 * (st - nband);
#pragma unroll
            for (int d = 0; d < 4; ++d)
#pragma unroll
                for (int s2 = 0; s2 < 2; ++s2) vreg[d * 2 + s2] = *(const bf16x8*)(vbase + (size_t)(keybase >> 3) * 32768 + s2 * 65536 + d * 256);
            f32x16 sc;
#pragma unroll
            for (int t = 0; t < 16; ++t) sc[t] = 0.f;
#pragma unroll
            for (int c = 0; c < 8; ++c) sc = __builtin_amdgcn_mfma_f32_32x32x16_bf16(kreg[c], qf[c], sc, 0, 0, 0);
            if (st + 1 < nst) {
                const int kn = (st + 1 < nband) ? kb_lat + (st + 1) * 64 : kb_ctx + 32 * (st + 1 - nband);
#pragma unroll
                for (int c = 0; c < 8; ++c) kreg[c] = *(const bf16x8*)(kbase + (size_t)(kn >> 3) * 32768 + 128 * c);
            }
            if (isl) {
                const int kr = r0a + st; const bool rowok = (kr >= myr0) && (kr < myr0 + 8);
                const int brow = (kr - qr + 7) * 31 - qcol + 15;
#pragma unroll
                for (int t = 0; t < 16; ++t) {
                    const int kc = cw + 16 * (t >> 3) + 8 * hh + (t & 7); const bool valid = rowok && (kc >= c0) && (kc < c0 + 16);
                    const float bias = rp[valid ? (brow + kc) : 0];
                    sc[t] = valid ? sc[t] + bias : -3.0e38f;
                }
            }
            float mx = sc[0];
#pragma unroll
            for (int t = 1; t < 16; ++t) mx = fmaxf(mx, sc[t]);
            mx = fmaxf(mx, __shfl_xor(mx, 32));
            const float m_new = fmaxf(m_run, mx), alpha = __expf(m_run - m_new);
            float rs = 0.f;
#pragma unroll
            for (int t = 0; t < 16; ++t) { sc[t] = __expf(sc[t] - m_new); rs += sc[t]; }
            rs += __shfl_xor(rs, 32);
            l_run = l_run * alpha + rs; m_run = m_new;
            union { u32x4 u; bf16x8 v; } P0, P1;
            P0.u.x = pk2(sc[0], sc[1]); P0.u.y = pk2(sc[2], sc[3]); P0.u.z = pk2(sc[4], sc[5]); P0.u.w = pk2(sc[6], sc[7]);
            P1.u.x = pk2(sc[8], sc[9]); P1.u.y = pk2(sc[10], sc[11]); P1.u.z = pk2(sc[12], sc[13]); P1.u.w = pk2(sc[14], sc[15]);
#pragma unroll
            for (int d = 0; d < 4; ++d) {
#pragma unroll
                for (int t = 0; t < 16; ++t) OT[d][t] *= alpha;
                OT[d] = __builtin_amdgcn_mfma_f32_32x32x16_bf16(vreg[d * 2 + 0], P0.v, OT[d], 0, 0, 0);
                OT[d] = __builtin_amdgcn_mfma_f32_32x32x16_bf16(vreg[d * 2 + 1], P1.v, OT[d], 0, 0, 0);
            }
        }
        const float inv = 1.0f / l_run;
        const size_t obase = (size_t)qtok * DI + h * 128 + 4 * hh;
#pragma unroll
        for (int d = 0; d < 4; ++d)
#pragma unroll
            for (int g4 = 0; g4 < 4; ++g4) {
                const size_t o = obase + 32 * d + 8 * g4;
                const u32x2 z = *(const u32x2*)(SZ + o);
                u32x2 w; w.x = pk2(OT[d][4 * g4 + 0] * inv * bflo(z.x), OT[d][4 * g4 + 1] * inv * bfhi(z.x)); w.y = pk2(OT[d][4 * g4 + 2] * inv * bflo(z.y), OT[d][4 * g4 + 3] * inv * bfhi(z.y));
                *(u32x2*)(GT + o) = w;
            }
    }
}

__device__ __forceinline__ void pool_phase(const Args& a, int G) {
    const bf16_t* U = (const bf16_t*)(a.ws + WS_S0); bf16_t* Pg = (bf16_t*)(a.ws + WS_S0 + SLOT);
    const int gt = blockIdx.x * NTHR + my_tid(), gsz = G * NTHR;
    for (int idx = gt; idx < MTOT * 512; idx += gsz) {
        const int row = idx >> 9, cv = idx & 511, col = cv * 8, g = col >> 10, hw = 1 << g;
        int t, T, base;
        if (row < MLAT) { t = row & 2047; T = SEQ; base = row - t; } else { const int r2 = row - MLAT; t = r2 & 255; T = CTX; base = row - t; }
        const int lo = max(t - hw, 0), hi = min(t + hw, T);
        float acc[8];
#pragma unroll
        for (int e = 0; e < 8; ++e) acc[e] = 0.f;
        for (int tt = lo; tt < hi; ++tt) {
            const u32x4 v = *(const u32x4*)(U + (size_t)(base + tt) * DI + col);
            acc[0] += bflo(v.x); acc[1] += bfhi(v.x); acc[2] += bflo(v.y); acc[3] += bfhi(v.y); acc[4] += bflo(v.z); acc[5] += bfhi(v.z); acc[6] += bflo(v.w); acc[7] += bfhi(v.w);
        }
        const float ic = 1.0f / (float)(hi - lo);
        const u32x4 c = *(const u32x4*)(U + (size_t)row * DI + col);
        u32x4 o; o.x = pk2(acc[0] * ic - bflo(c.x), acc[1] * ic - bfhi(c.x)); o.y = pk2(acc[2] * ic - bflo(c.y), acc[3] * ic - bfhi(c.y));
        o.z = pk2(acc[4] * ic - bflo(c.z), acc[5] * ic - bfhi(c.z)); o.w = pk2(acc[6] * ic - bflo(c.w), acc[7] * ic - bfhi(c.w));
        *(u32x4*)(Pg + ((size_t)g * MTOT + row) * 1024 + (col & 1023)) = o;
    }
}

__device__ __forceinline__ void hgate_phase(const Args& a, int G) {
    const bf16_t* Of = (const bf16_t*)(a.ws + WS_S0 + SLOT); const bf16_t* Ob = (const bf16_t*)(a.ws + WS_S0 + 4 * SLOT);
    const bf16_t* SZ = (const bf16_t*)(a.ws + WS_S0 + 2 * SLOT); bf16_t* GT = (bf16_t*)(a.ws + WS_S0);
    const float* gn = a.in[17];
    const int gt = blockIdx.x * NTHR + my_tid(), gsz = G * NTHR;
    for (int idx = gt; idx < MTOT * 512; idx += gsz) {
        const int row = idx >> 9, col = (idx & 511) * 8; const size_t off = (size_t)row * DI + col;
        const u32x4 f = *(const u32x4*)(Of + off), bk = *(const u32x4*)(Ob + off), z = *(const u32x4*)(SZ + off);
        float o[8];
        o[0] = bflo(f.x) + bflo(bk.x); o[1] = bfhi(f.x) + bfhi(bk.x); o[2] = bflo(f.y) + bflo(bk.y); o[3] = bfhi(f.y) + bfhi(bk.y);
        o[4] = bflo(f.z) + bflo(bk.z); o[5] = bfhi(f.z) + bfhi(bk.z); o[6] = bflo(f.w) + bflo(bk.w); o[7] = bfhi(f.w) + bfhi(bk.w);
        float ss = 0.f;
#pragma unroll
        for (int e = 0; e < 8; ++e) ss += o[e] * o[e];
        ss += __shfl_xor(ss, 1); ss += __shfl_xor(ss, 2); ss += __shfl_xor(ss, 4); ss += __shfl_xor(ss, 8);
        const float rstd = rsqrtf(ss * (1.0f / 128.0f) + EPS);
        const f32x4 g0 = *(const f32x4*)(gn + col), g1 = *(const f32x4*)(gn + col + 4);
        u32x4 w;
        w.x = pk2(o[0] * rstd * g0.x * bflo(z.x), o[1] * rstd * g0.y * bfhi(z.x)); w.y = pk2(o[2] * rstd * g0.z * bflo(z.y), o[3] * rstd * g0.w * bfhi(z.y));
        w.z = pk2(o[4] * rstd * g1.x * bflo(z.z), o[5] * rstd * g1.y * bfhi(z.z)); w.w = pk2(o[6] * rstd * g1.z * bflo(z.w), o[7] * rstd * g1.w * bfhi(z.w));
        *(u32x4*)(GT + off) = w;
    }
}

constexpr int SC_QT = 0, SC_KT = 8704, SC_KH = 17408, SC_DEC = 27648, SC_BUF = 28160, SC_TOT = 2 * SC_BUF;
struct ScanRaw { float lf[8]; unsigned short qs[8]; };

__device__ __forceinline__ void scan_chunk_t0(int cj, int b, int dir, int& t0) {
    const bool isctx = cj < 8;
    const int cc = isctx ? (dir ? 7 - cj : cj) : (dir ? 71 - cj : cj - 8);
    t0 = isctx ? MLAT + b * CTX + 32 * cc : b * SEQ + 32 * cc;
}

__device__ __forceinline__ void scan_phase(const Args& a, LAS unsigned char* lds, int G) {
    const int tid = my_tid(), wave = tid >> 6, lane = tid & 63, fr = lane & 15, fq = lane >> 4;
    const bf16_t* QS = (const bf16_t*)(a.ws + WS_S0); const bf16_t* Vt = (const bf16_t*)(a.ws + WS_S0 + 3 * SLOT);
    const int kch = tid & 127, part = tid >> 7;
    for (int sidx = blockIdx.x; sidx < 256; sidx += G) {
        const int dir = sidx & 1, h = (sidx >> 1) & 31, b = sidx >> 6;
        const float* LF = (const float*)(a.ws + WS_S0 + (dir ? 7 : 5) * SLOT);
        bf16_t* O = (bf16_t*)(a.ws + WS_S0 + (dir ? 4 : 1) * SLOT);
        f32x4 S[8];
#pragma unroll
        for (int k = 0; k < 8; ++k) S[k] = (f32x4){0.f, 0.f, 0.f, 0.f};
        float rlf[8]; unsigned short rqs[8]; bf16x8 vfn;
#define SCAN_RAW(cj) do { int _t0; scan_chunk_t0((cj), b, dir, _t0); \
        _Pragma("unroll") for (int e = 0; e < 8; ++e) { const int tau = 8 * part + e; const int tok = dir ? _t0 + 31 - tau : _t0 + tau; \
            rlf[e] = LF[(size_t)tok * DI + h * 128 + kch]; rqs[e] = QS[(size_t)tok * DI + h * 128 + kch]; } \
        vfn = *(const bf16x8*)(Vt + (size_t)(h * 128 + 16 * wave + fr) * MTOT + (dir ? _t0 + 24 - 8 * fq : _t0 + 8 * fq)); } while (0)
#define SCAN_PREP(bufp) do { LAS unsigned char* _B = (bufp); LAS float* TOT = (LAS float*)(lds + SC_TOT); \
        float cs[8]; float run = 0.f; \
        _Pragma("unroll") for (int e = 0; e < 8; ++e) { run += rlf[e]; cs[e] = run; } \
        TOT[part * 128 + kch] = run; __syncthreads(); \
        float off = 0.f, bend = 0.f; \
        _Pragma("unroll") for (int p = 0; p < 4; ++p) { const float tv = TOT[p * 128 + kch]; off += (p < part) ? tv : 0.f; bend += tv; } \
        unsigned kh[8]; \
        _Pragma("unroll") for (int e = 0; e < 8; ++e) { const int tau = 8 * part + e; const float bt = off + cs[e]; const float kf = 1.0f - __expf(rlf[e]); \
            const float qv = __uint_as_float(((unsigned)rqs[e]) << 16) * __expf(bt); const float kt = kf * __expf(-bt); const float kk = kf * __expf(bend - bt); \
            ((LAS bf16_t*)(_B + SC_QT))[tau * 136 + kch] = (bf16_t)(pk2(qv, 0.f) & 0xffffu); ((LAS bf16_t*)(_B + SC_KT))[tau * 136 + kch] = (bf16_t)(pk2(kt, 0.f) & 0xffffu); kh[e] = pk2(kk, 0.f) & 0xffffu; } \
        u32x4 kw; kw.x = kh[0] | (kh[1] << 16); kw.y = kh[2] | (kh[3] << 16); kw.z = kh[4] | (kh[5] << 16); kw.w = kh[6] | (kh[7] << 16); \
        *(LAS u32x4*)(_B + SC_KH + kch * 80 + part * 16) = kw; \
        if (part == 0) ((LAS float*)(_B + SC_DEC))[kch] = __expf(bend); } while (0)

        SCAN_RAW(0);
        SCAN_PREP(lds);
        bf16x8 vf = vfn;
        SCAN_RAW(1);
        __syncthreads();
        for (int ci = 0; ci < 72; ++ci) {
            LAS unsigned char* B = lds + (ci & 1) * SC_BUF;
            bf16x8 vf_next = vfn;
            if (ci + 1 < 72) { SCAN_PREP(lds + ((ci + 1) & 1) * SC_BUF); }
            if (ci + 2 < 72) { SCAN_RAW(ci + 2); }
            int t0; scan_chunk_t0(ci, b, dir, t0);
            bf16x8 vcur = vf;
            if (dir) { bf16x8 t = vf; vcur[0] = t[7]; vcur[1] = t[6]; vcur[2] = t[5]; vcur[3] = t[4]; vcur[4] = t[3]; vcur[5] = t[2]; vcur[6] = t[1]; vcur[7] = t[0]; }
            bf16x8 qb[2][4];
#pragma unroll
            for (int tb = 0; tb < 2; ++tb)
#pragma unroll
                for (int c = 0; c < 4; ++c) qb[tb][c] = *(const LAS bf16x8*)(B + SC_QT + ((16 * tb + fr) * 136 + 32 * c + 8 * fq) * 2);
            f32x4 att[2][2];
#pragma unroll
            for (int sb = 0; sb < 2; ++sb) {
                att[sb][0] = (f32x4){0.f, 0.f, 0.f, 0.f}; att[sb][1] = (f32x4){0.f, 0.f, 0.f, 0.f};
                const int srow = 8 * (fr >> 2) + 4 * sb + (fr & 3);
#pragma unroll
                for (int c = 0; c < 4; ++c) {
                    const bf16x8 ka = *(const LAS bf16x8*)(B + SC_KT + (srow * 136 + 32 * c + 8 * fq) * 2);
                    att[sb][0] = __builtin_amdgcn_mfma_f32_16x16x32_bf16(ka, qb[0][c], att[sb][0], 0, 0, 0);
                    att[sb][1] = __builtin_amdgcn_mfma_f32_16x16x32_bf16(ka, qb[1][c], att[sb][1], 0, 0, 0);
                }
            }
            f32x4 OT[2];
#pragma unroll
            for (int tb = 0; tb < 2; ++tb) {
                const int t = 16 * tb + fr;
#pragma unroll
                for (int sb = 0; sb < 2; ++sb)
#pragma unroll
                    for (int i = 0; i < 4; ++i) { const int sa = 8 * fq + 4 * sb + i; att[sb][tb][i] = (sa <= t) ? att[sb][tb][i] : 0.f; }
                union { u32x4 u; bf16x8 v; } P; P.u.x = pk2(att[0][tb][0], att[0][tb][1]); P.u.y = pk2(att[0][tb][2], att[0][tb][3]); P.u.z = pk2(att[1][tb][0], att[1][tb][1]); P.u.w = pk2(att[1][tb][2], att[1][tb][3]);
                OT[tb] = __builtin_amdgcn_mfma_f32_16x16x32_bf16(vcur, P.v, (f32x4){0.f, 0.f, 0.f, 0.f}, 0, 0, 0);
            }
#pragma unroll
            for (int c = 0; c < 4; ++c) {
                union { u32x4 u; bf16x8 v; } SF; SF.u.x = pk2(S[2 * c][0], S[2 * c][1]); SF.u.y = pk2(S[2 * c][2], S[2 * c][3]); SF.u.z = pk2(S[2 * c + 1][0], S[2 * c + 1][1]); SF.u.w = pk2(S[2 * c + 1][2], S[2 * c + 1][3]);
                OT[0] = __builtin_amdgcn_mfma_f32_16x16x32_bf16(SF.v, qb[0][c], OT[0], 0, 0, 0);
                OT[1] = __builtin_amdgcn_mfma_f32_16x16x32_bf16(SF.v, qb[1][c], OT[1], 0, 0, 0);
            }
#pragma unroll
            for (int kb = 0; kb < 8; ++kb) {
                const int krow = 32 * (kb >> 1) + 8 * (fr >> 2) + 4 * (kb & 1) + (fr & 3);
                const bf16x8 ka = *(const LAS bf16x8*)(B + SC_KH + krow * 80 + fq * 16);
                const f32x4 dc = *(const LAS f32x4*)(B + SC_DEC + (32 * (kb >> 1) + 8 * fq + 4 * (kb & 1)) * 4);
                S[kb] = __builtin_amdgcn_mfma_f32_16x16x32_bf16(ka, vcur, S[kb] * dc, 0, 0, 0);
            }
#pragma unroll
            for (int tb = 0; tb < 2; ++tb) {
                const int tau = 16 * tb + fr; const int tok = dir ? t0 + 31 - tau : t0 + tau;
                u32x2 w; w.x = pk2(OT[tb][0], OT[tb][1]); w.y = pk2(OT[tb][2], OT[tb][3]);
                *(u32x2*)(O + (size_t)tok * DI + h * 128 + 16 * wave + 4 * fq) = w;
            }
            vf = vf_next;
            __syncthreads();
        }
#undef SCAN_RAW
#undef SCAN_PREP
    }
}

#define XB_TMO      128
#define XB_XCNT(j)  (256  + 64 * (j))
#define XB_XSUB(j)  (1280 + 64 * (j))
#define XB_XGEN(j)  (2304 + 64 * (j))
#define XB_TOP      3328
#define XB_TOPGEN   3392
#define XCD_BAR_WORDS 3456
#define XB_SPIN_CAP (1u << 18)

__device__ __forceinline__ unsigned xb_ld(unsigned* p)              { return __hip_atomic_load(p, __ATOMIC_RELAXED, __HIP_MEMORY_SCOPE_AGENT); }
__device__ __forceinline__ unsigned xb_add(unsigned* p, unsigned v) { return __hip_atomic_fetch_add(p, v, __ATOMIC_RELAXED, __HIP_MEMORY_SCOPE_AGENT); }
__device__ __forceinline__ unsigned xb_xcc_id() { return (unsigned)__builtin_amdgcn_s_getreg((3 << 11) | 20) & 0xFu; }
#define XB_SPIN(cond, bar) do { unsigned _sp = 0; while (cond) { __builtin_amdgcn_s_sleep(1); \
    if ((++_sp & 255u) == 0u) { if (xb_ld(&(bar)[XB_TMO])) break; if (_sp > XB_SPIN_CAP) { atomicAdd(&(bar)[XB_TMO], 1u); break; } } } } while (0)

struct XcdBarrier {
    unsigned* bar; unsigned x;
    volatile LAS unsigned* st;
};

__device__ __forceinline__ XcdBarrier xcd_barrier_post(unsigned* bar, volatile LAS unsigned* st) {
    XcdBarrier b; b.bar = bar; b.x = xb_xcc_id(); b.st = st;
    if (threadIdx.x == 0) (void)xb_add(&bar[XB_XCNT(b.x)], 1u);
    return b;
}
__device__ __forceinline__ void xcd_barrier_complete(unsigned* bar, unsigned x, unsigned& nloc, unsigned& nx) {
    const unsigned G = gridDim.x * gridDim.y * gridDim.z;
    unsigned sum, cnt, mine, sp = 0u;
    for (;;) {
        sum = 0u; cnt = 0u; mine = 0u;
#pragma unroll
        for (unsigned j = 0; j < 16; ++j) { const unsigned c = xb_ld(&bar[XB_XCNT(j)]); sum += c; cnt += (c > 0u) ? 1u : 0u; mine = (j == x) ? c : mine; }
        if (sum == G) break;
        __builtin_amdgcn_s_sleep(1);
        if ((++sp & 255u) == 0u) { if (xb_ld(&bar[XB_TMO])) break; if (sp > XB_SPIN_CAP) { atomicAdd(&bar[XB_TMO], 1u); break; } }
    }
    nloc = mine > 0u ? mine : 1u; nx = cnt > 0u ? cnt : 1u;
}

__device__ __forceinline__ void xcd_barrier(const XcdBarrier& b) {
    asm volatile("s_waitcnt vmcnt(0)" ::: "memory");
    __syncthreads();
    if (threadIdx.x == 0) {
        unsigned* bar = b.bar;
        __builtin_amdgcn_s_waitcnt(0);
        unsigned nloc = b.st[0], nx = b.st[1];
        if (nloc == 0u) { xcd_barrier_complete(bar, b.x, nloc, nx); b.st[0] = nloc; b.st[1] = nx; }
        const unsigned old = xb_add(&bar[XB_XSUB(b.x)], 1u);
        const unsigned gen = old / nloc;
        if (old + 1u == (gen + 1u) * nloc) {
            __builtin_amdgcn_fence(__ATOMIC_RELEASE, "agent");
            asm volatile("s_waitcnt vmcnt(0)" ::: "memory");
            const unsigned og = xb_add(&bar[XB_TOP], 1u);
            const unsigned tg = og / nx;
            if (og + 1u == (tg + 1u) * nx) xb_add(&bar[XB_TOPGEN], 1u);
            else XB_SPIN(xb_ld(&bar[XB_TOPGEN]) == tg, bar);
            __builtin_amdgcn_fence(__ATOMIC_ACQUIRE, "agent");
            xb_add(&bar[XB_XGEN(b.x)], 1u);
            asm volatile("s_waitcnt vmcnt(0)" ::: "memory");
        } else {
            XB_SPIN(xb_ld(&bar[XB_XGEN(b.x)]) == gen, bar);
            __builtin_amdgcn_fence(__ATOMIC_ACQUIRE, "agent");
            asm volatile("s_waitcnt vmcnt(0)" ::: "memory");
        }
    }
    __syncthreads();
}


enum { OP_INIT = 0, OP_ROW = 1, OP_G1 = 2, OP_ATT = 3, OP_POOL = 4, OP_GG = 5, OP_SCAN = 6, OP_GATE = 7, OP_G2 = 8, OP_FINAL = 9 };
constexpr int NPHASE = 20;
constexpr int JOB_OFF = LDS_BYTES - 4096;
constexpr int BAR_ST_OFF = LDS_BYTES - 16;

__global__ void __launch_bounds__(NTHR, 2) fwd_mega(Args a0) {
    extern __shared__ __attribute__((aligned(16))) unsigned char lds_raw[];
    LAS unsigned char* lds = (LAS unsigned char*)lds_raw;
    cg::grid_group grid = cg::this_grid();
    const int G = gridDim.x, bid = blockIdx.x;
    if (a0.ws == nullptr) grid.sync();
    if (threadIdx.x == 0) {
        unsigned char* ws = a0.ws;
        bf16_t* H = (bf16_t*)(ws + WS_H); bf16_t* WIN = (bf16_t*)(ws + WS_WIN); bf16_t* WOUT = (bf16_t*)(ws + WS_WOUT); bf16_t* WG = (bf16_t*)(ws + WS_WG);
        const float* LB = (const float*)(ws + WS_LB);
        const int BIG = 1 << 30;
#define SLW(i) (ws + WS_S0 + (size_t)(i) * SLOT)
#define JW(gi, J0, J1, K, n0, n1) do { LAS unsigned char* p_ = lds + JOB_OFF + (gi) * 256; pg8::job_write(p_, J0); pg8::job_write(p_ + 128, J1); *(LAS int*)(p_ + 96) = (K); *(LAS int*)(p_ + 100) = (n0); *(LAS int*)(p_ + 104) = (n1); } while (0)
        const pg8::Job na0{H, WIN, 36, 48, BIG, 0, 4096, 0x271, SLW(0), SLW(1), SLW(2), nullptr, DI, nullptr, nullptr};
        const pg8::Job na1{WIN + (size_t)12288 * DM, H, 16, 36, BIG, 0, BIG, 0x8, SLW(3), nullptr, nullptr, nullptr, MTOT, nullptr, nullptr};
        const pg8::Job g2a{(const bf16_t*)SLW(4), WOUT, 36, 8, BIG, 0, BIG, 0x0, SLW(5), nullptr, nullptr, nullptr, DM, nullptr, nullptr};
        const pg8::Job g2c{(const bf16_t*)SLW(0), WOUT, 36, 8, BIG, 0, BIG, 0x0, SLW(5), nullptr, nullptr, nullptr, DM, nullptr, nullptr};
        const pg8::Job g2l{(const bf16_t*)SLW(4), WOUT, 32, 8, BIG, 0, BIG, 0x0, SLW(5), nullptr, nullptr, nullptr, DM, nullptr, nullptr};
        const pg8::Job p0{H, WIN, 36, 32, BIG, 0, 4096, 0x20, SLW(0), SLW(2), nullptr, nullptr, DI, nullptr, nullptr};
        const pg8::Job pg{(const bf16_t*)SLW(1), WG, 36, 16, 4, (size_t)MTOT * 1024, BIG, 0x6, SLW(4), nullptr, nullptr, nullptr, DI, a0.in[13], (const bf16_t*)SLW(2)};
        const pg8::Job h0{H, WIN, 36, 64, BIG, 0, 4096, 0x2432, SLW(0), SLW(5), SLW(7), SLW(2), DI, LB, nullptr};
        const pg8::Job h1{WIN + (size_t)16384 * DM, H, 16, 36, BIG, 0, BIG, 0x0, SLW(3), nullptr, nullptr, nullptr, MTOT, nullptr, nullptr};
        JW(0, na0, na1, DM, 36 * 48, 16 * 36); JW(1, g2a, g2a, DI, 36 * 8, 0);
        JW(2, p0, p0, DM, 36 * 32, 0); JW(3, pg, pg, 1024, 36 * 16, 0); JW(4, g2a, g2a, DI, 36 * 8, 0);
        JW(5, h0, h1, DM, 36 * 64, 16 * 36); JW(6, g2c, g2c, DI, 36 * 8, 0);
        JW(7, na0, na1, DM, 36 * 48, 16 * 36); JW(8, g2l, g2l, DI, 32 * 8, 0);
#undef JW
#undef SLW
    }
    {
        volatile LAS unsigned* st0 = (volatile LAS unsigned*)(lds + BAR_ST_OFF);
        if (threadIdx.x < 2) st0[threadIdx.x] = 0u;
        __syncthreads();
    }
    const XcdBarrier xbar = xcd_barrier_post((unsigned*)a0.ws, (volatile LAS unsigned*)(lds + BAR_ST_OFF));
#define SL(i) (ws + WS_S0 + (size_t)(i) * SLOT)
    const int BIG = 1 << 30;

    for (int ph = 0; ph < NPHASE; ++ph) {
        int li, op;
        if (ph == 0) { li = 0; op = OP_INIT; }
        else if (ph < 5) { li = 0; const int k = ph - 1; op = k == 0 ? OP_ROW : (k == 1 ? OP_G1 : (k == 2 ? OP_ATT : OP_G2)); }
        else if (ph < 10) { li = 1; const int k = ph - 5; op = k == 0 ? OP_ROW : (k == 1 ? OP_G1 : (k == 2 ? OP_POOL : (k == 3 ? OP_GG : OP_G2))); }
        else if (ph < 15) { li = 2; const int k = ph - 10; op = k == 0 ? OP_ROW : (k == 1 ? OP_G1 : (k == 2 ? OP_SCAN : (k == 3 ? OP_GATE : OP_G2))); }
        else if (ph < 19) { li = 3; const int k = ph - 15; op = k == 0 ? OP_ROW : (k == 1 ? OP_G1 : (k == 2 ? OP_ATT : OP_G2)); }
        else { li = 4; op = OP_FINAL; }
        const int kind = li % 3; const bool need_ctx = li < 3;
#if DBG_NL < 4
        if (li > DBG_NL || (li == DBG_NL && op != OP_ROW)) continue;
#endif
        int zero_ = 0; LAUNDER_S(zero_);
        Args a = a0;
#pragma unroll
        for (int i = 0; i < 19; ++i) a.in[i] = a0.in[i] + zero_;
        a.out = a0.out + zero_; a.ws = a0.ws + zero_;
        unsigned char* ws = a.ws;
        int tid_ = threadIdx.x; asm volatile("" : "+v"(tid_));
        const int tid = tid_, wave = __builtin_amdgcn_readfirstlane(tid >> 6), lane = tid & 63;
        const int gw = bid * NWAVES + wave, NGW = G * NWAVES;
        int gK = 0, gn0 = 0, gn1 = 0; const LAS unsigned char* jt = lds + JOB_OFF;
        if (op == OP_INIT) {
#ifdef ZERO_WS
            {
                u32x4* p = (u32x4*)(ws + WS_MOD); const size_t n16 = (WS_END - WS_MOD) / 16;
                for (size_t i = (size_t)bid * NTHR + tid; i < n16; i += (size_t)G * NTHR) p[i] = (u32x4){0u, 0u, 0u, 0u};
            }
#endif
#ifndef NO_MISC
            init_phase(a, lds, G);
            __syncthreads();
            transpose_layer(a, 0, lds, gw, NGW, wave, lane);
#ifdef PROBE_TR
            transpose_layer(a, 0, lds, gw, NGW, wave, lane);
#endif
#endif
        } else if (op == OP_ROW || op == OP_FINAL) {
#ifndef NO_MISC
            row_phase(a, li, gw, NGW, lane);
            if (li > 0 && li < 4) transpose_layer(a, li, lds, gw, NGW, wave, lane);
#ifdef PROBE_TR
            if (li > 0 && li < 4) transpose_layer(a, li, lds, gw, NGW, wave, lane);
#endif
#endif
        } else if (op == OP_ATT) {
#ifndef NO_ATTN
            attn_phase(a, li, lds, G, need_ctx ? 1 : 0);
#ifdef PROBE_ATT
            attn_phase(a, li, lds, G, need_ctx ? 1 : 0);
#endif
#endif
        } else if (op == OP_POOL) {
#ifndef NO_MISC
            pool_phase(a, G);
#endif
        } else if (op == OP_SCAN) {
#ifndef NO_SCAN
            scan_phase(a, lds, G);
#ifdef PROBE_SCAN
            scan_phase(a, lds, G);
#endif
#endif
        } else if (op == OP_GATE) {
#ifndef NO_MISC
            hgate_phase(a, G);
#endif
        } else {
            const int gi = li == 0 ? (op == OP_G1 ? 0 : 1) : (li == 1 ? (op == OP_G1 ? 2 : (op == OP_GG ? 3 : 4)) : (li == 2 ? (op == OP_G1 ? 5 : 6) : (op == OP_G1 ? 7 : 8)));
            jt = lds + JOB_OFF + gi * 256;
            gK = pg8::jl_i(jt + 96); gn0 = pg8::jl_i(jt + 100); gn1 = pg8::jl_i(jt + 104);
        }
#ifndef NO_GEMM
        if (gK) pg8::gemm_phase(lds, jt, gK, gn0, gn1, G, bid);
#ifdef PROBE_G2
        if (gK && op == OP_G2) { __syncthreads(); pg8::gemm_phase(lds, jt, gK, gn0, gn1, G, bid); }
#endif
#endif
        if (ph + 1 < NPHASE) xcd_barrier(xbar);
    }
#undef SL
}

extern "C" void kernel_launch(void* const* d_in, const int* in_sizes, int n_in, void* d_out, int out_size, void* d_ws, size_t ws_size, hipStream_t stream) {
    static int grid = 0;
    if (grid == 0) {
        if (n_in != 19 || out_size != MLAT * DM || ws_size < WS_END) { fprintf(stderr, "kernel_launch: unexpected shapes n_in %d out %d ws %zu (need %zu)\n", n_in, out_size, ws_size, (size_t)WS_END); grid = -1; return; }
        int dev = 0, cus = 0, per_cu = 0;
        (void)hipGetDevice(&dev);
        (void)hipDeviceGetAttribute(&cus, hipDeviceAttributeMultiprocessorCount, dev);
        (void)hipFuncSetAttribute((const void*)fwd_mega, hipFuncAttributeMaxDynamicSharedMemorySize, LDS_BYTES);
        (void)hipOccupancyMaxActiveBlocksPerMultiprocessor(&per_cu, (const void*)fwd_mega, NTHR, LDS_BYTES);
        fprintf(stderr, "cus %d per_cu %d ws %zu\n", cus, per_cu, ws_size);
        grid = cus > 0 ? cus : 256;
    }
    if (grid < 0) return;
    (void)hipMemsetAsync(d_ws, 0, 65536, stream);
    Args a{};
    for (int i = 0; i < 19; ++i) a.in[i] = (const float*)d_in[i];
    a.out = (float*)d_out; a.ws = (unsigned char*)d_ws;
    void* args[] = {&a};
    hipError_t e = hipLaunchCooperativeKernel((const void*)fwd_mega, dim3(grid), dim3(NTHR), args, LDS_BYTES, stream);
    if (e != hipSuccess) fprintf(stderr, "cooperative launch failed: %s (grid %d)\n", hipGetErrorString(e), grid);
}
```

```cpp
#ifndef DBG_NL
#define DBG_NL 4
#endif
#include <hip/hip_runtime.h>
#include <hip/hip_cooperative_groups.h>
#include <cstdio>
#include <cstdint>
namespace cg = cooperative_groups;

#define LAS __attribute__((address_space(3)))
#define GAS __attribute__((address_space(1)))
typedef unsigned short bf16_t;
typedef short bf16x8 __attribute__((ext_vector_type(8)));
typedef float f32x4 __attribute__((ext_vector_type(4)));
typedef unsigned u32x4 __attribute__((ext_vector_type(4)));
typedef unsigned u32x2 __attribute__((ext_vector_type(2)));

constexpr int DM = 2048, NB = 4, SEQ = 2048, CTX = 256, DI = 4096;
constexpr int MLAT = NB * SEQ, MCTX = NB * CTX, MTOT = MLAT + MCTX;
constexpr float EPS = 1e-6f;
constexpr int NTHR = 512, NWAVES = 8;
constexpr int LDS_BYTES = 147456;

constexpr size_t MiB = 1u << 20;
constexpr size_t WS_MOD = 1 * MiB;
constexpr size_t WS_LB = WS_MOD + 512 * 1024;
constexpr size_t WS_XC = 2 * MiB;
constexpr size_t WS_H = 10 * MiB;
constexpr size_t WS_WIN = 46 * MiB;
constexpr size_t WS_WOUT = 126 * MiB;
constexpr size_t WS_WG = 142 * MiB;
constexpr size_t WS_S0 = 150 * MiB;
constexpr size_t SLOT = 72 * MiB;
constexpr size_t WS_END = WS_S0 + 9 * SLOT;

typedef __bf16 bf2_t __attribute__((ext_vector_type(2)));
__device__ __forceinline__ unsigned pk2(float lo, float hi) { bf2_t v; v.x = (__bf16)lo; v.y = (__bf16)hi; return __builtin_bit_cast(unsigned, v); }
__device__ __forceinline__ float bflo(unsigned w) { return __uint_as_float(w << 16); }
__device__ __forceinline__ float bfhi(unsigned w) { return __uint_as_float(w & 0xffff0000u); }
__device__ __forceinline__ float fast_exp(float x) { return __expf(x); }
__device__ __forceinline__ float silu_f(float x) { return x * __builtin_amdgcn_rcpf(1.0f + __expf(-x)); }
__device__ __forceinline__ float wave_sum(float v) {
#pragma unroll
    for (int o = 1; o < 64; o <<= 1) v += __shfl_xor(v, o);
    return v;
}
#define LDS_WAIT() asm volatile("s_waitcnt lgkmcnt(0)" ::: "memory")
#define LAUNDER_V(x) asm volatile("" : "+v"(x))
#define LAUNDER_S(x) asm volatile("" : "+s"(x))
__device__ __forceinline__ int my_tid() { int t = threadIdx.x; LAUNDER_V(t); return t; }

namespace pg8 {
constexpr int BM = 256, BK = 64, HALF = 128, HTB = HALF * BK * 2, STAGE_BYTES = 8 * HTB, NXCD = 8, WGM = 8;
__device__ __forceinline__ int lds_byte(int r, int c) { const int st = (r >> 4) * 2 + (c >> 5), rr = r & 15, cc = c & 31, ob = rr * 64 + cc * 2; return st * 1024 + (ob ^ (((ob >> 9) & 1) << 5)); }
__device__ __forceinline__ void stage_rc(int b, int& R, int& C) { const int st = b / 1024, sb = b % 1024, swz = sb ^ (((sb >> 9) & 1) << 5); R = (st >> 1) * 16 + swz / 64; C = (st & 1) * 32 + (swz % 64) / 2; }
__device__ __forceinline__ int perm32(int rho) { const int n = rho >> 4, i = rho & 15; return 8 * (i >> 2) + 4 * n + (i & 3); }

struct Job {
    const bf16_t* A; const bf16_t* Bt; int nM, nN; int agdiv; size_t agstride;
    int segw; int acts; void* o0; void* o1; void* o2; void* o3; int ldo;
    const float* aux_f; const bf16_t* aux_b;
};
__device__ __forceinline__ void job_write(LAS unsigned char* p, const Job& J) {
    *(LAS unsigned long long*)(p + 0) = (unsigned long long)J.A; *(LAS unsigned long long*)(p + 8) = (unsigned long long)J.Bt;
    *(LAS int*)(p + 16) = J.nM; *(LAS int*)(p + 20) = J.nN; *(LAS int*)(p + 24) = J.agdiv; *(LAS int*)(p + 28) = J.ldo;
    *(LAS unsigned long long*)(p + 32) = (unsigned long long)J.agstride; *(LAS int*)(p + 40) = J.segw; *(LAS int*)(p + 44) = J.acts;
    *(LAS unsigned long long*)(p + 48) = (unsigned long long)J.o0; *(LAS unsigned long long*)(p + 56) = (unsigned long long)J.o1;
    *(LAS unsigned long long*)(p + 64) = (unsigned long long)J.o2; *(LAS unsigned long long*)(p + 72) = (unsigned long long)J.o3;
    *(LAS unsigned long long*)(p + 80) = (unsigned long long)J.aux_f; *(LAS unsigned long long*)(p + 88) = (unsigned long long)J.aux_b;
}
__device__ __forceinline__ int jl_i(const LAS unsigned char* p) { return __builtin_amdgcn_readfirstlane(*(const LAS int*)p); }
__device__ __forceinline__ unsigned long long jl_p(const LAS unsigned char* p) {
    const unsigned lo = (unsigned)__builtin_amdgcn_readfirstlane(*(const LAS int*)p), hi = (unsigned)__builtin_amdgcn_readfirstlane(*(const LAS int*)(p + 4));
    return ((unsigned long long)hi << 32) | lo;
}
struct Unit { int job, pm, pn; };

__device__ __forceinline__ void decode_tile(int l, int nM, int nN, int& pm, int& pn) {
    const int nwg = nM * nN; int wgid = l;
    { const int q = nwg / NXCD, r = nwg % NXCD, xcd = wgid % NXCD, off = wgid / NXCD; wgid = (xcd < r ? xcd * (q + 1) : r * (q + 1) + (xcd - r) * q) + off; }
    const int nig = WGM * nN, gid = wgid / nig, fm = gid * WGM, gsz = (nM - fm) < WGM ? (nM - fm) : WGM;
    pm = fm + ((wgid % nig) % gsz); pn = (wgid % nig) / gsz;
}

__device__ __forceinline__ void store_bf8(GAS bf16_t* p, const f32x4& v0, const f32x4& v1) {
    u32x4 w; w.x = pk2(v0[0], v0[1]); w.y = pk2(v0[2], v0[3]); w.z = pk2(v1[0], v1[1]); w.w = pk2(v1[2], v1[3]);
    *(GAS u32x4*)p = w;
}

__device__ __forceinline__ void epilogue(const f32x4 (&acc)[2][2][4][2], const LAS unsigned char* jt, const Unit& u, int wr, int wc, int fr_, int fq_) {
    int fr = fr_, fq = fq_; asm volatile("" : "+v"(fr), "+v"(fq));
    const LAS unsigned char* jp = jt + u.job * 128;
    const int segw = jl_i(jp + 40), acts = jl_i(jp + 44);
    const int colt = u.pn * BM; const int seg = colt / segw; const int act = (acts >> (4 * seg)) & 15;
    GAS unsigned char* op = (GAS unsigned char*)jl_p(jp + 48 + 8 * seg);
    const int col0 = colt - seg * segw + wc * 32 + 8 * fq;
    const int row0 = u.pm * BM + wr * 64 + fr;
    const int ldo = jl_i(jp + 28);
    const GAS float* aux_f = (const GAS float*)jl_p(jp + 80); const GAS bf16_t* aux_b = (const GAS bf16_t*)jl_p(jp + 88);
    if (act <= 2) {
        GAS bf16_t* O = (GAS bf16_t*)op;
#pragma unroll
        for (int ai = 0; ai < 2; ++ai)
#pragma unroll
            for (int m = 0; m < 4; ++m) {
                GAS bf16_t* rowp = O + (size_t)(row0 + ai * HALF + m * 16) * ldo + col0;
#pragma unroll
                for (int bj = 0; bj < 2; ++bj) {
                    f32x4 v0 = acc[ai][bj][m][0], v1 = acc[ai][bj][m][1];
                    if (act == 1) { v0 *= 0.08838834764831845f; v1 *= 0.08838834764831845f; }
                    if (act == 2) {
#pragma unroll
                        for (int j = 0; j < 4; ++j) { v0[j] = silu_f(v0[j]); v1[j] = silu_f(v1[j]); }
                    }
                    store_bf8(rowp + bj * HALF, v0, v1);
                }
            }
    } else if (act == 7) {
        GAS bf16_t* O = (GAS bf16_t*)op;
#pragma unroll
        for (int ai = 0; ai < 2; ++ai)
#pragma unroll
            for (int m = 0; m < 4; ++m) {
                const int token = row0 + ai * HALF + m * 16;
#pragma unroll
                for (int bj = 0; bj < 2; ++bj) {
                    const int col = col0 + bj * HALF, hd = col >> 7, d0 = col & 127;
                    store_bf8(O + ((size_t)(token >> 3) * 32 + hd) * 1024 + (d0 >> 4) * 128 + (token & 7) * 16 + ((d0 >> 3) & 1) * 8, acc[ai][bj][m][0], acc[ai][bj][m][1]);
                }
            }
    } else if (act == 8) {
        GAS bf16_t* O = (GAS bf16_t*)op;
#pragma unroll
        for (int ai = 0; ai < 2; ++ai)
#pragma unroll
            for (int m = 0; m < 4; ++m) {
                const int rr = row0 + ai * HALF + m * 16;
#pragma unroll
                for (int bj = 0; bj < 2; ++bj) {
                    const int t0 = col0 + bj * HALF;
                    store_bf8(O + ((size_t)(t0 >> 3) * 32 + (rr >> 7)) * 1024 + (rr & 127) * 8, acc[ai][bj][m][0], acc[ai][bj][m][1]);
                }
            }
    } else if (act == 3 || act == 4) {
        GAS float* O = (GAS float*)op;
        const GAS float* lbp = aux_f + (act - 3) * 4096 + col0;
#pragma unroll
        for (int bj = 0; bj < 2; ++bj) {
            const f32x4 l0 = *(const GAS f32x4*)(lbp + bj * HALF), l1 = *(const GAS f32x4*)(lbp + bj * HALF + 4);
#pragma unroll
            for (int ai = 0; ai < 2; ++ai)
#pragma unroll
                for (int m = 0; m < 4; ++m) {
                    GAS float* rowp = O + (size_t)(row0 + ai * HALF + m * 16) * ldo + col0 + bj * HALF;
                    f32x4 v0 = acc[ai][bj][m][0], v1 = acc[ai][bj][m][1];
#pragma unroll
                    for (int j = 0; j < 4; ++j) {
                        const float s0 = __builtin_amdgcn_rcpf(1.0f + __expf(-v0[j])), s1 = __builtin_amdgcn_rcpf(1.0f + __expf(-v1[j]));
                        v0[j] = __logf(l0[j] + (1.0f - l0[j]) * s0); v1[j] = __logf(l1[j] + (1.0f - l1[j]) * s1);
                    }
                    *(GAS f32x4*)rowp = v0; *(GAS f32x4*)(rowp + 4) = v1;
                }
        }
    } else if (act == 5) {
        GAS float* O = (GAS float*)op;
#pragma unroll
        for (int ai = 0; ai < 2; ++ai)
#pragma unroll
            for (int m = 0; m < 4; ++m) {
                GAS float* rowp = O + (size_t)(row0 + ai * HALF + m * 16) * ldo + col0;
#pragma unroll
                for (int bj = 0; bj < 2; ++bj) { *(GAS f32x4*)(rowp + bj * HALF) = acc[ai][bj][m][0]; *(GAS f32x4*)(rowp + bj * HALF + 4) = acc[ai][bj][m][1]; }
            }
    } else {
        GAS bf16_t* O = (GAS bf16_t*)op;
#pragma unroll
        for (int bj = 0; bj < 2; ++bj) {
            const f32x4 s0 = *(const GAS f32x4*)(aux_f + col0 + bj * HALF), s1 = *(const GAS f32x4*)(aux_f + col0 + bj * HALF + 4);
#pragma unroll
            for (int ai = 0; ai < 2; ++ai)
#pragma unroll
                for (int m = 0; m < 4; ++m) {
                    const size_t off = (size_t)(row0 + ai * HALF + m * 16) * ldo + col0 + bj * HALF;
                    const u32x4 z = *(const GAS u32x4*)(aux_b + off);
                    f32x4 v0 = acc[ai][bj][m][0] * s0, v1 = acc[ai][bj][m][1] * s1;
                    v0[0] *= bflo(z.x); v0[1] *= bfhi(z.x); v0[2] *= bflo(z.y); v0[3] *= bfhi(z.y);
                    v1[0] *= bflo(z.z); v1[1] *= bfhi(z.z); v1[2] *= bflo(z.w); v1[3] *= bfhi(z.w);
                    store_bf8(O + off, v0, v1);
                }
        }
    }
}

__device__ __forceinline__ bool next_unit(int i, int G, int c, const LAS unsigned char* jt, int n0, int n1, Unit& u) {
    const int L = i * G + c; if (L >= n0 + n1) return false;
    const int job = L < n0 ? 0 : 1; const LAS unsigned char* jp = jt + job * 128;
    u.job = job; decode_tile(job ? L - n0 : L, jl_i(jp + 16), jl_i(jp + 20), u.pm, u.pn);
    return true;
}
__device__ __forceinline__ const char* unit_a(const LAS unsigned char* jt, const Unit& u, size_t tstep) {
    const LAS unsigned char* jp = jt + u.job * 128;
    return (const char*)jl_p(jp + 0) + (size_t)(u.pn / jl_i(jp + 24)) * jl_p(jp + 32) * 2 + (size_t)u.pm * tstep;
}
__device__ __forceinline__ const char* unit_b(const LAS unsigned char* jt, const Unit& u, size_t tstep) {
    const LAS unsigned char* jp = jt + u.job * 128;
    return (const char*)jl_p(jp + 8) + (size_t)u.pn * tstep;
}

__device__ __forceinline__ void gemm_phase(LAS unsigned char* lds, const LAS unsigned char* jt, const int K, const int n0, const int n1, const int G, const int c) {
    int tid_ = threadIdx.x; asm volatile("" : "+v"(tid_));
    const int tid = tid_, wid = __builtin_amdgcn_readfirstlane(tid >> 6), lane = tid & 63, wr = wid >> 2, wc = wid & 3, fr = lane & 15, fq = lane >> 4;
    const int nt = K / BK;
    unsigned voffA[2], voffB[2];
#pragma unroll
    for (int i = 0; i < 2; ++i) { int R, C; stage_rc(tid * 16 + i * 8192, R, C); const int Rb = (R & ~31) + perm32(R & 31);
        voffA[i] = (unsigned)(R * K + C) * 2u; voffB[i] = (unsigned)(Rb * K + C) * 2u; }
    const size_t kstep = (size_t)(BK * 2);
    const size_t hstep = (size_t)HALF * K * 2;
    const size_t tstep = 2 * hstep;
    const unsigned ldsw = (unsigned)wid * 1024u;
    const int aoff = lds_byte(wr * 64 + fr, fq * 8), boff = lds_byte(wc * 32 + fr, fq * 8);
#define PG8_SA(b, h) (((b) * 2 + (h)) * HTB)
#define PG8_SB(b, h) ((4 + (b) * 2 + (h)) * HTB)
#define PG8_STAGE(bufoff, gbase, voff) do { _Pragma("unroll") for (int _i = 0; _i < 2; ++_i) \
        __builtin_amdgcn_global_load_lds((const unsigned*)((const char*)(gbase) + (voff)[_i]), (LAS unsigned*)(lds + (bufoff) + ldsw + _i * 8192), 16, 0, 0); } while (0)
#define PG8_LDA(dst, b, h) do { _Pragma("unroll") for (int m = 0; m < 4; ++m) _Pragma("unroll") for (int k = 0; k < 2; ++k) dst[m][k] = *(const LAS bf16x8*)(lds + PG8_SA(b, h) + aoff + m * 2048 + k * 1024); } while (0)
#define PG8_LDB(dst, b, h) do { _Pragma("unroll") for (int n = 0; n < 2; ++n) _Pragma("unroll") for (int k = 0; k < 2; ++k) dst[n][k] = *(const LAS bf16x8*)(lds + PG8_SB(b, h) + boff + n * 2048 + k * 1024); } while (0)
#define PG8_MMA(ai, bj, At, Bt) do { __builtin_amdgcn_s_setprio(1); _Pragma("unroll") for (int m = 0; m < 4; ++m) _Pragma("unroll") for (int n = 0; n < 2; ++n) _Pragma("unroll") for (int k = 0; k < 2; ++k) \
        acc[ai][bj][m][n] = __builtin_amdgcn_mfma_f32_16x16x32_bf16(Bt[n][k], At[m][k], acc[ai][bj][m][n], 0, 0, 0); __builtin_amdgcn_s_setprio(0); } while (0)
#define PG8_WAIT_V(n) asm volatile("s_waitcnt vmcnt(" #n ")" ::: "memory")
#define PG8_WAIT_L(n) asm volatile("s_waitcnt lgkmcnt(" #n ")" ::: "memory")
#define PG8_BAR __builtin_amdgcn_s_barrier()
#define PG8_SCHED __builtin_amdgcn_sched_barrier(0)
#define PG8_UA(u) unit_a(jt, (u), tstep)
#define PG8_UB(u) unit_b(jt, (u), tstep)
    Unit cur, nxt; int ui = 0;
    if (!next_unit(0, G, c, jt, n0, n1, cur)) return;
    f32x4 acc[2][2][4][2];
#pragma unroll
    for (int a = 0; a < 2; ++a)
#pragma unroll
        for (int b = 0; b < 2; ++b)
#pragma unroll
            for (int m = 0; m < 4; ++m)
#pragma unroll
                for (int n = 0; n < 2; ++n) acc[a][b][m][n] = (f32x4){0.f, 0.f, 0.f, 0.f};
    bf16x8 At[4][2], B0[2][2], B1[2][2];
    const char* cA = PG8_UA(cur); const char* cB = PG8_UB(cur);
    PG8_STAGE(PG8_SB(0, 0), cB, voffB); PG8_STAGE(PG8_SB(0, 1), cB + hstep, voffB); PG8_STAGE(PG8_SA(0, 0), cA, voffA); PG8_STAGE(PG8_SA(0, 1), cA + hstep, voffA);
    if (wr == 1) PG8_BAR;
    PG8_WAIT_V(2); PG8_BAR;
    PG8_STAGE(PG8_SB(1, 0), cB + kstep, voffB); PG8_STAGE(PG8_SA(1, 0), cA + kstep, voffA); PG8_STAGE(PG8_SB(1, 1), cB + hstep + kstep, voffB);
    PG8_WAIT_V(6); PG8_BAR;
    for (;;) {
        const bool has_next = next_unit(ui + 1, G, c, jt, n0, n1, nxt);
        const char* nA = cA; const char* nB = cB;
        if (has_next) { nA = PG8_UA(nxt); nB = PG8_UB(nxt); }
        for (int t = 0; t < nt; t += 2) {
            const bool last = (t == nt - 2);
            const char* a1 = cA + (size_t)(t + 1) * kstep;
            const char* a2 = last ? nA : cA + (size_t)(t + 2) * kstep; const char* b2 = last ? nB : cB + (size_t)(t + 2) * kstep;
            const char* a3 = a2 + kstep; const char* b3 = b2 + kstep;
            PG8_LDB(B0, 0, 0); PG8_LDB(B1, 0, 1); PG8_SCHED; PG8_LDA(At, 0, 0); PG8_STAGE(PG8_SA(1, 1), a1 + hstep, voffA);
            PG8_WAIT_V(8); PG8_WAIT_L(0); PG8_BAR; PG8_MMA(0, 0, At, B0); PG8_MMA(0, 1, At, B1); PG8_BAR; PG8_SCHED;
            PG8_LDA(At, 0, 1); PG8_STAGE(PG8_SB(0, 0), b2, voffB); PG8_STAGE(PG8_SB(0, 1), b2 + hstep, voffB); PG8_STAGE(PG8_SA(0, 0), a2, voffA);
            PG8_WAIT_V(8); PG8_WAIT_L(0); PG8_BAR; PG8_MMA(1, 0, At, B0); PG8_MMA(1, 1, At, B1); PG8_BAR; PG8_SCHED;
            PG8_LDB(B0, 1, 0); PG8_LDB(B1, 1, 1); PG8_SCHED; PG8_LDA(At, 1, 0); PG8_STAGE(PG8_SA(0, 1), a2 + hstep, voffA);
            PG8_WAIT_V(8); PG8_WAIT_L(0); PG8_BAR; PG8_MMA(0, 0, At, B0); PG8_MMA(0, 1, At, B1); PG8_BAR; PG8_SCHED;
            PG8_LDA(At, 1, 1); PG8_STAGE(PG8_SB(1, 0), b3, voffB); PG8_STAGE(PG8_SB(1, 1), b3 + hstep, voffB); PG8_STAGE(PG8_SA(1, 0), a3, voffA);
            PG8_WAIT_V(8); PG8_WAIT_L(0); PG8_BAR; PG8_MMA(1, 0, At, B0); PG8_MMA(1, 1, At, B1); PG8_BAR; PG8_SCHED;
        }
        if (wr == 0) PG8_BAR;
        epilogue(acc, jt, cur, wr, wc, fr, fq);
        if (!has_next) break;
#pragma unroll
        for (int a = 0; a < 2; ++a)
#pragma unroll
            for (int b = 0; b < 2; ++b)
#pragma unroll
                for (int m = 0; m < 4; ++m)
#pragma unroll
                    for (int n = 0; n < 2; ++n) acc[a][b][m][n] = (f32x4){0.f, 0.f, 0.f, 0.f};
        cur = nxt; cA = nA; cB = nB; ++ui;
        if (wr == 1) PG8_BAR;
    }
    PG8_WAIT_V(0);
    PG8_BAR;
#undef PG8_SA
#undef PG8_SB
#undef PG8_STAGE
#undef PG8_LDA
#undef PG8_LDB
#undef PG8_MMA
#undef PG8_WAIT_V
#undef PG8_WAIT_L
#undef PG8_BAR
#undef PG8_SCHED
#undef PG8_UA
#undef PG8_UB
}
}

struct Args {
    const float* in[19]; float* out; unsigned char* ws;
};

__device__ __forceinline__ void tr_item(const float* __restrict__ W, int K, int N, bf16_t* WT, int segperm, LAS float* scr, int item, int lane) {
    const int nblk = N >> 6, kb = item / nblk, nb = item - kb * nblk, k0 = kb << 6, n0 = nb << 6;
    const float* src = W + (size_t)k0 * N + n0 + lane;
#pragma unroll 16
    for (int i = 0; i < 64; ++i) scr[i * 65 + lane] = src[(size_t)i * N];
    LDS_WAIT();
    const int seg = n0 >> 12, dseg = (segperm >> (4 * seg)) & 15, drow0 = n0 + (dseg - seg) * 4096;
    const int c = lane & 7;
#pragma unroll
    for (int j = 0; j < 8; ++j) {
        const int n = (lane >> 3) + 8 * j; const LAS float* s = scr + (8 * c) * 65 + n;
        u32x4 o; o.x = pk2(s[0], s[65]); o.y = pk2(s[130], s[195]); o.z = pk2(s[260], s[325]); o.w = pk2(s[390], s[455]);
        *(u32x4*)(WT + (size_t)(drow0 + n) * K + k0 + 8 * c) = o;
    }
    LDS_WAIT();
}

__device__ __forceinline__ void transpose_layer(const Args& a, int layer, LAS unsigned char* lds, int gw, int NGW, int wave, int lane) {
    LAS float* scr = (LAS float*)(lds + wave * 16640);
    bf16_t* WIN = (bf16_t*)(a.ws + WS_WIN); bf16_t* WOUT = (bf16_t*)(a.ws + WS_WOUT); bf16_t* WG = (bf16_t*)(a.ws + WS_WG);
    const int kind = layer % 3, j = layer / 3;
    if (kind == 0) {
        const float* win = a.in[8] + (size_t)j * DM * 16384; const float* wout = a.in[10] + (size_t)j * DI * DM;
        const int n_in = (DM / 64) * (16384 / 64), n_out = (DI / 64) * (DM / 64);
        for (int it = gw; it < n_in + n_out; it += NGW) {
            if (it < n_in) tr_item(win, DM, 16384, WIN, 0x2310, scr, it, lane);
            else tr_item(wout, DI, DM, WOUT, 0x43210, scr, it - n_in, lane);
        }
    } else if (kind == 1) {
        const float* win = a.in[11]; const float* wg = a.in[12]; const float* wout = a.in[14];
        const int n_in = (DM / 64) * (8192 / 64), n_g = 16 * 16, n_out = (DI / 64) * (DM / 64);
        for (int it = gw; it < n_in + 4 * n_g + n_out; it += NGW) {
            if (it < n_in) tr_item(win, DM, 8192, WIN, 0x43210, scr, it, lane);
            else if (it < n_in + 4 * n_g) { const int g = (it - n_in) / n_g, r = (it - n_in) % n_g; tr_item(wg + (size_t)g * 1024 * 1024, 1024, 1024, WG + (size_t)g * 1024 * 1024, 0x43210, scr, r, lane); }
            else tr_item(wout, DI, DM, WOUT, 0x43210, scr, it - n_in - 4 * n_g, lane);
        }
    } else {
        const float* win = a.in[15]; const float* wout = a.in[18];
        const int n_in = (DM / 64) * (20480 / 64), n_out = (DI / 64) * (DM / 64);
        for (int it = gw; it < n_in + n_out; it += NGW) {
            if (it < n_in) tr_item(win, DM, 20480, WIN, 0x34210, scr, it, lane);
            else tr_item(wout, DI, DM, WOUT, 0x43210, scr, it - n_in, lane);
        }
    }
}

__device__ __forceinline__ void row_phase(const Args& a, int li, LAS unsigned char* lds, int G, int tid, int wave, int lane) {
    LAS f32x4* V = (LAS f32x4*)lds;
    const float* MOD = (const float*)(a.ws + WS_MOD);
    float* XC = (float*)(a.ws + WS_XC); bf16_t* H = (bf16_t*)(a.ws + WS_H);
    const bf16_t* Y = (const bf16_t*)(a.ws + WS_S0 + 5 * SLOT);
    for (int rb = blockIdx.x; rb < 256; rb += G) {
        const int mrl = rb >> 6;
        __syncthreads();
        {
            const int c4 = 4 * tid;
            if (li > 0) {
                const f32x4 gp = *(const f32x4*)(a.in[7] + (size_t)(li - 1) * DM + c4);
                const f32x4 gl = *(const f32x4*)(MOD + (size_t)((li - 1) * 5 + mrl) * 6144 + 4096 + c4), gc = *(const f32x4*)(MOD + (size_t)((li - 1) * 5 + 4) * 6144 + 4096 + c4);
                V[0 * 512 + tid] = gl * gp; V[1 * 512 + tid] = gc * gp;
            }
            if (li < 4) {
                const f32x4 gpre = *(const f32x4*)(a.in[6] + (size_t)li * DM + c4);
                const float* ml = MOD + (size_t)(li * 5 + mrl) * 6144 + c4; const float* mc = MOD + (size_t)(li * 5 + 4) * 6144 + c4;
                V[2 * 512 + tid] = gpre * (1.0f + *(const f32x4*)(ml + 2048)); V[3 * 512 + tid] = gpre * (1.0f + *(const f32x4*)(mc + 2048));
                V[4 * 512 + tid] = *(const f32x4*)ml; V[5 * 512 + tid] = *(const f32x4*)mc;
            }
        }
        __syncthreads();
        const int nr = (li == 4) ? 4 : (wave < 4 ? 5 : 4);
        for (int k = 0; k < nr; ++k) {
            const bool lat = k < 4;
            const int row = lat ? rb * 32 + wave * 4 + k : MLAT + rb * 4 + wave;
            const LAS f32x4* Vr = V + (lat ? 0 : 512) + lane;
            float* xrow = lat ? a.out + (size_t)row * DM : XC + (size_t)(row - MLAT) * DM;
            f32x4 xv[8];
            if (li == 0) {
                const float* src = lat ? a.in[0] + (size_t)row * DM : a.in[2] + (size_t)(row - MLAT) * DM;
#pragma unroll
                for (int j = 0; j < 8; ++j) xv[j] = *(const f32x4*)(src + 4 * lane + 256 * j);
#pragma unroll
                for (int j = 0; j < 8; ++j) *(f32x4*)(xrow + 4 * lane + 256 * j) = xv[j];
            } else {
                const bf16_t* yrow = Y + (size_t)row * DM;
                u32x2 yw[8];
#pragma unroll
                for (int j = 0; j < 8; ++j) xv[j] = *(const f32x4*)(xrow + 4 * lane + 256 * j);
#pragma unroll
                for (int j = 0; j < 8; ++j) yw[j] = *(const u32x2*)(yrow + 4 * lane + 256 * j);
                f32x4 yv[8]; float ss = 0.f;
#pragma unroll
                for (int j = 0; j < 8; ++j) { yv[j] = (f32x4){bflo(yw[j].x), bfhi(yw[j].x), bflo(yw[j].y), bfhi(yw[j].y)}; ss += (yv[j].x * yv[j].x + yv[j].y * yv[j].y) + (yv[j].z * yv[j].z + yv[j].w * yv[j].w); }
                const float rstd = rsqrtf(wave_sum(ss) * (1.0f / DM) + EPS);
#pragma unroll
                for (int j = 0; j < 8; ++j) {
                    xv[j] += Vr[0 * 512 + 64 * j] * (yv[j] * rstd);
                    *(f32x4*)(xrow + 4 * lane + 256 * j) = xv[j];
                }
            }
            if (li < 4) {
                float ss = 0.f;
#pragma unroll
                for (int j = 0; j < 8; ++j) ss += (xv[j].x * xv[j].x + xv[j].y * xv[j].y) + (xv[j].z * xv[j].z + xv[j].w * xv[j].w);
                const float rstd = rsqrtf(wave_sum(ss) * (1.0f / DM) + EPS);
                bf16_t* hrow = H + (size_t)row * DM;
#pragma unroll
                for (int j = 0; j < 8; ++j) {
                    const f32x4 hv = (xv[j] * rstd) * Vr[2 * 512 + 64 * j] + Vr[4 * 512 + 64 * j];
                    u32x2 w; w.x = pk2(hv.x, hv.y); w.y = pk2(hv.z, hv.w);
                    *(u32x2*)(hrow + 4 * lane + 256 * j) = w;
                }
            }
        }
    }
}

__device__ __forceinline__ void init_phase(const Args& a, LAS unsigned char* lds, int G) {
    LAS float* sc = (LAS float*)lds;
    LAS float* red = sc + 5 * 2048;
    const int tid = my_tid();
    float* MOD = (float*)(a.ws + WS_MOD); float* LB = (float*)(a.ws + WS_LB);
    for (int e = tid; e < 5 * 2048; e += NTHR) { const int r = e >> 11, k = e & 2047; const float v = r < 4 ? a.in[1][r * 2048 + k] : a.in[3][k]; sc[e] = silu_f(v); }
    __syncthreads();
    for (int item = blockIdx.x; item < 384; item += G) {
        const int layer = item / 96, n0 = (item % 96) * 64, ks = tid >> 6, nn = tid & 63;
        float acc0 = 0.f, acc1 = 0.f, acc2 = 0.f, acc3 = 0.f, acc4 = 0.f;
        const float* wp = a.in[4] + ((size_t)layer * 2048 + ks * 256) * 6144 + n0 + nn;
        const LAS float* sp = sc + ks * 256;
#pragma unroll 32
        for (int kk = 0; kk < 256; ++kk) {
            const float w = wp[(size_t)kk * 6144];
            acc0 += sp[kk] * w; acc1 += sp[2048 + kk] * w; acc2 += sp[4096 + kk] * w; acc3 += sp[6144 + kk] * w; acc4 += sp[8192 + kk] * w;
        }
        red[(ks * 5 + 0) * 64 + nn] = acc0; red[(ks * 5 + 1) * 64 + nn] = acc1; red[(ks * 5 + 2) * 64 + nn] = acc2; red[(ks * 5 + 3) * 64 + nn] = acc3; red[(ks * 5 + 4) * 64 + nn] = acc4;
        __syncthreads();
        if (tid < 320) {
            const int r = tid >> 6, n2 = tid & 63; float s = 0.f;
#pragma unroll
            for (int k8 = 0; k8 < 8; ++k8) s += red[(k8 * 5 + r) * 64 + n2];
            MOD[(size_t)(layer * 5 + r) * 6144 + n0 + n2] = s + a.in[5][layer * 6144 + n0 + n2];
        }
        __syncthreads();
    }
    const int gt = blockIdx.x * NTHR + tid;
    if (gt < 2 * 4096) {
        const int d = gt >> 12, f = gt & 4095; const float* p = a.in[16] + (size_t)d * 4 * 4096 + f;
        const float l0 = p[0], l1 = p[4096], l2 = p[8192], l3 = p[12288];
        const float mx = fmaxf(fmaxf(l0, l1), fmaxf(l2, l3));
        const float e0 = expf(l0 - mx), e1 = expf(l1 - mx), e2 = expf(l2 - mx), e3 = expf(l3 - mx);
        LB[gt] = (e1 + e2) / (e0 + e1 + e2 + e3);
    }
}

typedef float f32x16 __attribute__((ext_vector_type(16)));
__device__ __forceinline__ void attn_phase(const Args& a, int layer, LAS unsigned char* lds, int G, int need_ctx) {
    const int tid = my_tid(), wave = __builtin_amdgcn_readfirstlane(tid >> 6), lane = tid & 63, q = lane & 31, hh = lane >> 5;
    const bf16_t* Q = (const bf16_t*)(a.ws + WS_S0); const bf16_t* Kp = (const bf16_t*)(a.ws + WS_S0 + SLOT);
    const bf16_t* SZ = (const bf16_t*)(a.ws + WS_S0 + 2 * SLOT); const bf16_t* Vt = (const bf16_t*)(a.ws + WS_S0 + 3 * SLOT);
    bf16_t* GT = (bf16_t*)(a.ws + WS_S0 + 4 * SLOT);
    const float* rpb = a.in[9] + (size_t)(layer / 3) * 32 * 465;
    LAS float* rp = (LAS float*)(lds + wave * 2048);
    const int gw = blockIdx.x * NWAVES + wave, NGW = G * NWAVES;
    const int nlat = 8192, ntask = nlat + (need_ctx ? 1024 : 0);
    const int sig = (q & 19) | ((q & 8) >> 1) | ((q & 4) << 1);
    for (int task = gw; task < ntask; task += NGW) {
        const bool lat = task < nlat;
        int b, h, r = 0, j = 0, qtok;
        if (lat) { j = task & 3; r = 2 * ((task >> 2) & 15); h = (task >> 6) & 31; b = task >> 11; qtok = b * SEQ + (r + (q >> 4)) * 64 + 16 * j + (q & 15); }
        else { const int t2 = task - nlat; h = (t2 >> 3) & 31; b = t2 >> 8; qtok = MLAT + b * CTX + 32 * (t2 & 7) + q; }
        bf16x8 qf[8];
#pragma unroll
        for (int c = 0; c < 8; ++c) qf[c] = *(const bf16x8*)(Q + (size_t)qtok * DI + h * 128 + 16 * c + 8 * hh);
        if (lat) {
            LDS_WAIT();
            for (int e = lane; e < 465; e += 64) rp[e] = rpb[h * 465 + e];
            LDS_WAIT();
        }
        const int r0a = min(max(r - 4, 0), 24), r0b = min(max(r - 3, 0), 24), nband = lat ? (r0b + 8 - r0a) : 0;
        const int qr = r + (q >> 4), myr0 = (q >> 4) ? r0b : r0a;
        const int cw = min(max(16 * j - 8, 0), 32), qcol = 16 * j + (q & 15), c0 = min(max(qcol - 8, 0), 48);
        const int nst = nband + 8;
        const int kb_lat = b * SEQ + r0a * 64 + cw, kb_ctx = MLAT + b * CTX;
        const bf16_t* kbase = Kp + (size_t)h * 1024 + (size_t)(sig >> 3) * 32768 + (sig & 7) * 16 + 8 * hh;
        const bf16_t* vbase = Vt + (size_t)h * 1024 + (size_t)hh * 32768 + q * 8;
        float m_run = -1e30f, l_run = 0.f;
        f32x16 OT[4];
#pragma unroll
        for (int d = 0; d < 4; ++d)
#pragma unroll
            for (int t = 0; t < 16; ++t) OT[d][t] = 0.f;
        bf16x8 kreg[8], vreg[8];
        { const int kb0 = nband ? kb_lat : kb_ctx;
#pragma unroll
          for (int c = 0; c < 8; ++c) kreg[c] = *(const bf16x8*)(kbase + (size_t)(kb0 >> 3) * 32768 + 128 * c); }
        for (int st = 0; st < nst; ++st) {
            const bool isl = st < nband;
            const int keybase = isl ? kb_lat + st * 64 : kb_ctx + 32 * (st - nband);
#pragma unroll
            for (int d = 0; d < 4; ++d)
#pragma unroll
                for (int s2 = 0; s2 < 2; ++s2) vreg[d * 2 + s2] = *(const bf16x8*)(vbase + (size_t)(keybase >> 3) * 32768 + s2 * 65536 + d * 256);
            f32x16 sc;
#pragma unroll
            for (int t = 0; t < 16; ++t) sc[t] = 0.f;
#pragma unroll
            for (int c = 0; c < 8; ++c) sc = __builtin_amdgcn_mfma_f32_32x32x16_bf16(kreg[c], qf[c], sc, 0, 0, 0);
            if (st + 1 < nst) {
                const int kn = (st + 1 < nband) ? kb_lat + (st + 1) * 64 : kb_ctx + 32 * (st + 1 - nband);
#pragma unroll
                for (int c = 0; c < 8; ++c) kreg[c] = *(const bf16x8*)(kbase + (size_t)(kn >> 3) * 32768 + 128 * c);
            }
            if (isl) {
                const int kr = r0a + st; const bool rowok = (kr >= myr0) && (kr < myr0 + 8);
                const int brow = (kr - qr + 7) * 31 - qcol + 15;
#pragma unroll
                for (int t = 0; t < 16; ++t) {
                    const int kc = cw + 16 * (t >> 3) + 8 * hh + (t & 7); const bool valid = rowok && (kc >= c0) && (kc < c0 + 16);
                    const float bias = rp[valid ? (brow + kc) : 0];
                    sc[t] = valid ? sc[t] + bias : -3.0e38f;
                }
            }
            float mx = sc[0];
#pragma unroll
            for (int t = 1; t < 16; ++t) mx = fmaxf(mx, sc[t]);
            mx = fmaxf(mx, __shfl_xor(mx, 32));
            const float m_new = fmaxf(m_run, mx), alpha = __expf(m_run - m_new);
            float rs = 0.f;
#pragma unroll
            for (int t = 0; t < 16; ++t) { sc[t] = __expf(sc[t] - m_new); rs += sc[t]; }
            rs += __shfl_xor(rs, 32);
            l_run = l_run * alpha + rs; m_run = m_new;
            union { u32x4 u; bf16x8 v; } P0, P1;
            P0.u.x = pk2(sc[0], sc[1]); P0.u.y = pk2(sc[2], sc[3]); P0.u.z = pk2(sc[4], sc[5]); P0.u.w = pk2(sc[6], sc[7]);
            P1.u.x = pk2(sc[8], sc[9]); P1.u.y = pk2(sc[10], sc[11]); P1.u.z = pk2(sc[12], sc[13]); P1.u.w = pk2(sc[14], sc[15]);
#pragma unroll
            for (int d = 0; d < 4; ++d) {
#pragma unroll
                for (int t = 0; t < 16; ++t) OT[d][t] *= alpha;
                OT[d] = __builtin_amdgcn_mfma_f32_32x32x16_bf16(vreg[d * 2 + 0], P0.v, OT[d], 0, 0, 0);
                OT[d] = __builtin_amdgcn_mfma_f32_32x32x16_bf16(vreg[d * 2 + 1], P1.v, OT[d], 0, 0, 0);
            }
        }
        const float inv = 1.0f / l_run;
        const size_t obase = (size_t)qtok * DI + h * 128 + 4 * hh;
#pragma unroll
        for (int d = 0; d < 4; ++d)
#pragma unroll
            for (int g4 = 0; g4 < 4; ++g4) {
                const size_t o = obase + 32 * d + 8 * g4;
                const u32x2 z = *(const u32x2*)(SZ + o);
                u32x2 w; w.x = pk2(OT[d][4 * g4 + 0] * inv * bflo(z.x), OT[d][4 * g4 + 1] * inv * bfhi(z.x)); w.y = pk2(OT[d][4 * g4 + 2] * inv * bflo(z.y), OT[d][4 * g4 + 3] * inv * bfhi(z.y));
                *(u32x2*)(GT + o) = w;
            }
    }
}

__device__ __forceinline__ void pool_phase(const Args& a, int G) {
    const bf16_t* U = (const bf16_t*)(a.ws + WS_S0); bf16_t* Pg = (bf16_t*)(a.ws + WS_S0 + SLOT);
    const int gt = blockIdx.x * NTHR + my_tid(), gsz = G * NTHR;
    for (int idx = gt; idx < MTOT * 512; idx += gsz) {
        const int row = idx >> 9, cv = idx & 511, col = cv * 8, g = col >> 10, hw = 1 << g;
        int t, T, base;
        if (row < MLAT) { t = row & 2047; T = SEQ; base = row - t; } else { const int r2 = row - MLAT; t = r2 & 255; T = CTX; base = row - t; }
        const int lo = max(t - hw, 0), hi = min(t + hw, T);
        float acc[8];
#pragma unroll
        for (int e = 0; e < 8; ++e) acc[e] = 0.f;
        for (int tt = lo; tt < hi; ++tt) {
            const u32x4 v = *(const u32x4*)(U + (size_t)(base + tt) * DI + col);
            acc[0] += bflo(v.x); acc[1] += bfhi(v.x); acc[2] += bflo(v.y); acc[3] += bfhi(v.y); acc[4] += bflo(v.z); acc[5] += bfhi(v.z); acc[6] += bflo(v.w); acc[7] += bfhi(v.w);
        }
        const float ic = 1.0f / (float)(hi - lo);
        const u32x4 c = *(const u32x4*)(U + (size_t)row * DI + col);
        u32x4 o; o.x = pk2(acc[0] * ic - bflo(c.x), acc[1] * ic - bfhi(c.x)); o.y = pk2(acc[2] * ic - bflo(c.y), acc[3] * ic - bfhi(c.y));
        o.z = pk2(acc[4] * ic - bflo(c.z), acc[5] * ic - bfhi(c.z)); o.w = pk2(acc[6] * ic - bflo(c.w), acc[7] * ic - bfhi(c.w));
        *(u32x4*)(Pg + ((size_t)g * MTOT + row) * 1024 + (col & 1023)) = o;
    }
}

__device__ __forceinline__ void hgate_phase(const Args& a, int G) {
    const bf16_t* Of = (const bf16_t*)(a.ws + WS_S0 + SLOT); const bf16_t* Ob = (const bf16_t*)(a.ws + WS_S0 + 4 * SLOT);
    const bf16_t* SZ = (const bf16_t*)(a.ws + WS_S0 + 2 * SLOT); bf16_t* GT = (bf16_t*)(a.ws + WS_S0);
    const float* gn = a.in[17];
    const int gt = blockIdx.x * NTHR + my_tid(), gsz = G * NTHR;
    for (int idx = gt; idx < MTOT * 512; idx += gsz) {
        const int row = idx >> 9, col = (idx & 511) * 8; const size_t off = (size_t)row * DI + col;
        const u32x4 f = *(const u32x4*)(Of + off), bk = *(const u32x4*)(Ob + off), z = *(const u32x4*)(SZ + off);
        float o[8];
        o[0] = bflo(f.x) + bflo(bk.x); o[1] = bfhi(f.x) + bfhi(bk.x); o[2] = bflo(f.y) + bflo(bk.y); o[3] = bfhi(f.y) + bfhi(bk.y);
        o[4] = bflo(f.z) + bflo(bk.z); o[5] = bfhi(f.z) + bfhi(bk.z); o[6] = bflo(f.w) + bflo(bk.w); o[7] = bfhi(f.w) + bfhi(bk.w);
        float ss = 0.f;
#pragma unroll
        for (int e = 0; e < 8; ++e) ss += o[e] * o[e];
        ss += __shfl_xor(ss, 1); ss += __shfl_xor(ss, 2); ss += __shfl_xor(ss, 4); ss += __shfl_xor(ss, 8);
        const float rstd = rsqrtf(ss * (1.0f / 128.0f) + EPS);
        const f32x4 g0 = *(const f32x4*)(gn + col), g1 = *(const f32x4*)(gn + col + 4);
        u32x4 w;
        w.x = pk2(o[0] * rstd * g0.x * bflo(z.x), o[1] * rstd * g0.y * bfhi(z.x)); w.y = pk2(o[2] * rstd * g0.z * bflo(z.y), o[3] * rstd * g0.w * bfhi(z.y));
        w.z = pk2(o[4] * rstd * g1.x * bflo(z.z), o[5] * rstd * g1.y * bfhi(z.z)); w.w = pk2(o[6] * rstd * g1.z * bflo(z.w), o[7] * rstd * g1.w * bfhi(z.w));
        *(u32x4*)(GT + off) = w;
    }
}

constexpr int SC_QT = 0, SC_KT = 8704, SC_KH = 17408, SC_DEC = 27648, SC_BUF = 28160, SC_TOT = 2 * SC_BUF;
struct ScanRaw { float lf[8]; unsigned short qs[8]; };

__device__ __forceinline__ void scan_chunk_t0(int cj, int b, int dir, int& t0) {
    const bool isctx = cj < 8;
    const int cc = isctx ? (dir ? 7 - cj : cj) : (dir ? 71 - cj : cj - 8);
    t0 = isctx ? MLAT + b * CTX + 32 * cc : b * SEQ + 32 * cc;
}

__device__ __forceinline__ void scan_phase(const Args& a, LAS unsigned char* lds, int G) {
    const int tid = my_tid(), wave = tid >> 6, lane = tid & 63, fr = lane & 15, fq = lane >> 4;
    const bf16_t* QS = (const bf16_t*)(a.ws + WS_S0); const bf16_t* Vt = (const bf16_t*)(a.ws + WS_S0 + 3 * SLOT);
    const int kch = tid & 127, part = tid >> 7;
    for (int sidx = blockIdx.x; sidx < 256; sidx += G) {
        const int dir = sidx & 1, h = (sidx >> 1) & 31, b = sidx >> 6;
        const float* LF = (const float*)(a.ws + WS_S0 + (dir ? 7 : 5) * SLOT);
        bf16_t* O = (bf16_t*)(a.ws + WS_S0 + (dir ? 4 : 1) * SLOT);
        f32x4 S[8];
#pragma unroll
        for (int k = 0; k < 8; ++k) S[k] = (f32x4){0.f, 0.f, 0.f, 0.f};
        float rlf[8]; unsigned short rqs[8]; bf16x8 vfn;
#define SCAN_RAW(cj) do { int _t0; scan_chunk_t0((cj), b, dir, _t0); \
        _Pragma("unroll") for (int e = 0; e < 8; ++e) { const int tau = 8 * part + e; const int tok = dir ? _t0 + 31 - tau : _t0 + tau; \
            rlf[e] = LF[(size_t)tok * DI + h * 128 + kch]; rqs[e] = QS[(size_t)tok * DI + h * 128 + kch]; } \
        vfn = *(const bf16x8*)(Vt + (size_t)(h * 128 + 16 * wave + fr) * MTOT + (dir ? _t0 + 24 - 8 * fq : _t0 + 8 * fq)); } while (0)
#define SCAN_PREP(bufp) do { LAS unsigned char* _B = (bufp); LAS float* TOT = (LAS float*)(lds + SC_TOT); \
        float cs[8]; float run = 0.f; \
        _Pragma("unroll") for (int e = 0; e < 8; ++e) { run += rlf[e]; cs[e] = run; } \
        TOT[part * 128 + kch] = run; __syncthreads(); \
        float off = 0.f, bend = 0.f; \
        _Pragma("unroll") for (int p = 0; p < 4; ++p) { const float tv = TOT[p * 128 + kch]; off += (p < part) ? tv : 0.f; bend += tv; } \
        unsigned kh[8]; \
        _Pragma("unroll") for (int e = 0; e < 8; ++e) { const int tau = 8 * part + e; const float bt = off + cs[e]; const float kf = 1.0f - __expf(rlf[e]); \
            const float qv = __uint_as_float(((unsigned)rqs[e]) << 16) * __expf(bt); const float kt = kf * __expf(-bt); const float kk = kf * __expf(bend - bt); \
            ((LAS bf16_t*)(_B + SC_QT))[tau * 136 + kch] = (bf16_t)(pk2(qv, 0.f) & 0xffffu); ((LAS bf16_t*)(_B + SC_KT))[tau * 136 + kch] = (bf16_t)(pk2(kt, 0.f) & 0xffffu); kh[e] = pk2(kk, 0.f) & 0xffffu; } \
        u32x4 kw; kw.x = kh[0] | (kh[1] << 16); kw.y = kh[2] | (kh[3] << 16); kw.z = kh[4] | (kh[5] << 16); kw.w = kh[6] | (kh[7] << 16); \
        *(LAS u32x4*)(_B + SC_KH + kch * 80 + part * 16) = kw; \
        if (part == 0) ((LAS float*)(_B + SC_DEC))[kch] = __expf(bend); } while (0)

        SCAN_RAW(0);
        SCAN_PREP(lds);
        bf16x8 vf = vfn;
        SCAN_RAW(1);
        __syncthreads();
        for (int ci = 0; ci < 72; ++ci) {
            LAS unsigned char* B = lds + (ci & 1) * SC_BUF;
            bf16x8 vf_next = vfn;
            if (ci + 1 < 72) { SCAN_PREP(lds + ((ci + 1) & 1) * SC_BUF); }
            if (ci + 2 < 72) { SCAN_RAW(ci + 2); }
            int t0; scan_chunk_t0(ci, b, dir, t0);
            bf16x8 vcur = vf;
            if (dir) { bf16x8 t = vf; vcur[0] = t[7]; vcur[1] = t[6]; vcur[2] = t[5]; vcur[3] = t[4]; vcur[4] = t[3]; vcur[5] = t[2]; vcur[6] = t[1]; vcur[7] = t[0]; }
            bf16x8 qb[2][4];
#pragma unroll
            for (int tb = 0; tb < 2; ++tb)
#pragma unroll
                for (int c = 0; c < 4; ++c) qb[tb][c] = *(const LAS bf16x8*)(B + SC_QT + ((16 * tb + fr) * 136 + 32 * c + 8 * fq) * 2);
            f32x4 att[2][2];
#pragma unroll
            for (int sb = 0; sb < 2; ++sb) {
                att[sb][0] = (f32x4){0.f, 0.f, 0.f, 0.f}; att[sb][1] = (f32x4){0.f, 0.f, 0.f, 0.f};
                const int srow = 8 * (fr >> 2) + 4 * sb + (fr & 3);
#pragma unroll
                for (int c = 0; c < 4; ++c) {
                    const bf16x8 ka = *(const LAS bf16x8*)(B + SC_KT + (srow * 136 + 32 * c + 8 * fq) * 2);
                    att[sb][0] = __builtin_amdgcn_mfma_f32_16x16x32_bf16(ka, qb[0][c], att[sb][0], 0, 0, 0);
                    att[sb][1] = __builtin_amdgcn_mfma_f32_16x16x32_bf16(ka, qb[1][c], att[sb][1], 0, 0, 0);
                }
            }
            f32x4 OT[2];
#pragma unroll
            for (int tb = 0; tb < 2; ++tb) {
                const int t = 16 * tb + fr;
#pragma unroll
                for (int sb = 0; sb < 2; ++sb)
#pragma unroll
                    for (int i = 0; i < 4; ++i) { const int sa = 8 * fq + 4 * sb + i; att[sb][tb][i] = (sa <= t) ? att[sb][tb][i] : 0.f; }
                union { u32x4 u; bf16x8 v; } P; P.u.x = pk2(att[0][tb][0], att[0][tb][1]); P.u.y = pk2(att[0][tb][2], att[0][tb][3]); P.u.z = pk2(att[1][tb][0], att[1][tb][1]); P.u.w = pk2(att[1][tb][2], att[1][tb][3]);
                OT[tb] = __builtin_amdgcn_mfma_f32_16x16x32_bf16(vcur, P.v, (f32x4){0.f, 0.f, 0.f, 0.f}, 0, 0, 0);
            }
#pragma unroll
            for (int c = 0; c < 4; ++c) {
                union { u32x4 u; bf16x8 v; } SF; SF.u.x = pk2(S[2 * c][0], S[2 * c][1]); SF.u.y = pk2(S[2 * c][2], S[2 * c][3]); SF.u.z = pk2(S[2 * c + 1][0], S[2 * c + 1][1]); SF.u.w = pk2(S[2 * c + 1][2], S[2 * c + 1][3]);
                OT[0] = __builtin_amdgcn_mfma_f32_16x16x32_bf16(SF.v, qb[0][c], OT[0], 0, 0, 0);
                OT[1] = __builtin_amdgcn_mfma_f32_16x16x32_bf16(SF.v, qb[1][c], OT[1], 0, 0, 0);
            }
#pragma unroll
            for (int kb = 0; kb < 8; ++kb) {
                const int krow = 32 * (kb >> 1) + 8 * (fr >> 2) + 4 * (kb & 1) + (fr & 3);
                const bf16x8 ka = *(const LAS bf16x8*)(B + SC_KH + krow * 80 + fq * 16);
                const f32x4 dc = *(const LAS f32x4*)(B + SC_DEC + (32 * (kb >> 1) + 8 * fq + 4 * (kb & 1)) * 4);
                S[kb] = __builtin_amdgcn_mfma_f32_16x16x32_bf16(ka, vcur, S[kb] * dc, 0, 0, 0);
            }
#pragma unroll
            for (int tb = 0; tb < 2; ++tb) {
                const int tau = 16 * tb + fr; const int tok = dir ? t0 + 31 - tau : t0 + tau;
                u32x2 w; w.x = pk2(OT[tb][0], OT[tb][1]); w.y = pk2(OT[tb][2], OT[tb][3]);
                *(u32x2*)(O + (size_t)tok * DI + h * 128 + 16 * wave + 4 * fq) = w;
            }
            vf = vf_next;
            __syncthreads();
        }
#undef SCAN_RAW
#undef SCAN_PREP
    }
}

#define XB_TMO      128
#define XB_XCNT(j)  (256  + 64 * (j))
#define XB_XSUB(j)  (1280 + 64 * (j))
#define XB_XGEN(j)  (2304 + 64 * (j))
#define XB_TOP      3328
#define XB_TOPGEN   3392
#define XCD_BAR_WORDS 3456
#define XB_SPIN_CAP (1u << 18)

__device__ __forceinline__ unsigned xb_ld(unsigned* p)              { return __hip_atomic_load(p, __ATOMIC_RELAXED, __HIP_MEMORY_SCOPE_AGENT); }
__device__ __forceinline__ unsigned xb_add(unsigned* p, unsigned v) { return __hip_atomic_fetch_add(p, v, __ATOMIC_RELAXED, __HIP_MEMORY_SCOPE_AGENT); }
__device__ __forceinline__ unsigned xb_xcc_id() { return (unsigned)__builtin_amdgcn_s_getreg((3 << 11) | 20) & 0xFu; }
#define XB_SPIN(cond, bar) do { unsigned _sp = 0; while (cond) { __builtin_amdgcn_s_sleep(1); \
    if ((++_sp & 255u) == 0u) { if (xb_ld(&(bar)[XB_TMO])) break; if (_sp > XB_SPIN_CAP) { atomicAdd(&(bar)[XB_TMO], 1u); break; } } } } while (0)

struct XcdBarrier {
    unsigned* bar; unsigned x;
    volatile LAS unsigned* st;
};

__device__ __forceinline__ XcdBarrier xcd_barrier_post(unsigned* bar, volatile LAS unsigned* st) {
    XcdBarrier b; b.bar = bar; b.x = xb_xcc_id(); b.st = st;
    if (threadIdx.x == 0) (void)xb_add(&bar[XB_XCNT(b.x)], 1u);
    return b;
}
__device__ __forceinline__ void xcd_barrier_complete(unsigned* bar, unsigned x, unsigned& nloc, unsigned& nx) {
    const unsigned G = gridDim.x * gridDim.y * gridDim.z;
    unsigned sum, cnt, mine, sp = 0u;
    for (;;) {
        sum = 0u; cnt = 0u; mine = 0u;
#pragma unroll
        for (unsigned j = 0; j < 16; ++j) { const unsigned c = xb_ld(&bar[XB_XCNT(j)]); sum += c; cnt += (c > 0u) ? 1u : 0u; mine = (j == x) ? c : mine; }
        if (sum == G) break;
        __builtin_amdgcn_s_sleep(1);
        if ((++sp & 255u) == 0u) { if (xb_ld(&bar[XB_TMO])) break; if (sp > XB_SPIN_CAP) { atomicAdd(&bar[XB_TMO], 1u); break; } }
    }
    nloc = mine > 0u ? mine : 1u; nx = cnt > 0u ? cnt : 1u;
}

__device__ __forceinline__ void xcd_barrier(const XcdBarrier& b) {
    asm volatile("s_waitcnt vmcnt(0)" ::: "memory");
    __syncthreads();
    if (threadIdx.x == 0) {
        unsigned* bar = b.bar;
        __builtin_amdgcn_s_waitcnt(0);
        unsigned nloc = b.st[0], nx = b.st[1];
        if (nloc == 0u) { xcd_barrier_complete(bar, b.x, nloc, nx); b.st[0] = nloc; b.st[1] = nx; }
        const unsigned old = xb_add(&bar[XB_XSUB(b.x)], 1u);
        const unsigned gen = old / nloc;
        if (old + 1u == (gen + 1u) * nloc) {
            __builtin_amdgcn_fence(__ATOMIC_RELEASE, "agent");
            asm volatile("s_waitcnt vmcnt(0)" ::: "memory");
            const unsigned og = xb_add(&bar[XB_TOP], 1u);
            const unsigned tg = og / nx;
            if (og + 1u == (tg + 1u) * nx) xb_add(&bar[XB_TOPGEN], 1u);
            else XB_SPIN(xb_ld(&bar[XB_TOPGEN]) == tg, bar);
            __builtin_amdgcn_fence(__ATOMIC_ACQUIRE, "agent");
            xb_add(&bar[XB_XGEN(b.x)], 1u);
            asm volatile("s_waitcnt vmcnt(0)" ::: "memory");
        } else {
            XB_SPIN(xb_ld(&bar[XB_XGEN(b.x)]) == gen, bar);
            __builtin_amdgcn_fence(__ATOMIC_ACQUIRE, "agent");
            asm volatile("s_waitcnt vmcnt(0)" ::: "memory");
        }
    }
    __syncthreads();
}


enum { OP_INIT = 0, OP_ROW = 1, OP_G1 = 2, OP_ATT = 3, OP_POOL = 4, OP_GG = 5, OP_SCAN = 6, OP_GATE = 7, OP_G2 = 8, OP_FINAL = 9 };
constexpr int NPHASE = 20;
constexpr int JOB_OFF = LDS_BYTES - 4096;
constexpr int BAR_ST_OFF = LDS_BYTES - 16;

__global__ void __launch_bounds__(NTHR, 2) fwd_mega(Args a0) {
    extern __shared__ __attribute__((aligned(16))) unsigned char lds_raw[];
    LAS unsigned char* lds = (LAS unsigned char*)lds_raw;
    cg::grid_group grid = cg::this_grid();
    const int G = gridDim.x, bid = blockIdx.x;
    if (a0.ws == nullptr) grid.sync();
    if (threadIdx.x == 0) {
        unsigned char* ws = a0.ws;
        bf16_t* H = (bf16_t*)(ws + WS_H); bf16_t* WIN = (bf16_t*)(ws + WS_WIN); bf16_t* WOUT = (bf16_t*)(ws + WS_WOUT); bf16_t* WG = (bf16_t*)(ws + WS_WG);
        const float* LB = (const float*)(ws + WS_LB);
        const int BIG = 1 << 30;
#define SLW(i) (ws + WS_S0 + (size_t)(i) * SLOT)
#define JW(gi, J0, J1, K, n0, n1) do { LAS unsigned char* p_ = lds + JOB_OFF + (gi) * 256; pg8::job_write(p_, J0); pg8::job_write(p_ + 128, J1); *(LAS int*)(p_ + 96) = (K); *(LAS int*)(p_ + 100) = (n0); *(LAS int*)(p_ + 104) = (n1); } while (0)
        const pg8::Job na0{H, WIN, 36, 48, BIG, 0, 4096, 0x271, SLW(0), SLW(1), SLW(2), nullptr, DI, nullptr, nullptr};
        const pg8::Job na1{WIN + (size_t)12288 * DM, H, 16, 36, BIG, 0, BIG, 0x8, SLW(3), nullptr, nullptr, nullptr, MTOT, nullptr, nullptr};
        const pg8::Job g2a{(const bf16_t*)SLW(4), WOUT, 36, 8, BIG, 0, BIG, 0x0, SLW(5), nullptr, nullptr, nullptr, DM, nullptr, nullptr};
        const pg8::Job g2c{(const bf16_t*)SLW(0), WOUT, 36, 8, BIG, 0, BIG, 0x0, SLW(5), nullptr, nullptr, nullptr, DM, nullptr, nullptr};
        const pg8::Job g2l{(const bf16_t*)SLW(4), WOUT, 32, 8, BIG, 0, BIG, 0x0, SLW(5), nullptr, nullptr, nullptr, DM, nullptr, nullptr};
        const pg8::Job p0{H, WIN, 36, 32, BIG, 0, 4096, 0x20, SLW(0), SLW(2), nullptr, nullptr, DI, nullptr, nullptr};
        const pg8::Job pg{(const bf16_t*)SLW(1), WG, 36, 16, 4, (size_t)MTOT * 1024, BIG, 0x6, SLW(4), nullptr, nullptr, nullptr, DI, a0.in[13], (const bf16_t*)SLW(2)};
        const pg8::Job h0{H, WIN, 36, 64, BIG, 0, 4096, 0x2432, SLW(0), SLW(5), SLW(7), SLW(2), DI, LB, nullptr};
        const pg8::Job h1{WIN + (size_t)16384 * DM, H, 16, 36, BIG, 0, BIG, 0x0, SLW(3), nullptr, nullptr, nullptr, MTOT, nullptr, nullptr};
        JW(0, na0, na1, DM, 36 * 48, 16 * 36); JW(1, g2a, g2a, DI, 36 * 8, 0);
        JW(2, p0, p0, DM, 36 * 32, 0); JW(3, pg, pg, 1024, 36 * 16, 0); JW(4, g2a, g2a, DI, 36 * 8, 0);
        JW(5, h0, h1, DM, 36 * 64, 16 * 36); JW(6, g2c, g2c, DI, 36 * 8, 0);
        JW(7, na0, na1, DM, 36 * 48, 16 * 36); JW(8, g2l, g2l, DI, 32 * 8, 0);
#undef JW
#undef SLW
    }
    {
        volatile LAS unsigned* st0 = (volatile LAS unsigned*)(lds + BAR_ST_OFF);
        if (threadIdx.x < 2) st0[threadIdx.x] = 0u;
        __syncthreads();
    }
    const XcdBarrier xbar = xcd_barrier_post((unsigned*)a0.ws, (volatile LAS unsigned*)(lds + BAR_ST_OFF));
#define SL(i) (ws + WS_S0 + (size_t)(i) * SLOT)
    const int BIG = 1 << 30;

    for (int ph = 0; ph < NPHASE; ++ph) {
        int li, op;
        if (ph == 0) { li = 0; op = OP_INIT; }
        else if (ph < 5) { li = 0; const int k = ph - 1; op = k == 0 ? OP_ROW : (k == 1 ? OP_G1 : (k == 2 ? OP_ATT : OP_G2)); }
        else if (ph < 10) { li = 1; const int k = ph - 5; op = k == 0 ? OP_ROW : (k == 1 ? OP_G1 : (k == 2 ? OP_POOL : (k == 3 ? OP_GG : OP_G2))); }
        else if (ph < 15) { li = 2; const int k = ph - 10; op = k == 0 ? OP_ROW : (k == 1 ? OP_G1 : (k == 2 ? OP_SCAN : (k == 3 ? OP_GATE : OP_G2))); }
        else if (ph < 19) { li = 3; const int k = ph - 15; op = k == 0 ? OP_ROW : (k == 1 ? OP_G1 : (k == 2 ? OP_ATT : OP_G2)); }
        else { li = 4; op = OP_FINAL; }
        const int kind = li % 3; const bool need_ctx = li < 3;
#if DBG_NL < 4
        if (li > DBG_NL || (li == DBG_NL && op != OP_ROW)) continue;
#endif
        int zero_ = 0; LAUNDER_S(zero_);
        Args a = a0;
#pragma unroll
        for (int i = 0; i < 19; ++i) a.in[i] = a0.in[i] + zero_;
        a.out = a0.out + zero_; a.ws = a0.ws + zero_;
        unsigned char* ws = a.ws;
        int tid_ = threadIdx.x; asm volatile("" : "+v"(tid_));
        const int tid = tid_, wave = __builtin_amdgcn_readfirstlane(tid >> 6), lane = tid & 63;
        const int gw = bid * NWAVES + wave, NGW = G * NWAVES;
        int gK = 0, gn0 = 0, gn1 = 0; const LAS unsigned char* jt = lds + JOB_OFF;
        if (op == OP_INIT) {
#ifdef ZERO_WS
            {
                u32x4* p = (u32x4*)(ws + WS_MOD); const size_t n16 = (WS_END - WS_MOD) / 16;
                for (size_t i = (size_t)bid * NTHR + tid; i < n16; i += (size_t)G * NTHR) p[i] = (u32x4){0u, 0u, 0u, 0u};
            }
#endif
#ifndef NO_MISC
            init_phase(a, lds, G);
            __syncthreads();
            transpose_layer(a, 0, lds, gw, NGW, wave, lane);
#ifdef PROBE_TR
            transpose_layer(a, 0, lds, gw, NGW, wave, lane);
#endif
#endif
        } else if (op == OP_ROW || op == OP_FINAL) {
#ifndef NO_MISC
            row_phase(a, li, lds, G, tid, wave, lane);
            __syncthreads();
            if (li > 0 && li < 4) transpose_layer(a, li, lds, gw, NGW, wave, lane);
#ifdef PROBE_TR
            if (li > 0 && li < 4) transpose_layer(a, li, lds, gw, NGW, wave, lane);
#endif
#endif
        } else if (op == OP_ATT) {
#ifndef NO_ATTN
            attn_phase(a, li, lds, G, need_ctx ? 1 : 0);
#ifdef PROBE_ATT
            attn_phase(a, li, lds, G, need_ctx ? 1 : 0);
#endif
#endif
        } else if (op == OP_POOL) {
#ifndef NO_MISC
            pool_phase(a, G);
#endif
        } else if (op == OP_SCAN) {
#ifndef NO_SCAN
            scan_phase(a, lds, G);
#ifdef PROBE_SCAN
            scan_phase(a, lds, G);
#endif
#endif
        } else if (op == OP_GATE) {
#ifndef NO_MISC
            hgate_phase(a, G);
#endif
        } else {
            const int gi = li == 0 ? (op == OP_G1 ? 0 : 1) : (li == 1 ? (op == OP_G1 ? 2 : (op == OP_GG ? 3 : 4)) : (li == 2 ? (op == OP_G1 ? 5 : 6) : (op == OP_G1 ? 7 : 8)));
            jt = lds + JOB_OFF + gi * 256;
            gK = pg8::jl_i(jt + 96); gn0 = pg8::jl_i(jt + 100); gn1 = pg8::jl_i(jt + 104);
        }
#ifndef NO_GEMM
        if (gK) pg8::gemm_phase(lds, jt, gK, gn0, gn1, G, bid);
#ifdef PROBE_G2
        if (gK && op == OP_G2) { __syncthreads(); pg8::gemm_phase(lds, jt, gK, gn0, gn1, G, bid); }
#endif
#endif
        if (ph + 1 < NPHASE) xcd_barrier(xbar);
    }
#undef SL
}

extern "C" void kernel_launch(void* const* d_in, const int* in_sizes, int n_in, void* d_out, int out_size, void* d_ws, size_t ws_size, hipStream_t stream) {
    static int grid = 0;
    if (grid == 0) {
        if (n_in != 19 || out_size != MLAT * DM || ws_size < WS_END) { fprintf(stderr, "kernel_launch: unexpected shapes n_in %d out %d ws %zu (need %zu)\n", n_in, out_size, ws_size, (size_t)WS_END); grid = -1; return; }
        int dev = 0, cus = 0, per_cu = 0;
        (void)hipGetDevice(&dev);
        (void)hipDeviceGetAttribute(&cus, hipDeviceAttributeMultiprocessorCount, dev);
        (void)hipFuncSetAttribute((const void*)fwd_mega, hipFuncAttributeMaxDynamicSharedMemorySize, LDS_BYTES);
        (void)hipOccupancyMaxActiveBlocksPerMultiprocessor(&per_cu, (const void*)fwd_mega, NTHR, LDS_BYTES);
        fprintf(stderr, "cus %d per_cu %d ws %zu\n", cus, per_cu, ws_size);
        grid = cus > 0 ? cus : 256;
    }
    if (grid < 0) return;
    (void)hipMemsetAsync(d_ws, 0, 65536, stream);
    Args a{};
    for (int i = 0; i < 19; ++i) a.in[i] = (const float*)d_in[i];
    a.out = (float*)d_out; a.ws = (unsigned char*)d_ws;
    void* args[] = {&a};
    hipError_t e = hipLaunchCooperativeKernel((const void*)fwd_mega, dim3(grid), dim3(NTHR), args, LDS_BYTES, stream);
    if (e != hipSuccess) fprintf(stderr, "cooperative launch failed: %s (grid %d)\n", hipGetErrorString(e), grid);
}
```

```cpp
#ifndef DBG_NL
#define DBG_NL 4
#endif
#include <hip/hip_runtime.h>
#include <hip/hip_cooperative_groups.h>
#include <cstdio>
#include <cstdint>
namespace cg = cooperative_groups;

#define LAS __attribute__((address_space(3)))
#define GAS __attribute__((address_space(1)))
typedef unsigned short bf16_t;
typedef short bf16x8 __attribute__((ext_vector_type(8)));
typedef float f32x4 __attribute__((ext_vector_type(4)));
typedef unsigned u32x4 __attribute__((ext_vector_type(4)));
typedef unsigned u32x2 __attribute__((ext_vector_type(2)));

constexpr int DM = 2048, NB = 4, SEQ = 2048, CTX = 256, DI = 4096;
constexpr int MLAT = NB * SEQ, MCTX = NB * CTX, MTOT = MLAT + MCTX;
constexpr float EPS = 1e-6f;
constexpr int NTHR = 512, NWAVES = 8;
constexpr int LDS_BYTES = 147456;

constexpr size_t MiB = 1u << 20;
constexpr size_t WS_MOD = 1 * MiB;
constexpr size_t WS_LB = WS_MOD + 512 * 1024;
constexpr size_t WS_XC = 2 * MiB;
constexpr size_t WS_H = 10 * MiB;
constexpr size_t WS_WIN = 46 * MiB;
constexpr size_t WS_WOUT = 126 * MiB;
constexpr size_t WS_WG = 142 * MiB;
constexpr size_t WS_S0 = 150 * MiB;
constexpr size_t SLOT = 72 * MiB;
constexpr size_t WS_END = WS_S0 + 9 * SLOT;

typedef __bf16 bf2_t __attribute__((ext_vector_type(2)));
__device__ __forceinline__ unsigned pk2(float lo, float hi) { bf2_t v; v.x = (__bf16)lo; v.y = (__bf16)hi; return __builtin_bit_cast(unsigned, v); }
__device__ __forceinline__ float bflo(unsigned w) { return __uint_as_float(w << 16); }
__device__ __forceinline__ float bfhi(unsigned w) { return __uint_as_float(w & 0xffff0000u); }
__device__ __forceinline__ float fast_exp(float x) { return __expf(x); }
__device__ __forceinline__ float silu_f(float x) { return x * __builtin_amdgcn_rcpf(1.0f + __expf(-x)); }
__device__ __forceinline__ float wave_sum(float v) {
#pragma unroll
    for (int o = 1; o < 64; o <<= 1) v += __shfl_xor(v, o);
    return v;
}
#define LDS_WAIT() asm volatile("s_waitcnt lgkmcnt(0)" ::: "memory")
#define LAUNDER_V(x) asm volatile("" : "+v"(x))
#define LAUNDER_S(x) asm volatile("" : "+s"(x))
__device__ __forceinline__ int my_tid() { int t = threadIdx.x; LAUNDER_V(t); return t; }

namespace pg8 {
constexpr int BM = 256, BK = 64, HALF = 128, HTB = HALF * BK * 2, STAGE_BYTES = 8 * HTB, NXCD = 8, WGM = 8;
__device__ __forceinline__ int lds_byte(int r, int c) { const int st = (r >> 4) * 2 + (c >> 5), rr = r & 15, cc = c & 31, ob = rr * 64 + cc * 2; return st * 1024 + (ob ^ (((ob >> 9) & 1) << 5)); }
__device__ __forceinline__ void stage_rc(int b, int& R, int& C) { const int st = b / 1024, sb = b % 1024, swz = sb ^ (((sb >> 9) & 1) << 5); R = (st >> 1) * 16 + swz / 64; C = (st & 1) * 32 + (swz % 64) / 2; }
__device__ __forceinline__ int perm32(int rho) { const int n = rho >> 4, i = rho & 15; return 8 * (i >> 2) + 4 * n + (i & 3); }

struct Job {
    const bf16_t* A; const bf16_t* Bt; int nM, nN; int agdiv; size_t agstride;
    int segw; int acts; void* o0; void* o1; void* o2; void* o3; int ldo;
    const float* aux_f; const bf16_t* aux_b;
};
__device__ __forceinline__ void job_write(LAS unsigned char* p, const Job& J) {
    *(LAS unsigned long long*)(p + 0) = (unsigned long long)J.A; *(LAS unsigned long long*)(p + 8) = (unsigned long long)J.Bt;
    *(LAS int*)(p + 16) = J.nM; *(LAS int*)(p + 20) = J.nN; *(LAS int*)(p + 24) = J.agdiv; *(LAS int*)(p + 28) = J.ldo;
    *(LAS unsigned long long*)(p + 32) = (unsigned long long)J.agstride; *(LAS int*)(p + 40) = J.segw; *(LAS int*)(p + 44) = J.acts;
    *(LAS unsigned long long*)(p + 48) = (unsigned long long)J.o0; *(LAS unsigned long long*)(p + 56) = (unsigned long long)J.o1;
    *(LAS unsigned long long*)(p + 64) = (unsigned long long)J.o2; *(LAS unsigned long long*)(p + 72) = (unsigned long long)J.o3;
    *(LAS unsigned long long*)(p + 80) = (unsigned long long)J.aux_f; *(LAS unsigned long long*)(p + 88) = (unsigned long long)J.aux_b;
}
__device__ __forceinline__ int jl_i(const LAS unsigned char* p) { return __builtin_amdgcn_readfirstlane(*(const LAS int*)p); }
__device__ __forceinline__ unsigned long long jl_p(const LAS unsigned char* p) {
    const unsigned lo = (unsigned)__builtin_amdgcn_readfirstlane(*(const LAS int*)p), hi = (unsigned)__builtin_amdgcn_readfirstlane(*(const LAS int*)(p + 4));
    return ((unsigned long long)hi << 32) | lo;
}
struct Unit { int job, pm, pn; };

__device__ __forceinline__ void decode_tile(int l, int nM, int nN, int& pm, int& pn) {
    const int nwg = nM * nN; int wgid = l;
    { const int q = nwg / NXCD, r = nwg % NXCD, xcd = wgid % NXCD, off = wgid / NXCD; wgid = (xcd < r ? xcd * (q + 1) : r * (q + 1) + (xcd - r) * q) + off; }
    const int nig = WGM * nN, gid = wgid / nig, fm = gid * WGM, gsz = (nM - fm) < WGM ? (nM - fm) : WGM;
    pm = fm + ((wgid % nig) % gsz); pn = (wgid % nig) / gsz;
}

__device__ __forceinline__ void store_bf8(GAS bf16_t* p, const f32x4& v0, const f32x4& v1) {
    u32x4 w; w.x = pk2(v0[0], v0[1]); w.y = pk2(v0[2], v0[3]); w.z = pk2(v1[0], v1[1]); w.w = pk2(v1[2], v1[3]);
    *(GAS u32x4*)p = w;
}

__device__ __forceinline__ void epilogue(const f32x4 (&acc)[2][2][4][2], const LAS unsigned char* jt, const Unit& u, int wr, int wc, int fr_, int fq_) {
    int fr = fr_, fq = fq_; asm volatile("" : "+v"(fr), "+v"(fq));
    const LAS unsigned char* jp = jt + u.job * 128;
    const int segw = jl_i(jp + 40), acts = jl_i(jp + 44);
    const int colt = u.pn * BM; const int seg = colt / segw; const int act = (acts >> (4 * seg)) & 15;
    GAS unsigned char* op = (GAS unsigned char*)jl_p(jp + 48 + 8 * seg);
    const int col0 = colt - seg * segw + wc * 32 + 8 * fq;
    const int row0 = u.pm * BM + wr * 64 + fr;
    const int ldo = jl_i(jp + 28);
    const GAS float* aux_f = (const GAS float*)jl_p(jp + 80); const GAS bf16_t* aux_b = (const GAS bf16_t*)jl_p(jp + 88);
    if (act <= 2) {
        GAS bf16_t* O = (GAS bf16_t*)op;
#pragma unroll
        for (int ai = 0; ai < 2; ++ai)
#pragma unroll
            for (int m = 0; m < 4; ++m) {
                GAS bf16_t* rowp = O + (size_t)(row0 + ai * HALF + m * 16) * ldo + col0;
#pragma unroll
                for (int bj = 0; bj < 2; ++bj) {
                    f32x4 v0 = acc[ai][bj][m][0], v1 = acc[ai][bj][m][1];
                    if (act == 1) { v0 *= 0.08838834764831845f; v1 *= 0.08838834764831845f; }
                    if (act == 2) {
#pragma unroll
                        for (int j = 0; j < 4; ++j) { v0[j] = silu_f(v0[j]); v1[j] = silu_f(v1[j]); }
                    }
                    store_bf8(rowp + bj * HALF, v0, v1);
                }
            }
    } else if (act == 7) {
        GAS bf16_t* O = (GAS bf16_t*)op;
#pragma unroll
        for (int ai = 0; ai < 2; ++ai)
#pragma unroll
            for (int m = 0; m < 4; ++m) {
                const int token = row0 + ai * HALF + m * 16;
#pragma unroll
                for (int bj = 0; bj < 2; ++bj) {
                    const int col = col0 + bj * HALF, hd = col >> 7, d0 = col & 127;
                    store_bf8(O + ((size_t)(token >> 3) * 32 + hd) * 1024 + (d0 >> 4) * 128 + (token & 7) * 16 + ((d0 >> 3) & 1) * 8, acc[ai][bj][m][0], acc[ai][bj][m][1]);
                }
            }
    } else if (act == 8) {
        GAS bf16_t* O = (GAS bf16_t*)op;
#pragma unroll
        for (int ai = 0; ai < 2; ++ai)
#pragma unroll
            for (int m = 0; m < 4; ++m) {
                const int rr = row0 + ai * HALF + m * 16;
#pragma unroll
                for (int bj = 0; bj < 2; ++bj) {
                    const int t0 = col0 + bj * HALF;
                    store_bf8(O + ((size_t)(t0 >> 3) * 32 + (rr >> 7)) * 1024 + (rr & 127) * 8, acc[ai][bj][m][0], acc[ai][bj][m][1]);
                }
            }
    } else if (act == 3 || act == 4) {
        GAS float* O = (GAS float*)op;
        const GAS float* lbp = aux_f + (act - 3) * 4096 + col0;
#pragma unroll
        for (int bj = 0; bj < 2; ++bj) {
            const f32x4 l0 = *(const GAS f32x4*)(lbp + bj * HALF), l1 = *(const GAS f32x4*)(lbp + bj * HALF + 4);
#pragma unroll
            for (int ai = 0; ai < 2; ++ai)
#pragma unroll
                for (int m = 0; m < 4; ++m) {
                    GAS float* rowp = O + (size_t)(row0 + ai * HALF + m * 16) * ldo + col0 + bj * HALF;
                    f32x4 v0 = acc[ai][bj][m][0], v1 = acc[ai][bj][m][1];
#pragma unroll
                    for (int j = 0; j < 4; ++j) {
                        const float s0 = __builtin_amdgcn_rcpf(1.0f + __expf(-v0[j])), s1 = __builtin_amdgcn_rcpf(1.0f + __expf(-v1[j]));
                        v0[j] = __logf(l0[j] + (1.0f - l0[j]) * s0); v1[j] = __logf(l1[j] + (1.0f - l1[j]) * s1);
                    }
                    *(GAS f32x4*)rowp = v0; *(GAS f32x4*)(rowp + 4) = v1;
                }
        }
    } else if (act == 5) {
        GAS float* O = (GAS float*)op;
#pragma unroll
        for (int ai = 0; ai < 2; ++ai)
#pragma unroll
            for (int m = 0; m < 4; ++m) {
                GAS float* rowp = O + (size_t)(row0 + ai * HALF + m * 16) * ldo + col0;
#pragma unroll
                for (int bj = 0; bj < 2; ++bj) { *(GAS f32x4*)(rowp + bj * HALF) = acc[ai][bj][m][0]; *(GAS f32x4*)(rowp + bj * HALF + 4) = acc[ai][bj][m][1]; }
            }
    } else {
        GAS bf16_t* O = (GAS bf16_t*)op;
#pragma unroll
        for (int bj = 0; bj < 2; ++bj) {
            const f32x4 s0 = *(const GAS f32x4*)(aux_f + col0 + bj * HALF), s1 = *(const GAS f32x4*)(aux_f + col0 + bj * HALF + 4);
#pragma unroll
            for (int ai = 0; ai < 2; ++ai)
#pragma unroll
                for (int m = 0; m < 4; ++m) {
                    const size_t off = (size_t)(row0 + ai * HALF + m * 16) * ldo + col0 + bj * HALF;
                    const u32x4 z = *(const GAS u32x4*)(aux_b + off);
                    f32x4 v0 = acc[ai][bj][m][0] * s0, v1 = acc[ai][bj][m][1] * s1;
                    v0[0] *= bflo(z.x); v0[1] *= bfhi(z.x); v0[2] *= bflo(z.y); v0[3] *= bfhi(z.y);
                    v1[0] *= bflo(z.z); v1[1] *= bfhi(z.z); v1[2] *= bflo(z.w); v1[3] *= bfhi(z.w);
                    store_bf8(O + off, v0, v1);
                }
        }
    }
}

__device__ __forceinline__ bool next_unit(int i, int G, int c, const LAS unsigned char* jt, int n0, int n1, Unit& u) {
    const int L = i * G + c; if (L >= n0 + n1) return false;
    const int job = L < n0 ? 0 : 1; const LAS unsigned char* jp = jt + job * 128;
    u.job = job; decode_tile(job ? L - n0 : L, jl_i(jp + 16), jl_i(jp + 20), u.pm, u.pn);
    return true;
}
__device__ __forceinline__ const char* unit_a(const LAS unsigned char* jt, const Unit& u, size_t tstep) {
    const LAS unsigned char* jp = jt + u.job * 128;
    return (const char*)jl_p(jp + 0) + (size_t)(u.pn / jl_i(jp + 24)) * jl_p(jp + 32) * 2 + (size_t)u.pm * tstep;
}
__device__ __forceinline__ const char* unit_b(const LAS unsigned char* jt, const Unit& u, size_t tstep) {
    const LAS unsigned char* jp = jt + u.job * 128;
    return (const char*)jl_p(jp + 8) + (size_t)u.pn * tstep;
}

__device__ __forceinline__ void gemm_phase(LAS unsigned char* lds, const LAS unsigned char* jt, const int K, const int n0, const int n1, const int G, const int c) {
    int tid_ = threadIdx.x; asm volatile("" : "+v"(tid_));
    const int tid = tid_, wid = __builtin_amdgcn_readfirstlane(tid >> 6), lane = tid & 63, wr = wid >> 2, wc = wid & 3, fr = lane & 15, fq = lane >> 4;
    const int nt = K / BK;
    unsigned voffA[2], voffB[2];
#pragma unroll
    for (int i = 0; i < 2; ++i) { int R, C; stage_rc(tid * 16 + i * 8192, R, C); const int Rb = (R & ~31) + perm32(R & 31);
        voffA[i] = (unsigned)(R * K + C) * 2u; voffB[i] = (unsigned)(Rb * K + C) * 2u; }
    const size_t kstep = (size_t)(BK * 2);
    const size_t hstep = (size_t)HALF * K * 2;
    const size_t tstep = 2 * hstep;
    const unsigned ldsw = (unsigned)wid * 1024u;
    const int aoff = lds_byte(wr * 64 + fr, fq * 8), boff = lds_byte(wc * 32 + fr, fq * 8);
#define PG8_SA(b, h) (((b) * 2 + (h)) * HTB)
#define PG8_SB(b, h) ((4 + (b) * 2 + (h)) * HTB)
#define PG8_STAGE(bufoff, gbase, voff) do { _Pragma("unroll") for (int _i = 0; _i < 2; ++_i) \
        __builtin_amdgcn_global_load_lds((const unsigned*)((const char*)(gbase) + (voff)[_i]), (LAS unsigned*)(lds + (bufoff) + ldsw + _i * 8192), 16, 0, 0); } while (0)
#define PG8_LDA(dst, b, h) do { _Pragma("unroll") for (int m = 0; m < 4; ++m) _Pragma("unroll") for (int k = 0; k < 2; ++k) dst[m][k] = *(const LAS bf16x8*)(lds + PG8_SA(b, h) + aoff + m * 2048 + k * 1024); } while (0)
#define PG8_LDB(dst, b, h) do { _Pragma("unroll") for (int n = 0; n < 2; ++n) _Pragma("unroll") for (int k = 0; k < 2; ++k) dst[n][k] = *(const LAS bf16x8*)(lds + PG8_SB(b, h) + boff + n * 2048 + k * 1024); } while (0)
#define PG8_MMA(ai, bj, At, Bt) do { __builtin_amdgcn_s_setprio(1); _Pragma("unroll") for (int m = 0; m < 4; ++m) _Pragma("unroll") for (int n = 0; n < 2; ++n) _Pragma("unroll") for (int k = 0; k < 2; ++k) \
        acc[ai][bj][m][n] = __builtin_amdgcn_mfma_f32_16x16x32_bf16(Bt[n][k], At[m][k], acc[ai][bj][m][n], 0, 0, 0); __builtin_amdgcn_s_setprio(0); } while (0)
#define PG8_WAIT_V(n) asm volatile("s_waitcnt vmcnt(" #n ")" ::: "memory")
#define PG8_WAIT_L(n) asm volatile("s_waitcnt lgkmcnt(" #n ")" ::: "memory")
#define PG8_BAR __builtin_amdgcn_s_barrier()
#define PG8_SCHED __builtin_amdgcn_sched_barrier(0)
#define PG8_UA(u) unit_a(jt, (u), tstep)
#define PG8_UB(u) unit_b(jt, (u), tstep)
    Unit cur, nxt; int ui = 0;
    if (!next_unit(0, G, c, jt, n0, n1, cur)) return;
    f32x4 acc[2][2][4][2];
#pragma unroll
    for (int a = 0; a < 2; ++a)
#pragma unroll
        for (int b = 0; b < 2; ++b)
#pragma unroll
            for (int m = 0; m < 4; ++m)
#pragma unroll
                for (int n = 0; n < 2; ++n) acc[a][b][m][n] = (f32x4){0.f, 0.f, 0.f, 0.f};
    bf16x8 At[4][2], B0[2][2], B1[2][2];
    const char* cA = PG8_UA(cur); const char* cB = PG8_UB(cur);
    PG8_STAGE(PG8_SB(0, 0), cB, voffB); PG8_STAGE(PG8_SB(0, 1), cB + hstep, voffB); PG8_STAGE(PG8_SA(0, 0), cA, voffA); PG8_STAGE(PG8_SA(0, 1), cA + hstep, voffA);
    if (wr == 1) PG8_BAR;
    PG8_WAIT_V(2); PG8_BAR;
    PG8_STAGE(PG8_SB(1, 0), cB + kstep, voffB); PG8_STAGE(PG8_SA(1, 0), cA + kstep, voffA); PG8_STAGE(PG8_SB(1, 1), cB + hstep + kstep, voffB);
    PG8_WAIT_V(6); PG8_BAR;
    for (;;) {
        const bool has_next = next_unit(ui + 1, G, c, jt, n0, n1, nxt);
        const char* nA = cA; const char* nB = cB;
        if (has_next) { nA = PG8_UA(nxt); nB = PG8_UB(nxt); }
        for (int t = 0; t < nt; t += 2) {
            const bool last = (t == nt - 2);
            const char* a1 = cA + (size_t)(t + 1) * kstep;
            const char* a2 = last ? nA : cA + (size_t)(t + 2) * kstep; const char* b2 = last ? nB : cB + (size_t)(t + 2) * kstep;
            const char* a3 = a2 + kstep; const char* b3 = b2 + kstep;
            PG8_LDB(B0, 0, 0); PG8_LDB(B1, 0, 1); PG8_SCHED; PG8_LDA(At, 0, 0); PG8_STAGE(PG8_SA(1, 1), a1 + hstep, voffA);
            PG8_WAIT_V(8); PG8_WAIT_L(0); PG8_BAR; PG8_MMA(0, 0, At, B0); PG8_MMA(0, 1, At, B1); PG8_BAR; PG8_SCHED;
            PG8_LDA(At, 0, 1); PG8_STAGE(PG8_SB(0, 0), b2, voffB); PG8_STAGE(PG8_SB(0, 1), b2 + hstep, voffB); PG8_STAGE(PG8_SA(0, 0), a2, voffA);
            PG8_WAIT_V(8); PG8_WAIT_L(0); PG8_BAR; PG8_MMA(1, 0, At, B0); PG8_MMA(1, 1, At, B1); PG8_BAR; PG8_SCHED;
            PG8_LDB(B0, 1, 0); PG8_LDB(B1, 1, 1); PG8_SCHED; PG8_LDA(At, 1, 0); PG8_STAGE(PG8_SA(0, 1), a2 + hstep, voffA);
            PG8_WAIT_V(8); PG8_WAIT_L(0); PG8_BAR; PG8_MMA(0, 0, At, B0); PG8_MMA(0, 1, At, B1); PG8_BAR; PG8_SCHED;
            PG8_LDA(At, 1, 1); PG8_STAGE(PG8_SB(1, 0), b3, voffB); PG8_STAGE(PG8_SB(1, 1), b3 + hstep, voffB); PG8_STAGE(PG8_SA(1, 0), a3, voffA);
            PG8_WAIT_V(8); PG8_WAIT_L(0); PG8_BAR; PG8_MMA(1, 0, At, B0); PG8_MMA(1, 1, At, B1); PG8_BAR; PG8_SCHED;
        }
        if (wr == 0) PG8_BAR;
        epilogue(acc, jt, cur, wr, wc, fr, fq);
        if (!has_next) break;
#pragma unroll
        for (int a = 0; a < 2; ++a)
#pragma unroll
            for (int b = 0; b < 2; ++b)
#pragma unroll
                for (int m = 0; m < 4; ++m)
#pragma unroll
                    for (int n = 0; n < 2; ++n) acc[a][b][m][n] = (f32x4){0.f, 0.f, 0.f, 0.f};
        cur = nxt; cA = nA; cB = nB; ++ui;
        if (wr == 1) PG8_BAR;
    }
    PG8_WAIT_V(0);
    PG8_BAR;
#undef PG8_SA
#undef PG8_SB
#undef PG8_STAGE
#undef PG8_LDA
#undef PG8_LDB
#undef PG8_MMA
#undef PG8_WAIT_V
#undef PG8_WAIT_L
#undef PG8_BAR
#undef PG8_SCHED
#undef PG8_UA
#undef PG8_UB
}
}

struct Args {
    const float* in[19]; float* out; unsigned char* ws;
};

__device__ __forceinline__ void tr_item(const float* __restrict__ W, int K, int N, bf16_t* WT, int segperm, LAS float* scr, int item, int lane) {
    const int nblk = N >> 6, kb = item / nblk, nb = item - kb * nblk, k0 = kb << 6, n0 = nb << 6;
    const float* src = W + (size_t)k0 * N + n0 + lane;
#pragma unroll 16
    for (int i = 0; i < 64; ++i) scr[i * 65 + lane] = src[(size_t)i * N];
    LDS_WAIT();
    const int seg = n0 >> 12, dseg = (segperm >> (4 * seg)) & 15, drow0 = n0 + (dseg - seg) * 4096;
    const int c = lane & 7;
#pragma unroll
    for (int j = 0; j < 8; ++j) {
        const int n = (lane >> 3) + 8 * j; const LAS float* s = scr + (8 * c) * 65 + n;
        u32x4 o; o.x = pk2(s[0], s[65]); o.y = pk2(s[130], s[195]); o.z = pk2(s[260], s[325]); o.w = pk2(s[390], s[455]);
        *(u32x4*)(WT + (size_t)(drow0 + n) * K + k0 + 8 * c) = o;
    }
    LDS_WAIT();
}

__device__ __forceinline__ void transpose_layer(const Args& a, int layer, LAS unsigned char* lds, int gw, int NGW, int wave, int lane) {
    LAS float* scr = (LAS float*)(lds + wave * 16640);
    bf16_t* WIN = (bf16_t*)(a.ws + WS_WIN); bf16_t* WOUT = (bf16_t*)(a.ws + WS_WOUT); bf16_t* WG = (bf16_t*)(a.ws + WS_WG);
    const int kind = layer % 3, j = layer / 3;
    if (kind == 0) {
        const float* win = a.in[8] + (size_t)j * DM * 16384; const float* wout = a.in[10] + (size_t)j * DI * DM;
        const int n_in = (DM / 64) * (16384 / 64), n_out = (DI / 64) * (DM / 64);
        for (int it = gw; it < n_in + n_out; it += NGW) {
            if (it < n_in) tr_item(win, DM, 16384, WIN, 0x2310, scr, it, lane);
            else tr_item(wout, DI, DM, WOUT, 0x43210, scr, it - n_in, lane);
        }
    } else if (kind == 1) {
        const float* win = a.in[11]; const float* wg = a.in[12]; const float* wout = a.in[14];
        const int n_in = (DM / 64) * (8192 / 64), n_g = 16 * 16, n_out = (DI / 64) * (DM / 64);
        for (int it = gw; it < n_in + 4 * n_g + n_out; it += NGW) {
            if (it < n_in) tr_item(win, DM, 8192, WIN, 0x43210, scr, it, lane);
            else if (it < n_in + 4 * n_g) { const int g = (it - n_in) / n_g, r = (it - n_in) % n_g; tr_item(wg + (size_t)g * 1024 * 1024, 1024, 1024, WG + (size_t)g * 1024 * 1024, 0x43210, scr, r, lane); }
            else tr_item(wout, DI, DM, WOUT, 0x43210, scr, it - n_in - 4 * n_g, lane);
        }
    } else {
        const float* win = a.in[15]; const float* wout = a.in[18];
        const int n_in = (DM / 64) * (20480 / 64), n_out = (DI / 64) * (DM / 64);
        for (int it = gw; it < n_in + n_out; it += NGW) {
            if (it < n_in) tr_item(win, DM, 20480, WIN, 0x34210, scr, it, lane);
            else tr_item(wout, DI, DM, WOUT, 0x43210, scr, it - n_in, lane);
        }
    }
}

__device__ __forceinline__ void row_phase(const Args& a, int li, LAS unsigned char* lds, int G, int tid, int wave, int lane) {
    LAS f32x4* V = (LAS f32x4*)lds;
    const float* MOD = (const float*)(a.ws + WS_MOD);
    float* XC = (float*)(a.ws + WS_XC); bf16_t* H = (bf16_t*)(a.ws + WS_H);
    const bf16_t* Y = (const bf16_t*)(a.ws + WS_S0 + 5 * SLOT);
    for (int rb = blockIdx.x; rb < 256; rb += G) {
        const int mrl = rb >> 6;
        __syncthreads();
        {
            const int c4 = 4 * tid;
            if (li > 0) {
                const f32x4 gp = *(const f32x4*)(a.in[7] + (size_t)(li - 1) * DM + c4);
                const f32x4 gl = *(const f32x4*)(MOD + (size_t)((li - 1) * 5 + mrl) * 6144 + 4096 + c4), gc = *(const f32x4*)(MOD + (size_t)((li - 1) * 5 + 4) * 6144 + 4096 + c4);
                V[0 * 512 + tid] = gl * gp; V[1 * 512 + tid] = gc * gp;
            }
            if (li < 4) {
                const f32x4 gpre = *(const f32x4*)(a.in[6] + (size_t)li * DM + c4);
                const float* ml = MOD + (size_t)(li * 5 + mrl) * 6144 + c4; const float* mc = MOD + (size_t)(li * 5 + 4) * 6144 + c4;
                V[2 * 512 + tid] = gpre * (1.0f + *(const f32x4*)(ml + 2048)); V[3 * 512 + tid] = gpre * (1.0f + *(const f32x4*)(mc + 2048));
                V[4 * 512 + tid] = *(const f32x4*)ml; V[5 * 512 + tid] = *(const f32x4*)mc;
            }
        }
        __syncthreads();
        const int nr = (li == 4) ? 4 : (wave < 4 ? 5 : 4);
        for (int k = 0; k < nr; ++k) {
            const bool lat = k < 4;
            const int row = lat ? rb * 32 + wave * 4 + k : MLAT + rb * 4 + wave;
            const LAS f32x4* Vr = V + (lat ? 0 : 512) + lane;
            float* xrow = lat ? a.out + (size_t)row * DM : XC + (size_t)(row - MLAT) * DM;
            f32x4 xv[8];
            if (li == 0) {
                const float* src = lat ? a.in[0] + (size_t)row * DM : a.in[2] + (size_t)(row - MLAT) * DM;
#pragma unroll
                for (int j = 0; j < 8; ++j) xv[j] = *(const f32x4*)(src + 4 * lane + 256 * j);
#pragma unroll
                for (int j = 0; j < 8; ++j) *(f32x4*)(xrow + 4 * lane + 256 * j) = xv[j];
            } else {
                const bf16_t* yrow = Y + (size_t)row * DM;
                u32x2 yw[8];
#pragma unroll
                for (int j = 0; j < 8; ++j) xv[j] = *(const f32x4*)(xrow + 4 * lane + 256 * j);
#pragma unroll
                for (int j = 0; j < 8; ++j) yw[j] = *(const u32x2*)(yrow + 4 * lane + 256 * j);
                f32x4 yv[8]; float ss = 0.f;
#pragma unroll
                for (int j = 0; j < 8; ++j) { yv[j] = (f32x4){bflo(yw[j].x), bfhi(yw[j].x), bflo(yw[j].y), bfhi(yw[j].y)}; ss += (yv[j].x * yv[j].x + yv[j].y * yv[j].y) + (yv[j].z * yv[j].z + yv[j].w * yv[j].w); }
                const float rstd = rsqrtf(wave_sum(ss) * (1.0f / DM) + EPS);
#pragma unroll
                for (int j = 0; j < 8; ++j) {
                    xv[j] += Vr[0 * 512 + 64 * j] * (yv[j] * rstd);
                    *(f32x4*)(xrow + 4 * lane + 256 * j) = xv[j];
                }
            }
            if (li < 4) {
                float ss = 0.f;
#pragma unroll
                for (int j = 0; j < 8; ++j) ss += (xv[j].x * xv[j].x + xv[j].y * xv[j].y) + (xv[j].z * xv[j].z + xv[j].w * xv[j].w);
                const float rstd = rsqrtf(wave_sum(ss) * (1.0f / DM) + EPS);
                bf16_t* hrow = H + (size_t)row * DM;
#pragma unroll
                for (int j = 0; j < 8; ++j) {
                    const f32x4 hv = (xv[j] * rstd) * Vr[2 * 512 + 64 * j] + Vr[4 * 512 + 64 * j];
                    u32x2 w; w.x = pk2(hv.x, hv.y); w.y = pk2(hv.z, hv.w);
                    *(u32x2*)(hrow + 4 * lane + 256 * j) = w;
                }
            }
        }
    }
}

__device__ __forceinline__ void init_phase(const Args& a, LAS unsigned char* lds, int G) {
    LAS float* sc = (LAS float*)lds;
    LAS float* red = sc + 5 * 2048;
    const int tid = my_tid();
    float* MOD = (float*)(a.ws + WS_MOD); float* LB = (float*)(a.ws + WS_LB);
    for (int e = tid; e < 5 * 2048; e += NTHR) { const int r = e >> 11, k = e & 2047; const float v = r < 4 ? a.in[1][r * 2048 + k] : a.in[3][k]; sc[e] = silu_f(v); }
    __syncthreads();
    for (int item = blockIdx.x; item < 384; item += G) {
        const int layer = item / 96, n0 = (item % 96) * 64, ks = tid >> 6, nn = tid & 63;
        float acc0 = 0.f, acc1 = 0.f, acc2 = 0.f, acc3 = 0.f, acc4 = 0.f;
        const float* wp = a.in[4] + ((size_t)layer * 2048 + ks * 256) * 6144 + n0 + nn;
        const LAS float* sp = sc + ks * 256;
#pragma unroll 32
        for (int kk = 0; kk < 256; ++kk) {
            const float w = wp[(size_t)kk * 6144];
            acc0 += sp[kk] * w; acc1 += sp[2048 + kk] * w; acc2 += sp[4096 + kk] * w; acc3 += sp[6144 + kk] * w; acc4 += sp[8192 + kk] * w;
        }
        red[(ks * 5 + 0) * 64 + nn] = acc0; red[(ks * 5 + 1) * 64 + nn] = acc1; red[(ks * 5 + 2) * 64 + nn] = acc2; red[(ks * 5 + 3) * 64 + nn] = acc3; red[(ks * 5 + 4) * 64 + nn] = acc4;
        __syncthreads();
        if (tid < 320) {
            const int r = tid >> 6, n2 = tid & 63; float s = 0.f;
#pragma unroll
            for (int k8 = 0; k8 < 8; ++k8) s += red[(k8 * 5 + r) * 64 + n2];
            MOD[(size_t)(layer * 5 + r) * 6144 + n0 + n2] = s + a.in[5][layer * 6144 + n0 + n2];
        }
        __syncthreads();
    }
    const int gt = blockIdx.x * NTHR + tid;
    if (gt < 2 * 4096) {
        const int d = gt >> 12, f = gt & 4095; const float* p = a.in[16] + (size_t)d * 4 * 4096 + f;
        const float l0 = p[0], l1 = p[4096], l2 = p[8192], l3 = p[12288];
        const float mx = fmaxf(fmaxf(l0, l1), fmaxf(l2, l3));
        const float e0 = expf(l0 - mx), e1 = expf(l1 - mx), e2 = expf(l2 - mx), e3 = expf(l3 - mx);
        LB[gt] = (e1 + e2) / (e0 + e1 + e2 + e3);
    }
}

typedef float f32x16 __attribute__((ext_vector_type(16)));
__device__ __forceinline__ void attn_phase(const Args& a, int layer, LAS unsigned char* lds, int G, int need_ctx) {
    const int tid = my_tid(), wave = __builtin_amdgcn_readfirstlane(tid >> 6), lane = tid & 63, q = lane & 31, hh = lane >> 5;
    const bf16_t* Q = (const bf16_t*)(a.ws + WS_S0); const bf16_t* Kp = (const bf16_t*)(a.ws + WS_S0 + SLOT);
    const bf16_t* SZ = (const bf16_t*)(a.ws + WS_S0 + 2 * SLOT); const bf16_t* Vt = (const bf16_t*)(a.ws + WS_S0 + 3 * SLOT);
    bf16_t* GT = (bf16_t*)(a.ws + WS_S0 + 4 * SLOT);
    const float* rpb = a.in[9] + (size_t)(layer / 3) * 32 * 465;
    LAS float* rp = (LAS float*)(lds + wave * 2048);
    const int gw = blockIdx.x * NWAVES + wave, NGW = G * NWAVES;
    const int nlat = 8192, ntask = nlat + (need_ctx ? 1024 : 0);
    const int sig = (q & 19) | ((q & 8) >> 1) | ((q & 4) << 1);
    for (int task = gw; task < ntask; task += NGW) {
        const bool lat = task < nlat;
        int b, h, r = 0, j = 0, qtok;
        if (lat) { j = task & 3; r = 2 * ((task >> 2) & 15); h = (task >> 6) & 31; b = task >> 11; qtok = b * SEQ + (r + (q >> 4)) * 64 + 16 * j + (q & 15); }
        else { const int t2 = task - nlat; h = (t2 >> 3) & 31; b = t2 >> 8; qtok = MLAT + b * CTX + 32 * (t2 & 7) + q; }
        bf16x8 qf[8];
#pragma unroll
        for (int c = 0; c < 8; ++c) qf[c] = *(const bf16x8*)(Q + (size_t)qtok * DI + h * 128 + 16 * c + 8 * hh);
        if (lat) {
            LDS_WAIT();
            for (int e = lane; e < 465; e += 64) rp[e] = rpb[h * 465 + e];
            LDS_WAIT();
        }
        const int r0a = min(max(r - 4, 0), 24), r0b = min(max(r - 3, 0), 24), nband = lat ? (r0b + 8 - r0a) : 0;
        const int qr = r + (q >> 4), myr0 = (q >> 4) ? r0b : r0a;
        const int cw = min(max(16 * j - 8, 0), 32), qcol = 16 * j + (q & 15), c0 = min(max(qcol - 8, 0), 48);
        const int nst = nband + 8;
        const int kb_lat = b * SEQ + r0a * 64 + cw, kb_ctx = MLAT + b * CTX;
        const bf16_t* kbase = Kp + (size_t)h * 1024 + (size_t)(sig >> 3) * 32768 + (sig & 7) * 16 + 8 * hh;
        const bf16_t* vbase = Vt + (size_t)h * 1024 + (size_t)hh * 32768 + q * 8;
        float m_run = -1e30f, l_run = 0.f;
        f32x16 OT[4];
#pragma unroll
        for (int d = 0; d < 4; ++d)
#pragma unroll
            for (int t = 0; t < 16; ++t) OT[d][t] = 0.f;
        bf16x8 kreg[8], vreg[8];
        { const int kb0 = nband ? kb_lat : kb_ctx;
#pragma unroll
          for (int c = 0; c < 8; ++c) kreg[c] = *(const bf16x8*)(kbase + (size_t)(kb0 >> 3) * 32768 + 128 * c); }
        for (int st = 0; st < nst; ++st) {
            const bool isl = st < nband;
            const int keybase = isl ? kb_lat + st * 64 : kb_ctx + 32 * (st - nband);
#pragma unroll
            for (int d = 0; d < 4; ++d)
#pragma unroll
                for (int s2 = 0; s2 < 2; ++s2) vreg[d * 2 + s2] = *(const bf16x8*)(vbase + (size_t)(keybase >> 3) * 32768 + s2 * 65536 + d * 256);
            f32x16 sc;
#pragma unroll
            for (int t = 0; t < 16; ++t) sc[t] = 0.f;
#pragma unroll
            for (int c = 0; c < 8; ++c) sc = __builtin_amdgcn_mfma_f32_32x32x16_bf16(kreg[c], qf[c], sc, 0, 0, 0);
            if (st + 1 < nst) {
                const int kn = (st + 1 < nband) ? kb_lat + (st + 1) * 64 : kb_ctx + 32 * (st + 1 - nband);
#pragma unroll
                for (int c = 0; c < 8; ++c) kreg[c] = *(const bf16x8*)(kbase + (size_t)(kn >> 3) * 32768 + 128 * c);
            }
            if (isl) {
                const int kr = r0a + st; const bool rowok = (kr >= myr0) && (kr < myr0 + 8);
                const int brow = (kr - qr + 7) * 31 - qcol + 15;
#pragma unroll
                for (int t = 0; t < 16; ++t) {
                    const int kc = cw + 16 * (t >> 3) + 8 * hh + (t & 7); const bool valid = rowok && (kc >= c0) && (kc < c0 + 16);
                    const float bias = rp[valid ? (brow + kc) : 0];
                    sc[t] = valid ? sc[t] + bias : -3.0e38f;
                }
            }
            float mx = sc[0];
#pragma unroll
            for (int t = 1; t < 16; ++t) mx = fmaxf(mx, sc[t]);
            mx = fmaxf(mx, __shfl_xor(mx, 32));
            const float m_new = fmaxf(m_run, mx), alpha = __expf(m_run - m_new);
            float rs = 0.f;
#pragma unroll
            for (int t = 0; t < 16; ++t) { sc[t] = __expf(sc[t] - m_new); rs += sc[t]; }
            rs += __shfl_xor(rs, 32);
            l_run = l_run * alpha + rs; m_run = m_new;
            union { u32x4 u; bf16x8 v; } P0, P1;
            P0.u.x = pk2(sc[0], sc[1]); P0.u.y = pk2(sc[2], sc[3]); P0.u.z = pk2(sc[4], sc[5]); P0.u.w = pk2(sc[6], sc[7]);
            P1.u.x = pk2(sc[8], sc[9]); P1.u.y = pk2(sc[10], sc[11]); P1.u.z = pk2(sc[12], sc[13]); P1.u.w = pk2(sc[14], sc[15]);
#pragma unroll
            for (int d = 0; d < 4; ++d) {
#pragma unroll
                for (int t = 0; t < 16; ++t) OT[d][t] *= alpha;
                OT[d] = __builtin_amdgcn_mfma_f32_32x32x16_bf16(vreg[d * 2 + 0], P0.v, OT[d], 0, 0, 0);
                OT[d] = __builtin_amdgcn_mfma_f32_32x32x16_bf16(vreg[d * 2 + 1], P1.v, OT[d], 0, 0, 0);
            }
        }
        const float inv = 1.0f / l_run;
        const size_t obase = (size_t)qtok * DI + h * 128 + 4 * hh;
#pragma unroll
        for (int d = 0; d < 4; ++d)
#pragma unroll
            for (int g4 = 0; g4 < 4; ++g4) {
                const size_t o = obase + 32 * d + 8 * g4;
                const u32x2 z = *(const u32x2*)(SZ + o);
                u32x2 w; w.x = pk2(OT[d][4 * g4 + 0] * inv * bflo(z.x), OT[d][4 * g4 + 1] * inv * bfhi(z.x)); w.y = pk2(OT[d][4 * g4 + 2] * inv * bflo(z.y), OT[d][4 * g4 + 3] * inv * bfhi(z.y));
                *(u32x2*)(GT + o) = w;
            }
    }
}

__device__ __forceinline__ void pool_phase(const Args& a, int G) {
    const bf16_t* U = (const bf16_t*)(a.ws + WS_S0); bf16_t* Pg = (bf16_t*)(a.ws + WS_S0 + SLOT);
    const int gt = blockIdx.x * NTHR + my_tid(), gsz = G * NTHR;
    for (int idx = gt; idx < MTOT * 512; idx += gsz) {
        const int row = idx >> 9, cv = idx & 511, col = cv * 8, g = col >> 10, hw = 1 << g;
        int t, T, base;
        if (row < MLAT) { t = row & 2047; T = SEQ; base = row - t; } else { const int r2 = row - MLAT; t = r2 & 255; T = CTX; base = row - t; }
        const int lo = max(t - hw, 0), hi = min(t + hw, T);
        float acc[8];
#pragma unroll
        for (int e = 0; e < 8; ++e) acc[e] = 0.f;
        for (int tt = lo; tt < hi; ++tt) {
            const u32x4 v = *(const u32x4*)(U + (size_t)(base + tt) * DI + col);
            acc[0] += bflo(v.x); acc[1] += bfhi(v.x); acc[2] += bflo(v.y); acc[3] += bfhi(v.y); acc[4] += bflo(v.z); acc[5] += bfhi(v.z); acc[6] += bflo(v.w); acc[7] += bfhi(v.w);
        }
        const float ic = 1.0f / (float)(hi - lo);
        const u32x4 c = *(const u32x4*)(U + (size_t)row * DI + col);
        u32x4 o; o.x = pk2(acc[0] * ic - bflo(c.x), acc[1] * ic - bfhi(c.x)); o.y = pk2(acc[2] * ic - bflo(c.y), acc[3] * ic - bfhi(c.y));
        o.z = pk2(acc[4] * ic - bflo(c.z), acc[5] * ic - bfhi(c.z)); o.w = pk2(acc[6] * ic - bflo(c.w), acc[7] * ic - bfhi(c.w));
        *(u32x4*)(Pg + ((size_t)g * MTOT + row) * 1024 + (col & 1023)) = o;
    }
}

__device__ __forceinline__ void hgate_phase(const Args& a, int G) {
    const bf16_t* Of = (const bf16_t*)(a.ws + WS_S0 + SLOT); const bf16_t* Ob = (const bf16_t*)(a.ws + WS_S0 + 4 * SLOT);
    const bf16_t* SZ = (const bf16_t*)(a.ws + WS_S0 + 2 * SLOT); bf16_t* GT = (bf16_t*)(a.ws + WS_S0);
    const float* gn = a.in[17];
    const int gt = blockIdx.x * NTHR + my_tid(), gsz = G * NTHR;
    for (int idx = gt; idx < MTOT * 512; idx += gsz) {
        const int row = idx >> 9, col = (idx & 511) * 8; const size_t off = (size_t)row * DI + col;
        const u32x4 f = *(const u32x4*)(Of + off), bk = *(const u32x4*)(Ob + off), z = *(const u32x4*)(SZ + off);
        float o[8];
        o[0] = bflo(f.x) + bflo(bk.x); o[1] = bfhi(f.x) + bfhi(bk.x); o[2] = bflo(f.y) + bflo(bk.y); o[3] = bfhi(f.y) + bfhi(bk.y);
        o[4] = bflo(f.z) + bflo(bk.z); o[5] = bfhi(f.z) + bfhi(bk.z); o[6] = bflo(f.w) + bflo(bk.w); o[7] = bfhi(f.w) + bfhi(bk.w);
        float ss = 0.f;
#pragma unroll
        for (int e = 0; e < 8; ++e) ss += o[e] * o[e];
        ss += __shfl_xor(ss, 1); ss += __shfl_xor(ss, 2); ss += __shfl_xor(ss, 4); ss += __shfl_xor(ss, 8);
        const float rstd = rsqrtf(ss * (1.0f / 128.0f) + EPS);
        const f32x4 g0 = *(const f32x4*)(gn + col), g1 = *(const f32x4*)(gn + col + 4);
        u32x4 w;
        w.x = pk2(o[0] * rstd * g0.x * bflo(z.x), o[1] * rstd * g0.y * bfhi(z.x)); w.y = pk2(o[2] * rstd * g0.z * bflo(z.y), o[3] * rstd * g0.w * bfhi(z.y));
        w.z = pk2(o[4] * rstd * g1.x * bflo(z.z), o[5] * rstd * g1.y * bfhi(z.z)); w.w = pk2(o[6] * rstd * g1.z * bflo(z.w), o[7] * rstd * g1.w * bfhi(z.w));
        *(u32x4*)(GT + off) = w;
    }
}

constexpr int SC_QT = 0, SC_KT = 8704, SC_KH = 17408, SC_DEC = 27648, SC_BUF = 28160, SC_TOT = 2 * SC_BUF;
struct ScanRaw { float lf[8]; unsigned short qs[8]; };

__device__ __forceinline__ void scan_chunk_t0(int cj, int b, int dir, int& t0) {
    const bool isctx = cj < 8;
    const int cc = isctx ? (dir ? 7 - cj : cj) : (dir ? 71 - cj : cj - 8);
    t0 = isctx ? MLAT + b * CTX + 32 * cc : b * SEQ + 32 * cc;
}

#define SCAN_BAR() do { asm volatile("s_waitcnt lgkmcnt(0)" ::: "memory"); __builtin_amdgcn_s_barrier(); asm volatile("" ::: "memory"); } while (0)
__device__ __forceinline__ void scan_phase(const Args& a, LAS unsigned char* lds, int G) {
    const int tid = my_tid(), wave = tid >> 6, lane = tid & 63, fr = lane & 15, fq = lane >> 4;
    const bf16_t* QS = (const bf16_t*)(a.ws + WS_S0); const bf16_t* Vt = (const bf16_t*)(a.ws + WS_S0 + 3 * SLOT);
    const int kch = tid & 127, part = tid >> 7;
    for (int sidx = blockIdx.x; sidx < 256; sidx += G) {
        const int dir = sidx & 1, h = (sidx >> 1) & 31, b = sidx >> 6;
        const float* LF = (const float*)(a.ws + WS_S0 + (dir ? 7 : 5) * SLOT);
        bf16_t* O = (bf16_t*)(a.ws + WS_S0 + (dir ? 4 : 1) * SLOT);
        f32x4 S[8];
#pragma unroll
        for (int k = 0; k < 8; ++k) S[k] = (f32x4){0.f, 0.f, 0.f, 0.f};
        float rlf[8]; unsigned short rqs[8]; bf16x8 vfn;
#define SCAN_RAW(cj) do { int _t0; scan_chunk_t0((cj), b, dir, _t0); \
        _Pragma("unroll") for (int e = 0; e < 8; ++e) { const int tau = 8 * part + e; const int tok = dir ? _t0 + 31 - tau : _t0 + tau; \
            rlf[e] = LF[(size_t)tok * DI + h * 128 + kch]; rqs[e] = QS[(size_t)tok * DI + h * 128 + kch]; } \
        vfn = *(const bf16x8*)(Vt + (size_t)(h * 128 + 16 * wave + fr) * MTOT + (dir ? _t0 + 24 - 8 * fq : _t0 + 8 * fq)); } while (0)
#define SCAN_PREP(bufp) do { LAS unsigned char* _B = (bufp); LAS float* TOT = (LAS float*)(lds + SC_TOT); \
        float cs[8]; float run = 0.f; \
        _Pragma("unroll") for (int e = 0; e < 8; ++e) { run += rlf[e]; cs[e] = run; } \
        TOT[part * 128 + kch] = run; SCAN_BAR(); \
        float off = 0.f, bend = 0.f; \
        _Pragma("unroll") for (int p = 0; p < 4; ++p) { const float tv = TOT[p * 128 + kch]; off += (p < part) ? tv : 0.f; bend += tv; } \
        unsigned kh[8]; \
        _Pragma("unroll") for (int e = 0; e < 8; ++e) { const int tau = 8 * part + e; const float bt = off + cs[e]; const float kf = 1.0f - __expf(rlf[e]); \
            const float qv = __uint_as_float(((unsigned)rqs[e]) << 16) * __expf(bt); const float kt = kf * __expf(-bt); const float kk = kf * __expf(bend - bt); \
            ((LAS bf16_t*)(_B + SC_QT))[tau * 136 + kch] = (bf16_t)(pk2(qv, 0.f) & 0xffffu); ((LAS bf16_t*)(_B + SC_KT))[tau * 136 + kch] = (bf16_t)(pk2(kt, 0.f) & 0xffffu); kh[e] = pk2(kk, 0.f) & 0xffffu; } \
        u32x4 kw; kw.x = kh[0] | (kh[1] << 16); kw.y = kh[2] | (kh[3] << 16); kw.z = kh[4] | (kh[5] << 16); kw.w = kh[6] | (kh[7] << 16); \
        *(LAS u32x4*)(_B + SC_KH + kch * 80 + part * 16) = kw; \
        if (part == 0) ((LAS float*)(_B + SC_DEC))[kch] = __expf(bend); } while (0)

        SCAN_RAW(0);
        SCAN_PREP(lds);
        bf16x8 vf = vfn;
        SCAN_RAW(1);
        SCAN_BAR();
        for (int ci = 0; ci < 72; ++ci) {
            LAS unsigned char* B = lds + (ci & 1) * SC_BUF;
            bf16x8 vf_next = vfn;
            if (ci + 1 < 72) { SCAN_PREP(lds + ((ci + 1) & 1) * SC_BUF); }
            if (ci + 2 < 72) { SCAN_RAW(ci + 2); }
            int t0; scan_chunk_t0(ci, b, dir, t0);
            bf16x8 vcur = vf;
            if (dir) { bf16x8 t = vf; vcur[0] = t[7]; vcur[1] = t[6]; vcur[2] = t[5]; vcur[3] = t[4]; vcur[4] = t[3]; vcur[5] = t[2]; vcur[6] = t[1]; vcur[7] = t[0]; }
            bf16x8 qb[2][4];
#pragma unroll
            for (int tb = 0; tb < 2; ++tb)
#pragma unroll
                for (int c = 0; c < 4; ++c) qb[tb][c] = *(const LAS bf16x8*)(B + SC_QT + ((16 * tb + fr) * 136 + 32 * c + 8 * fq) * 2);
            f32x4 att[2][2];
#pragma unroll
            for (int sb = 0; sb < 2; ++sb) {
                att[sb][0] = (f32x4){0.f, 0.f, 0.f, 0.f}; att[sb][1] = (f32x4){0.f, 0.f, 0.f, 0.f};
                const int srow = 8 * (fr >> 2) + 4 * sb + (fr & 3);
#pragma unroll
                for (int c = 0; c < 4; ++c) {
                    const bf16x8 ka = *(const LAS bf16x8*)(B + SC_KT + (srow * 136 + 32 * c + 8 * fq) * 2);
                    att[sb][0] = __builtin_amdgcn_mfma_f32_16x16x32_bf16(ka, qb[0][c], att[sb][0], 0, 0, 0);
                    att[sb][1] = __builtin_amdgcn_mfma_f32_16x16x32_bf16(ka, qb[1][c], att[sb][1], 0, 0, 0);
                }
            }
            f32x4 OT[2];
#pragma unroll
            for (int tb = 0; tb < 2; ++tb) {
                const int t = 16 * tb + fr;
#pragma unroll
                for (int sb = 0; sb < 2; ++sb)
#pragma unroll
                    for (int i = 0; i < 4; ++i) { const int sa = 8 * fq + 4 * sb + i; att[sb][tb][i] = (sa <= t) ? att[sb][tb][i] : 0.f; }
                union { u32x4 u; bf16x8 v; } P; P.u.x = pk2(att[0][tb][0], att[0][tb][1]); P.u.y = pk2(att[0][tb][2], att[0][tb][3]); P.u.z = pk2(att[1][tb][0], att[1][tb][1]); P.u.w = pk2(att[1][tb][2], att[1][tb][3]);
                OT[tb] = __builtin_amdgcn_mfma_f32_16x16x32_bf16(vcur, P.v, (f32x4){0.f, 0.f, 0.f, 0.f}, 0, 0, 0);
            }
#pragma unroll
            for (int c = 0; c < 4; ++c) {
                union { u32x4 u; bf16x8 v; } SF; SF.u.x = pk2(S[2 * c][0], S[2 * c][1]); SF.u.y = pk2(S[2 * c][2], S[2 * c][3]); SF.u.z = pk2(S[2 * c + 1][0], S[2 * c + 1][1]); SF.u.w = pk2(S[2 * c + 1][2], S[2 * c + 1][3]);
                OT[0] = __builtin_amdgcn_mfma_f32_16x16x32_bf16(SF.v, qb[0][c], OT[0], 0, 0, 0);
                OT[1] = __builtin_amdgcn_mfma_f32_16x16x32_bf16(SF.v, qb[1][c], OT[1], 0, 0, 0);
            }
#pragma unroll
            for (int kb = 0; kb < 8; ++kb) {
                const int krow = 32 * (kb >> 1) + 8 * (fr >> 2) + 4 * (kb & 1) + (fr & 3);
                const bf16x8 ka = *(const LAS bf16x8*)(B + SC_KH + krow * 80 + fq * 16);
                const f32x4 dc = *(const LAS f32x4*)(B + SC_DEC + (32 * (kb >> 1) + 8 * fq + 4 * (kb & 1)) * 4);
                S[kb] = __builtin_amdgcn_mfma_f32_16x16x32_bf16(ka, vcur, S[kb] * dc, 0, 0, 0);
            }
#pragma unroll
            for (int tb = 0; tb < 2; ++tb) {
                const int tau = 16 * tb + fr; const int tok = dir ? t0 + 31 - tau : t0 + tau;
                u32x2 w; w.x = pk2(OT[tb][0], OT[tb][1]); w.y = pk2(OT[tb][2], OT[tb][3]);
                *(u32x2*)(O + (size_t)tok * DI + h * 128 + 16 * wave + 4 * fq) = w;
            }
            vf = vf_next;
            SCAN_BAR();
        }
#undef SCAN_RAW
#undef SCAN_PREP
    }
}

#define XB_TMO      128
#define XB_XCNT(j)  (256  + 64 * (j))
#define XB_XSUB(j)  (1280 + 64 * (j))
#define XB_XGEN(j)  (2304 + 64 * (j))
#define XB_TOP      3328
#define XB_TOPGEN   3392
#define XCD_BAR_WORDS 3456
#define XB_SPIN_CAP (1u << 18)

__device__ __forceinline__ unsigned xb_ld(unsigned* p)              { return __hip_atomic_load(p, __ATOMIC_RELAXED, __HIP_MEMORY_SCOPE_AGENT); }
__device__ __forceinline__ unsigned xb_add(unsigned* p, unsigned v) { return __hip_atomic_fetch_add(p, v, __ATOMIC_RELAXED, __HIP_MEMORY_SCOPE_AGENT); }
__device__ __forceinline__ unsigned xb_xcc_id() { return (unsigned)__builtin_amdgcn_s_getreg((3 << 11) | 20) & 0xFu; }
#define XB_SPIN(cond, bar) do { unsigned _sp = 0; while (cond) { __builtin_amdgcn_s_sleep(1); \
    if ((++_sp & 255u) == 0u) { if (xb_ld(&(bar)[XB_TMO])) break; if (_sp > XB_SPIN_CAP) { atomicAdd(&(bar)[XB_TMO], 1u); break; } } } } while (0)

struct XcdBarrier {
    unsigned* bar; unsigned x;
    volatile LAS unsigned* st;
};

__device__ __forceinline__ XcdBarrier xcd_barrier_post(unsigned* bar, volatile LAS unsigned* st) {
    XcdBarrier b; b.bar = bar; b.x = xb_xcc_id(); b.st = st;
    if (threadIdx.x == 0) (void)xb_add(&bar[XB_XCNT(b.x)], 1u);
    return b;
}
__device__ __forceinline__ void xcd_barrier_complete(unsigned* bar, unsigned x, unsigned& nloc, unsigned& nx) {
    const unsigned G = gridDim.x * gridDim.y * gridDim.z;
    unsigned sum, cnt, mine, sp = 0u;
    for (;;) {
        sum = 0u; cnt = 0u; mine = 0u;
#pragma unroll
        for (unsigned j = 0; j < 16; ++j) { const unsigned c = xb_ld(&bar[XB_XCNT(j)]); sum += c; cnt += (c > 0u) ? 1u : 0u; mine = (j == x) ? c : mine; }
        if (sum == G) break;
        __builtin_amdgcn_s_sleep(1);
        if ((++sp & 255u) == 0u) { if (xb_ld(&bar[XB_TMO])) break; if (sp > XB_SPIN_CAP) { atomicAdd(&bar[XB_TMO], 1u); break; } }
    }
    nloc = mine > 0u ? mine : 1u; nx = cnt > 0u ? cnt : 1u;
}

__device__ __forceinline__ void xcd_barrier(const XcdBarrier& b) {
    asm volatile("s_waitcnt vmcnt(0)" ::: "memory");
    __syncthreads();
    if (threadIdx.x == 0) {
        unsigned* bar = b.bar;
        __builtin_amdgcn_s_waitcnt(0);
        unsigned nloc = b.st[0], nx = b.st[1];
        if (nloc == 0u) { xcd_barrier_complete(bar, b.x, nloc, nx); b.st[0] = nloc; b.st[1] = nx; }
        const unsigned old = xb_add(&bar[XB_XSUB(b.x)], 1u);
        const unsigned gen = old / nloc;
        if (old + 1u == (gen + 1u) * nloc) {
            __builtin_amdgcn_fence(__ATOMIC_RELEASE, "agent");
            asm volatile("s_waitcnt vmcnt(0)" ::: "memory");
            const unsigned og = xb_add(&bar[XB_TOP], 1u);
            const unsigned tg = og / nx;
            if (og + 1u == (tg + 1u) * nx) xb_add(&bar[XB_TOPGEN], 1u);
            else XB_SPIN(xb_ld(&bar[XB_TOPGEN]) == tg, bar);
            __builtin_amdgcn_fence(__ATOMIC_ACQUIRE, "agent");
            xb_add(&bar[XB_XGEN(b.x)], 1u);
            asm volatile("s_waitcnt vmcnt(0)" ::: "memory");
        } else {
            XB_SPIN(xb_ld(&bar[XB_XGEN(b.x)]) == gen, bar);
            __builtin_amdgcn_fence(__ATOMIC_ACQUIRE, "agent");
            asm volatile("s_waitcnt vmcnt(0)" ::: "memory");
        }
    }
    __syncthreads();
}


enum { OP_INIT = 0, OP_ROW = 1, OP_G1 = 2, OP_ATT = 3, OP_POOL = 4, OP_GG = 5, OP_SCAN = 6, OP_GATE = 7, OP_G2 = 8, OP_FINAL = 9 };
constexpr int NPHASE = 20;
constexpr int JOB_OFF = LDS_BYTES - 4096;
constexpr int BAR_ST_OFF = LDS_BYTES - 16;

__global__ void __launch_bounds__(NTHR, 2) fwd_mega(Args a0) {
    extern __shared__ __attribute__((aligned(16))) unsigned char lds_raw[];
    LAS unsigned char* lds = (LAS unsigned char*)lds_raw;
    cg::grid_group grid = cg::this_grid();
    const int G = gridDim.x, bid = blockIdx.x;
    if (a0.ws == nullptr) grid.sync();
    if (threadIdx.x == 0) {
        unsigned char* ws = a0.ws;
        bf16_t* H = (bf16_t*)(ws + WS_H); bf16_t* WIN = (bf16_t*)(ws + WS_WIN); bf16_t* WOUT = (bf16_t*)(ws + WS_WOUT); bf16_t* WG = (bf16_t*)(ws + WS_WG);
        const float* LB = (const float*)(ws + WS_LB);
        const int BIG = 1 << 30;
#define SLW(i) (ws + WS_S0 + (size_t)(i) * SLOT)
#define JW(gi, J0, J1, K, n0, n1) do { LAS unsigned char* p_ = lds + JOB_OFF + (gi) * 256; pg8::job_write(p_, J0); pg8::job_write(p_ + 128, J1); *(LAS int*)(p_ + 96) = (K); *(LAS int*)(p_ + 100) = (n0); *(LAS int*)(p_ + 104) = (n1); } while (0)
        const pg8::Job na0{H, WIN, 36, 48, BIG, 0, 4096, 0x271, SLW(0), SLW(1), SLW(2), nullptr, DI, nullptr, nullptr};
        const pg8::Job na1{WIN + (size_t)12288 * DM, H, 16, 36, BIG, 0, BIG, 0x8, SLW(3), nullptr, nullptr, nullptr, MTOT, nullptr, nullptr};
        const pg8::Job g2a{(const bf16_t*)SLW(4), WOUT, 36, 8, BIG, 0, BIG, 0x0, SLW(5), nullptr, nullptr, nullptr, DM, nullptr, nullptr};
        const pg8::Job g2c{(const bf16_t*)SLW(0), WOUT, 36, 8, BIG, 0, BIG, 0x0, SLW(5), nullptr, nullptr, nullptr, DM, nullptr, nullptr};
        const pg8::Job g2l{(const bf16_t*)SLW(4), WOUT, 32, 8, BIG, 0, BIG, 0x0, SLW(5), nullptr, nullptr, nullptr, DM, nullptr, nullptr};
        const pg8::Job p0{H, WIN, 36, 32, BIG, 0, 4096, 0x20, SLW(0), SLW(2), nullptr, nullptr, DI, nullptr, nullptr};
        const pg8::Job pg{(const bf16_t*)SLW(1), WG, 36, 16, 4, (size_t)MTOT * 1024, BIG, 0x6, SLW(4), nullptr, nullptr, nullptr, DI, a0.in[13], (const bf16_t*)SLW(2)};
        const pg8::Job h0{H, WIN, 36, 64, BIG, 0, 4096, 0x2432, SLW(0), SLW(5), SLW(7), SLW(2), DI, LB, nullptr};
        const pg8::Job h1{WIN + (size_t)16384 * DM, H, 16, 36, BIG, 0, BIG, 0x0, SLW(3), nullptr, nullptr, nullptr, MTOT, nullptr, nullptr};
        JW(0, na0, na1, DM, 36 * 48, 16 * 36); JW(1, g2a, g2a, DI, 36 * 8, 0);
        JW(2, p0, p0, DM, 36 * 32, 0); JW(3, pg, pg, 1024, 36 * 16, 0); JW(4, g2a, g2a, DI, 36 * 8, 0);
        JW(5, h0, h1, DM, 36 * 64, 16 * 36); JW(6, g2c, g2c, DI, 36 * 8, 0);
        JW(7, na0, na1, DM, 36 * 48, 16 * 36); JW(8, g2l, g2l, DI, 32 * 8, 0);
#undef JW
#undef SLW
    }
    {
        volatile LAS unsigned* st0 = (volatile LAS unsigned*)(lds + BAR_ST_OFF);
        if (threadIdx.x < 2) st0[threadIdx.x] = 0u;
        __syncthreads();
    }
    const XcdBarrier xbar = xcd_barrier_post((unsigned*)a0.ws, (volatile LAS unsigned*)(lds + BAR_ST_OFF));
#define SL(i) (ws + WS_S0 + (size_t)(i) * SLOT)
    const int BIG = 1 << 30;

    for (int ph = 0; ph < NPHASE; ++ph) {
        int li, op;
        if (ph == 0) { li = 0; op = OP_INIT; }
        else if (ph < 5) { li = 0; const int k = ph - 1; op = k == 0 ? OP_ROW : (k == 1 ? OP_G1 : (k == 2 ? OP_ATT : OP_G2)); }
        else if (ph < 10) { li = 1; const int k = ph - 5; op = k == 0 ? OP_ROW : (k == 1 ? OP_G1 : (k == 2 ? OP_POOL : (k == 3 ? OP_GG : OP_G2))); }
        else if (ph < 15) { li = 2; const int k = ph - 10; op = k == 0 ? OP_ROW : (k == 1 ? OP_G1 : (k == 2 ? OP_SCAN : (k == 3 ? OP_GATE : OP_G2))); }
        else if (ph < 19) { li = 3; const int k = ph - 15; op = k == 0 ? OP_ROW : (k == 1 ? OP_G1 : (k == 2 ? OP_ATT : OP_G2)); }
        else { li = 4; op = OP_FINAL; }
        const int kind = li % 3; const bool need_ctx = li < 3;
#if DBG_NL < 4
        if (li > DBG_NL || (li == DBG_NL && op != OP_ROW)) continue;
#endif
        int zero_ = 0; LAUNDER_S(zero_);
        Args a = a0;
#pragma unroll
        for (int i = 0; i < 19; ++i) a.in[i] = a0.in[i] + zero_;
        a.out = a0.out + zero_; a.ws = a0.ws + zero_;
        unsigned char* ws = a.ws;
        int tid_ = threadIdx.x; asm volatile("" : "+v"(tid_));
        const int tid = tid_, wave = __builtin_amdgcn_readfirstlane(tid >> 6), lane = tid & 63;
        const int gw = bid * NWAVES + wave, NGW = G * NWAVES;
        int gK = 0, gn0 = 0, gn1 = 0; const LAS unsigned char* jt = lds + JOB_OFF;
        if (op == OP_INIT) {
#ifdef ZERO_WS
            {
                u32x4* p = (u32x4*)(ws + WS_MOD); const size_t n16 = (WS_END - WS_MOD) / 16;
                for (size_t i = (size_t)bid * NTHR + tid; i < n16; i += (size_t)G * NTHR) p[i] = (u32x4){0u, 0u, 0u, 0u};
            }
#endif
#ifndef NO_MISC
            init_phase(a, lds, G);
            __syncthreads();
            transpose_layer(a, 0, lds, gw, NGW, wave, lane);
#ifdef PROBE_TR
            transpose_layer(a, 0, lds, gw, NGW, wave, lane);
#endif
#endif
        } else if (op == OP_ROW || op == OP_FINAL) {
#ifndef NO_MISC
            row_phase(a, li, lds, G, tid, wave, lane);
            __syncthreads();
            if (li > 0 && li < 4) transpose_layer(a, li, lds, gw, NGW, wave, lane);
#ifdef PROBE_TR
            if (li > 0 && li < 4) transpose_layer(a, li, lds, gw, NGW, wave, lane);
#endif
#endif
        } else if (op == OP_ATT) {
#ifndef NO_ATTN
            attn_phase(a, li, lds, G, need_ctx ? 1 : 0);
#ifdef PROBE_ATT
            attn_phase(a, li, lds, G, need_ctx ? 1 : 0);
#endif
#endif
        } else if (op == OP_POOL) {
#ifndef NO_MISC
            pool_phase(a, G);
#endif
        } else if (op == OP_SCAN) {
#ifndef NO_SCAN
            scan_phase(a, lds, G);
#ifdef PROBE_SCAN
            scan_phase(a, lds, G);
#endif
#endif
        } else if (op == OP_GATE) {
#ifndef NO_MISC
            hgate_phase(a, G);
#endif
        } else {
            const int gi = li == 0 ? (op == OP_G1 ? 0 : 1) : (li == 1 ? (op == OP_G1 ? 2 : (op == OP_GG ? 3 : 4)) : (li == 2 ? (op == OP_G1 ? 5 : 6) : (op == OP_G1 ? 7 : 8)));
            jt = lds + JOB_OFF + gi * 256;
            gK = pg8::jl_i(jt + 96); gn0 = pg8::jl_i(jt + 100); gn1 = pg8::jl_i(jt + 104);
        }
#ifndef NO_GEMM
        if (gK) pg8::gemm_phase(lds, jt, gK, gn0, gn1, G, bid);
#ifdef PROBE_G2
        if (gK && op == OP_G2) { __syncthreads(); pg8::gemm_phase(lds, jt, gK, gn0, gn1, G, bid); }
#endif
#endif
        if (ph + 1 < NPHASE) xcd_barrier(xbar);
    }
#undef SL
}

extern "C" void kernel_launch(void* const* d_in, const int* in_sizes, int n_in, void* d_out, int out_size, void* d_ws, size_t ws_size, hipStream_t stream) {
    static int grid = 0;
    if (grid == 0) {
        if (n_in != 19 || out_size != MLAT * DM || ws_size < WS_END) { fprintf(stderr, "kernel_launch: unexpected shapes n_in %d out %d ws %zu (need %zu)\n", n_in, out_size, ws_size, (size_t)WS_END); grid = -1; return; }
        int dev = 0, cus = 0, per_cu = 0;
        (void)hipGetDevice(&dev);
        (void)hipDeviceGetAttribute(&cus, hipDeviceAttributeMultiprocessorCount, dev);
        (void)hipFuncSetAttribute((const void*)fwd_mega, hipFuncAttributeMaxDynamicSharedMemorySize, LDS_BYTES);
        (void)hipOccupancyMaxActiveBlocksPerMultiprocessor(&per_cu, (const void*)fwd_mega, NTHR, LDS_BYTES);
        fprintf(stderr, "cus %d per_cu %d ws %zu\n", cus, per_cu, ws_size);
        grid = cus > 0 ? cus : 256;
    }
    if (grid < 0) return;
    (void)hipMemsetAsync(d_ws, 0, 65536, stream);
    Args a{};
    for (int i = 0; i < 19; ++i) a.in[i] = (const float*)d_in[i];
    a.out = (float*)d_out; a.ws = (unsigned char*)d_ws;
    void* args[] = {&a};
    hipError_t e = hipLaunchCooperativeKernel((const void*)fwd_mega, dim3(grid), dim3(NTHR), args, LDS_BYTES, stream);
    if (e != hipSuccess) fprintf(stderr, "cooperative launch failed: %s (grid %d)\n", hipGetErrorString(e), grid);
}
```

```cpp
#ifndef DBG_NL
#define DBG_NL 4
#endif
#include <hip/hip_runtime.h>
#include <hip/hip_cooperative_groups.h>
#include <cstdio>
#include <cstdint>
namespace cg = cooperative_groups;

#define LAS __attribute__((address_space(3)))
#define GAS __attribute__((address_space(1)))
typedef unsigned short bf16_t;
typedef short bf16x8 __attribute__((ext_vector_type(8)));
typedef float f32x4 __attribute__((ext_vector_type(4)));
typedef unsigned u32x4 __attribute__((ext_vector_type(4)));
typedef unsigned u32x2 __attribute__((ext_vector_type(2)));

constexpr int DM = 2048, NB = 4, SEQ = 2048, CTX = 256, DI = 4096;
constexpr int MLAT = NB * SEQ, MCTX = NB * CTX, MTOT = MLAT + MCTX;
constexpr float EPS = 1e-6f;
constexpr int NTHR = 512, NWAVES = 8;
constexpr int LDS_BYTES = 147456;

constexpr size_t MiB = 1u << 20;
constexpr size_t WS_MOD = 1 * MiB;
constexpr size_t WS_LB = WS_MOD + 512 * 1024;
constexpr size_t WS_XC = 2 * MiB;
constexpr size_t WS_H = 10 * MiB;
constexpr size_t WS_WIN = 46 * MiB;
constexpr size_t WS_WOUT = 126 * MiB;
constexpr size_t WS_WG = 142 * MiB;
constexpr size_t WS_S0 = 150 * MiB;
constexpr size_t SLOT = 72 * MiB;
constexpr size_t WS_END = WS_S0 + 9 * SLOT;

typedef __bf16 bf2_t __attribute__((ext_vector_type(2)));
__device__ __forceinline__ unsigned pk2(float lo, float hi) { bf2_t v; v.x = (__bf16)lo; v.y = (__bf16)hi; return __builtin_bit_cast(unsigned, v); }
__device__ __forceinline__ float bflo(unsigned w) { return __uint_as_float(w << 16); }
__device__ __forceinline__ float bfhi(unsigned w) { return __uint_as_float(w & 0xffff0000u); }
__device__ __forceinline__ float fast_exp(float x) { return __expf(x); }
__device__ __forceinline__ float silu_f(float x) { return x * __builtin_amdgcn_rcpf(1.0f + __expf(-x)); }
__device__ __forceinline__ float wave_sum(float v) {
#pragma unroll
    for (int o = 1; o < 64; o <<= 1) v += __shfl_xor(v, o);
    return v;
}
#define LDS_WAIT() asm volatile("s_waitcnt lgkmcnt(0)" ::: "memory")
#define LAUNDER_V(x) asm volatile("" : "+v"(x))
#define LAUNDER_S(x) asm volatile("" : "+s"(x))
__device__ __forceinline__ int my_tid() { int t = threadIdx.x; LAUNDER_V(t); return t; }

namespace pg8 {
constexpr int BM = 256, BK = 64, HALF = 128, HTB = HALF * BK * 2, STAGE_BYTES = 8 * HTB, NXCD = 8, WGM = 8;
__device__ __forceinline__ int lds_byte(int r, int c) { const int st = (r >> 4) * 2 + (c >> 5), rr = r & 15, cc = c & 31, ob = rr * 64 + cc * 2; return st * 1024 + (ob ^ (((ob >> 9) & 1) << 5)); }
__device__ __forceinline__ void stage_rc(int b, int& R, int& C) { const int st = b / 1024, sb = b % 1024, swz = sb ^ (((sb >> 9) & 1) << 5); R = (st >> 1) * 16 + swz / 64; C = (st & 1) * 32 + (swz % 64) / 2; }
__device__ __forceinline__ int perm32(int rho) { const int n = rho >> 4, i = rho & 15; return 8 * (i >> 2) + 4 * n + (i & 3); }

struct Job {
    const bf16_t* A; const bf16_t* Bt; int nM, nN; int agdiv; size_t agstride;
    int segw; int acts; void* o0; void* o1; void* o2; void* o3; int ldo;
    const float* aux_f; const bf16_t* aux_b;
};
__device__ __forceinline__ void job_write(LAS unsigned char* p, const Job& J) {
    *(LAS unsigned long long*)(p + 0) = (unsigned long long)J.A; *(LAS unsigned long long*)(p + 8) = (unsigned long long)J.Bt;
    *(LAS int*)(p + 16) = J.nM; *(LAS int*)(p + 20) = J.nN; *(LAS int*)(p + 24) = J.agdiv; *(LAS int*)(p + 28) = J.ldo;
    *(LAS unsigned long long*)(p + 32) = (unsigned long long)J.agstride; *(LAS int*)(p + 40) = J.segw; *(LAS int*)(p + 44) = J.acts;
    *(LAS unsigned long long*)(p + 48) = (unsigned long long)J.o0; *(LAS unsigned long long*)(p + 56) = (unsigned long long)J.o1;
    *(LAS unsigned long long*)(p + 64) = (unsigned long long)J.o2; *(LAS unsigned long long*)(p + 72) = (unsigned long long)J.o3;
    *(LAS unsigned long long*)(p + 80) = (unsigned long long)J.aux_f; *(LAS unsigned long long*)(p + 88) = (unsigned long long)J.aux_b;
}
__device__ __forceinline__ int jl_i(const LAS unsigned char* p) { return __builtin_amdgcn_readfirstlane(*(const LAS int*)p); }
__device__ __forceinline__ unsigned long long jl_p(const LAS unsigned char* p) {
    const unsigned lo = (unsigned)__builtin_amdgcn_readfirstlane(*(const LAS int*)p), hi = (unsigned)__builtin_amdgcn_readfirstlane(*(const LAS int*)(p + 4));
    return ((unsigned long long)hi << 32) | lo;
}
struct Unit { int job, pm, pn; };

__device__ __forceinline__ void decode_tile(int l, int nM, int nN, int& pm, int& pn) {
    const int nwg = nM * nN; int wgid = l;
    { const int q = nwg / NXCD, r = nwg % NXCD, xcd = wgid % NXCD, off = wgid / NXCD; wgid = (xcd < r ? xcd * (q + 1) : r * (q + 1) + (xcd - r) * q) + off; }
    const int nig = WGM * nN, gid = wgid / nig, fm = gid * WGM, gsz = (nM - fm) < WGM ? (nM - fm) : WGM;
    pm = fm + ((wgid % nig) % gsz); pn = (wgid % nig) / gsz;
}

__device__ __forceinline__ void store_bf8(GAS bf16_t* p, const f32x4& v0, const f32x4& v1) {
    u32x4 w; w.x = pk2(v0[0], v0[1]); w.y = pk2(v0[2], v0[3]); w.z = pk2(v1[0], v1[1]); w.w = pk2(v1[2], v1[3]);
    *(GAS u32x4*)p = w;
}

__device__ __forceinline__ void epilogue(const f32x4 (&acc)[2][2][4][2], const LAS unsigned char* jt, const Unit& u, int wr, int wc, int fr_, int fq_) {
    int fr = fr_, fq = fq_; asm volatile("" : "+v"(fr), "+v"(fq));
    const LAS unsigned char* jp = jt + u.job * 128;
    const int segw = jl_i(jp + 40), acts = jl_i(jp + 44);
    const int colt = u.pn * BM; const int seg = colt / segw; const int act = (acts >> (4 * seg)) & 15;
    GAS unsigned char* op = (GAS unsigned char*)jl_p(jp + 48 + 8 * seg);
    const int col0 = colt - seg * segw + wc * 32 + 8 * fq;
    const int row0 = u.pm * BM + wr * 64 + fr;
    const int ldo = jl_i(jp + 28);
    const GAS float* aux_f = (const GAS float*)jl_p(jp + 80); const GAS bf16_t* aux_b = (const GAS bf16_t*)jl_p(jp + 88);
    if (act <= 2) {
        GAS bf16_t* O = (GAS bf16_t*)op;
#pragma unroll
        for (int ai = 0; ai < 2; ++ai)
#pragma unroll
            for (int m = 0; m < 4; ++m) {
                GAS bf16_t* rowp = O + (size_t)(row0 + ai * HALF + m * 16) * ldo + col0;
#pragma unroll
                for (int bj = 0; bj < 2; ++bj) {
                    f32x4 v0 = acc[ai][bj][m][0], v1 = acc[ai][bj][m][1];
                    if (act == 1) { v0 *= 0.08838834764831845f; v1 *= 0.08838834764831845f; }
                    if (act == 2) {
#pragma unroll
                        for (int j = 0; j < 4; ++j) { v0[j] = silu_f(v0[j]); v1[j] = silu_f(v1[j]); }
                    }
                    store_bf8(rowp + bj * HALF, v0, v1);
                }
            }
    } else if (act == 7) {
        GAS bf16_t* O = (GAS bf16_t*)op;
#pragma unroll
        for (int ai = 0; ai < 2; ++ai)
#pragma unroll
            for (int m = 0; m < 4; ++m) {
                const int token = row0 + ai * HALF + m * 16;
#pragma unroll
                for (int bj = 0; bj < 2; ++bj) {
                    const int col = col0 + bj * HALF, hd = col >> 7, d0 = col & 127;
                    store_bf8(O + ((size_t)(token >> 3) * 32 + hd) * 1024 + (d0 >> 4) * 128 + (token & 7) * 16 + ((d0 >> 3) & 1) * 8, acc[ai][bj][m][0], acc[ai][bj][m][1]);
                }
            }
    } else if (act == 8) {
        GAS bf16_t* O = (GAS bf16_t*)op;
#pragma unroll
        for (int ai = 0; ai < 2; ++ai)
#pragma unroll
            for (int m = 0; m < 4; ++m) {
                const int rr = row0 + ai * HALF + m * 16;
#pragma unroll
                for (int bj = 0; bj < 2; ++bj) {
                    const int t0 = col0 + bj * HALF;
                    store_bf8(O + ((size_t)(t0 >> 3) * 32 + (rr >> 7)) * 1024 + (rr & 127) * 8, acc[ai][bj][m][0], acc[ai][bj][m][1]);
                }
            }
    } else if (act == 3 || act == 4) {
        GAS float* O = (GAS float*)op;
        const GAS float* lbp = aux_f + (act - 3) * 4096 + col0;
#pragma unroll
        for (int bj = 0; bj < 2; ++bj) {
            const f32x4 l0 = *(const GAS f32x4*)(lbp + bj * HALF), l1 = *(const GAS f32x4*)(lbp + bj * HALF + 4);
#pragma unroll
            for (int ai = 0; ai < 2; ++ai)
#pragma unroll
                for (int m = 0; m < 4; ++m) {
                    GAS float* rowp = O + (size_t)(row0 + ai * HALF + m * 16) * ldo + col0 + bj * HALF;
                    f32x4 v0 = acc[ai][bj][m][0], v1 = acc[ai][bj][m][1];
#pragma unroll
                    for (int j = 0; j < 4; ++j) {
                        const float s0 = __builtin_amdgcn_rcpf(1.0f + __expf(-v0[j])), s1 = __builtin_amdgcn_rcpf(1.0f + __expf(-v1[j]));
                        v0[j] = __logf(l0[j] + (1.0f - l0[j]) * s0); v1[j] = __logf(l1[j] + (1.0f - l1[j]) * s1);
                    }
                    *(GAS f32x4*)rowp = v0; *(GAS f32x4*)(rowp + 4) = v1;
                }
        }
    } else if (act == 5) {
        GAS float* O = (GAS float*)op;
#pragma unroll
        for (int ai = 0; ai < 2; ++ai)
#pragma unroll
            for (int m = 0; m < 4; ++m) {
                GAS float* rowp = O + (size_t)(row0 + ai * HALF + m * 16) * ldo + col0;
#pragma unroll
                for (int bj = 0; bj < 2; ++bj) { *(GAS f32x4*)(rowp + bj * HALF) = acc[ai][bj][m][0]; *(GAS f32x4*)(rowp + bj * HALF + 4) = acc[ai][bj][m][1]; }
            }
    } else {
        GAS bf16_t* O = (GAS bf16_t*)op;
#pragma unroll
        for (int bj = 0; bj < 2; ++bj) {
            const f32x4 s0 = *(const GAS f32x4*)(aux_f + col0 + bj * HALF), s1 = *(const GAS f32x4*)(aux_f + col0 + bj * HALF + 4);
#pragma unroll
            for (int ai = 0; ai < 2; ++ai)
#pragma unroll
                for (int m = 0; m < 4; ++m) {
                    const size_t off = (size_t)(row0 + ai * HALF + m * 16) * ldo + col0 + bj * HALF;
                    const u32x4 z = *(const GAS u32x4*)(aux_b + off);
                    f32x4 v0 = acc[ai][bj][m][0] * s0, v1 = acc[ai][bj][m][1] * s1;
                    v0[0] *= bflo(z.x); v0[1] *= bfhi(z.x); v0[2] *= bflo(z.y); v0[3] *= bfhi(z.y);
                    v1[0] *= bflo(z.z); v1[1] *= bfhi(z.z); v1[2] *= bflo(z.w); v1[3] *= bfhi(z.w);
                    store_bf8(O + off, v0, v1);
                }
        }
    }
}

__device__ __forceinline__ bool next_unit(int i, int G, int c, const LAS unsigned char* jt, int n0, int n1, Unit& u) {
    const int L = i * G + c; if (L >= n0 + n1) return false;
    const int job = L < n0 ? 0 : 1; const LAS unsigned char* jp = jt + job * 128;
    u.job = job; decode_tile(job ? L - n0 : L, jl_i(jp + 16), jl_i(jp + 20), u.pm, u.pn);
    return true;
}
__device__ __forceinline__ const char* unit_a(const LAS unsigned char* jt, const Unit& u, size_t tstep) {
    const LAS unsigned char* jp = jt + u.job * 128;
    return (const char*)jl_p(jp + 0) + (size_t)(u.pn / jl_i(jp + 24)) * jl_p(jp + 32) * 2 + (size_t)u.pm * tstep;
}
__device__ __forceinline__ const char* unit_b(const LAS unsigned char* jt, const Unit& u, size_t tstep) {
    const LAS unsigned char* jp = jt + u.job * 128;
    return (const char*)jl_p(jp + 8) + (size_t)u.pn * tstep;
}

__device__ __forceinline__ void gemm_phase(LAS unsigned char* lds, const LAS unsigned char* jt, const int K, const int n0, const int n1, const int G, const int c) {
    int tid_ = threadIdx.x; asm volatile("" : "+v"(tid_));
    const int tid = tid_, wid = __builtin_amdgcn_readfirstlane(tid >> 6), lane = tid & 63, wr = wid >> 2, wc = wid & 3, fr = lane & 15, fq = lane >> 4;
    const int nt = K / BK;
    unsigned voffA[2], voffB[2];
#pragma unroll
    for (int i = 0; i < 2; ++i) { int R, C; stage_rc(tid * 16 + i * 8192, R, C); const int Rb = (R & ~31) + perm32(R & 31);
        voffA[i] = (unsigned)(R * K + C) * 2u; voffB[i] = (unsigned)(Rb * K + C) * 2u; }
    const size_t kstep = (size_t)(BK * 2);
    const size_t hstep = (size_t)HALF * K * 2;
    const size_t tstep = 2 * hstep;
    const unsigned ldsw = (unsigned)wid * 1024u;
    const int aoff = lds_byte(wr * 64 + fr, fq * 8), boff = lds_byte(wc * 32 + fr, fq * 8);
#define PG8_SA(b, h) (((b) * 2 + (h)) * HTB)
#define PG8_SB(b, h) ((4 + (b) * 2 + (h)) * HTB)
#define PG8_STAGE(bufoff, gbase, voff) do { _Pragma("unroll") for (int _i = 0; _i < 2; ++_i) \
        __builtin_amdgcn_global_load_lds((const unsigned*)((const char*)(gbase) + (voff)[_i]), (LAS unsigned*)(lds + (bufoff) + ldsw + _i * 8192), 16, 0, 0); } while (0)
#define PG8_LDA(dst, b, h) do { _Pragma("unroll") for (int m = 0; m < 4; ++m) _Pragma("unroll") for (int k = 0; k < 2; ++k) dst[m][k] = *(const LAS bf16x8*)(lds + PG8_SA(b, h) + aoff + m * 2048 + k * 1024); } while (0)
#define PG8_LDB(dst, b, h) do { _Pragma("unroll") for (int n = 0; n < 2; ++n) _Pragma("unroll") for (int k = 0; k < 2; ++k) dst[n][k] = *(const LAS bf16x8*)(lds + PG8_SB(b, h) + boff + n * 2048 + k * 1024); } while (0)
#define PG8_MMA(ai, bj, At, Bt) do { __builtin_amdgcn_s_setprio(1); _Pragma("unroll") for (int m = 0; m < 4; ++m) _Pragma("unroll") for (int n = 0; n < 2; ++n) _Pragma("unroll") for (int k = 0; k < 2; ++k) \
        acc[ai][bj][m][n] = __builtin_amdgcn_mfma_f32_16x16x32_bf16(Bt[n][k], At[m][k], acc[ai][bj][m][n], 0, 0, 0); __builtin_amdgcn_s_setprio(0); } while (0)
#define PG8_WAIT_V(n) asm volatile("s_waitcnt vmcnt(" #n ")" ::: "memory")
#define PG8_WAIT_L(n) asm volatile("s_waitcnt lgkmcnt(" #n ")" ::: "memory")
#define PG8_BAR __builtin_amdgcn_s_barrier()
#define PG8_SCHED __builtin_amdgcn_sched_barrier(0)
#define PG8_UA(u) unit_a(jt, (u), tstep)
#define PG8_UB(u) unit_b(jt, (u), tstep)
    Unit cur, nxt; int ui = 0;
    if (!next_unit(0, G, c, jt, n0, n1, cur)) return;
    f32x4 acc[2][2][4][2];
#pragma unroll
    for (int a = 0; a < 2; ++a)
#pragma unroll
        for (int b = 0; b < 2; ++b)
#pragma unroll
            for (int m = 0; m < 4; ++m)
#pragma unroll
                for (int n = 0; n < 2; ++n) acc[a][b][m][n] = (f32x4){0.f, 0.f, 0.f, 0.f};
    bf16x8 At[4][2], B0[2][2], B1[2][2];
    const char* cA = PG8_UA(cur); const char* cB = PG8_UB(cur);
    PG8_STAGE(PG8_SB(0, 0), cB, voffB); PG8_STAGE(PG8_SB(0, 1), cB + hstep, voffB); PG8_STAGE(PG8_SA(0, 0), cA, voffA); PG8_STAGE(PG8_SA(0, 1), cA + hstep, voffA);
    if (wr == 1) PG8_BAR;
    PG8_WAIT_V(2); PG8_BAR;
    PG8_STAGE(PG8_SB(1, 0), cB + kstep, voffB); PG8_STAGE(PG8_SA(1, 0), cA + kstep, voffA); PG8_STAGE(PG8_SB(1, 1), cB + hstep + kstep, voffB);
    PG8_WAIT_V(6); PG8_BAR;
    for (;;) {
        const bool has_next = next_unit(ui + 1, G, c, jt, n0, n1, nxt);
        const char* nA = cA; const char* nB = cB;
        if (has_next) { nA = PG8_UA(nxt); nB = PG8_UB(nxt); }
        for (int t = 0; t < nt; t += 2) {
            const bool last = (t == nt - 2);
            const char* a1 = cA + (size_t)(t + 1) * kstep;
            const char* a2 = last ? nA : cA + (size_t)(t + 2) * kstep; const char* b2 = last ? nB : cB + (size_t)(t + 2) * kstep;
            const char* a3 = a2 + kstep; const char* b3 = b2 + kstep;
            PG8_LDB(B0, 0, 0); PG8_LDB(B1, 0, 1); PG8_SCHED; PG8_LDA(At, 0, 0); PG8_STAGE(PG8_SA(1, 1), a1 + hstep, voffA);
            PG8_WAIT_V(8); PG8_WAIT_L(0); PG8_BAR; PG8_MMA(0, 0, At, B0); PG8_MMA(0, 1, At, B1); PG8_BAR; PG8_SCHED;
            PG8_LDA(At, 0, 1); PG8_STAGE(PG8_SB(0, 0), b2, voffB); PG8_STAGE(PG8_SB(0, 1), b2 + hstep, voffB); PG8_STAGE(PG8_SA(0, 0), a2, voffA);
            PG8_WAIT_V(8); PG8_WAIT_L(0); PG8_BAR; PG8_MMA(1, 0, At, B0); PG8_MMA(1, 1, At, B1); PG8_BAR; PG8_SCHED;
            PG8_LDB(B0, 1, 0); PG8_LDB(B1, 1, 1); PG8_SCHED; PG8_LDA(At, 1, 0); PG8_STAGE(PG8_SA(0, 1), a2 + hstep, voffA);
            PG8_WAIT_V(8); PG8_WAIT_L(0); PG8_BAR; PG8_MMA(0, 0, At, B0); PG8_MMA(0, 1, At, B1); PG8_BAR; PG8_SCHED;
            PG8_LDA(At, 1, 1); PG8_STAGE(PG8_SB(1, 0), b3, voffB); PG8_STAGE(PG8_SB(1, 1), b3 + hstep, voffB); PG8_STAGE(PG8_SA(1, 0), a3, voffA);
            PG8_WAIT_V(8); PG8_WAIT_L(0); PG8_BAR; PG8_MMA(1, 0, At, B0); PG8_MMA(1, 1, At, B1); PG8_BAR; PG8_SCHED;
        }
        if (wr == 0) PG8_BAR;
        epilogue(acc, jt, cur, wr, wc, fr, fq);
        if (!has_next) break;
#pragma unroll
        for (int a = 0; a < 2; ++a)
#pragma unroll
            for (int b = 0; b < 2; ++b)
#pragma unroll
                for (int m = 0; m < 4; ++m)
#pragma unroll
                    for (int n = 0; n < 2; ++n) acc[a][b][m][n] = (f32x4){0.f, 0.f, 0.f, 0.f};
        cur = nxt; cA = nA; cB = nB; ++ui;
        if (wr == 1) PG8_BAR;
    }
    PG8_WAIT_V(0);
    PG8_BAR;
#undef PG8_SA
#undef PG8_SB
#undef PG8_STAGE
#undef PG8_LDA
#undef PG8_LDB
#undef PG8_MMA
#undef PG8_WAIT_V
#undef PG8_WAIT_L
#undef PG8_BAR
#undef PG8_SCHED
#undef PG8_UA
#undef PG8_UB
}
}

struct Args {
    const float* in[19]; float* out; unsigned char* ws;
};

__device__ __forceinline__ void tr_item(const float* __restrict__ W, int K, int N, bf16_t* WT, int segperm, LAS float* scr, int item, int lane) {
    const int nblk = N >> 6, kb = item / nblk, nb = item - kb * nblk, k0 = kb << 6, n0 = nb << 6;
    const float* src = W + (size_t)k0 * N + n0 + lane;
#pragma unroll 16
    for (int i = 0; i < 64; ++i) scr[i * 65 + lane] = src[(size_t)i * N];
    LDS_WAIT();
    const int seg = n0 >> 12, dseg = (segperm >> (4 * seg)) & 15, drow0 = n0 + (dseg - seg) * 4096;
    const int c = lane & 7;
#pragma unroll
    for (int j = 0; j < 8; ++j) {
        const int n = (lane >> 3) + 8 * j; const LAS float* s = scr + (8 * c) * 65 + n;
        u32x4 o; o.x = pk2(s[0], s[65]); o.y = pk2(s[130], s[195]); o.z = pk2(s[260], s[325]); o.w = pk2(s[390], s[455]);
        *(u32x4*)(WT + (size_t)(drow0 + n) * K + k0 + 8 * c) = o;
    }
    LDS_WAIT();
}

__device__ __forceinline__ void transpose_layer(const Args& a, int layer, LAS unsigned char* lds, int gw, int NGW, int wave, int lane) {
    LAS float* scr = (LAS float*)(lds + wave * 16640);
    bf16_t* WIN = (bf16_t*)(a.ws + WS_WIN); bf16_t* WOUT = (bf16_t*)(a.ws + WS_WOUT); bf16_t* WG = (bf16_t*)(a.ws + WS_WG);
    const int kind = layer % 3, j = layer / 3;
    if (kind == 0) {
        const float* win = a.in[8] + (size_t)j * DM * 16384; const float* wout = a.in[10] + (size_t)j * DI * DM;
        const int n_in = (DM / 64) * (16384 / 64), n_out = (DI / 64) * (DM / 64);
        for (int it = gw; it < n_in + n_out; it += NGW) {
            if (it < n_in) tr_item(win, DM, 16384, WIN, 0x2310, scr, it, lane);
            else tr_item(wout, DI, DM, WOUT, 0x43210, scr, it - n_in, lane);
        }
    } else if (kind == 1) {
        const float* win = a.in[11]; const float* wg = a.in[12]; const float* wout = a.in[14];
        const int n_in = (DM / 64) * (8192 / 64), n_g = 16 * 16, n_out = (DI / 64) * (DM / 64);
        for (int it = gw; it < n_in + 4 * n_g + n_out; it += NGW) {
            if (it < n_in) tr_item(win, DM, 8192, WIN, 0x43210, scr, it, lane);
            else if (it < n_in + 4 * n_g) { const int g = (it - n_in) / n_g, r = (it - n_in) % n_g; tr_item(wg + (size_t)g * 1024 * 1024, 1024, 1024, WG + (size_t)g * 1024 * 1024, 0x43210, scr, r, lane); }
            else tr_item(wout, DI, DM, WOUT, 0x43210, scr, it - n_in - 4 * n_g, lane);
        }
    } else {
        const float* win = a.in[15]; const float* wout = a.in[18];
        const int n_in = (DM / 64) * (20480 / 64), n_out = (DI / 64) * (DM / 64);
        for (int it = gw; it < n_in + n_out; it += NGW) {
            if (it < n_in) tr_item(win, DM, 20480, WIN, 0x34210, scr, it, lane);
            else tr_item(wout, DI, DM, WOUT, 0x43210, scr, it - n_in, lane);
        }
    }
}

__device__ __forceinline__ void row_phase(const Args& a, int li, LAS unsigned char* lds, int G, int tid, int wave, int lane) {
    LAS f32x4* V = (LAS f32x4*)lds;
    const float* MOD = (const float*)(a.ws + WS_MOD);
    float* XC = (float*)(a.ws + WS_XC); bf16_t* H = (bf16_t*)(a.ws + WS_H);
    const bf16_t* Y = (const bf16_t*)(a.ws + WS_S0 + 5 * SLOT);
    for (int rb = blockIdx.x; rb < 256; rb += G) {
        const int mrl = rb >> 6;
        __syncthreads();
        {
            const int c4 = 4 * tid;
            if (li > 0) {
                const f32x4 gp = *(const f32x4*)(a.in[7] + (size_t)(li - 1) * DM + c4);
                const f32x4 gl = *(const f32x4*)(MOD + (size_t)((li - 1) * 5 + mrl) * 6144 + 4096 + c4), gc = *(const f32x4*)(MOD + (size_t)((li - 1) * 5 + 4) * 6144 + 4096 + c4);
                V[0 * 512 + tid] = gl * gp; V[1 * 512 + tid] = gc * gp;
            }
            if (li < 4) {
                const f32x4 gpre = *(const f32x4*)(a.in[6] + (size_t)li * DM + c4);
                const float* ml = MOD + (size_t)(li * 5 + mrl) * 6144 + c4; const float* mc = MOD + (size_t)(li * 5 + 4) * 6144 + c4;
                V[2 * 512 + tid] = gpre * (1.0f + *(const f32x4*)(ml + 2048)); V[3 * 512 + tid] = gpre * (1.0f + *(const f32x4*)(mc + 2048));
                V[4 * 512 + tid] = *(const f32x4*)ml; V[5 * 512 + tid] = *(const f32x4*)mc;
            }
        }
        __syncthreads();
        const int nr = (li == 4) ? 4 : (wave < 4 ? 5 : 4);
        for (int k = 0; k < nr; ++k) {
            const bool lat = k < 4;
            const int row = lat ? rb * 32 + wave * 4 + k : MLAT + rb * 4 + wave;
            const LAS f32x4* Vr = V + (lat ? 0 : 512) + lane;
            float* xrow = lat ? a.out + (size_t)row * DM : XC + (size_t)(row - MLAT) * DM;
            f32x4 xv[8];
            if (li == 0) {
                const float* src = lat ? a.in[0] + (size_t)row * DM : a.in[2] + (size_t)(row - MLAT) * DM;
#pragma unroll
                for (int j = 0; j < 8; ++j) xv[j] = *(const f32x4*)(src + 4 * lane + 256 * j);
#pragma unroll
                for (int j = 0; j < 8; ++j) *(f32x4*)(xrow + 4 * lane + 256 * j) = xv[j];
            } else {
                const bf16_t* yrow = Y + (size_t)row * DM;
                u32x2 yw[8];
#pragma unroll
                for (int j = 0; j < 8; ++j) xv[j] = *(const f32x4*)(xrow + 4 * lane + 256 * j);
#pragma unroll
                for (int j = 0; j < 8; ++j) yw[j] = *(const u32x2*)(yrow + 4 * lane + 256 * j);
                f32x4 yv[8]; float ss = 0.f;
#pragma unroll
                for (int j = 0; j < 8; ++j) { yv[j] = (f32x4){bflo(yw[j].x), bfhi(yw[j].x), bflo(yw[j].y), bfhi(yw[j].y)}; ss += (yv[j].x * yv[j].x + yv[j].y * yv[j].y) + (yv[j].z * yv[j].z + yv[j].w * yv[j].w); }
                const float rstd = rsqrtf(wave_sum(ss) * (1.0f / DM) + EPS);
#pragma unroll
                for (int j = 0; j < 8; ++j) {
                    xv[j] += Vr[0 * 512 + 64 * j] * (yv[j] * rstd);
                    *(f32x4*)(xrow + 4 * lane + 256 * j) = xv[j];
                }
            }
            if (li < 4) {
                float ss = 0.f;
#pragma unroll
                for (int j = 0; j < 8; ++j) ss += (xv[j].x * xv[j].x + xv[j].y * xv[j].y) + (xv[j].z * xv[j].z + xv[j].w * xv[j].w);
                const float rstd = rsqrtf(wave_sum(ss) * (1.0f / DM) + EPS);
                bf16_t* hrow = H + (size_t)row * DM;
#pragma unroll
                for (int j = 0; j < 8; ++j) {
                    const f32x4 hv = (xv[j] * rstd) * Vr[2 * 512 + 64 * j] + Vr[4 * 512 + 64 * j];
                    u32x2 w; w.x = pk2(hv.x, hv.y); w.y = pk2(hv.z, hv.w);
                    *(u32x2*)(hrow + 4 * lane + 256 * j) = w;
                }
            }
        }
    }
}

__device__ __forceinline__ void init_phase(const Args& a, LAS unsigned char* lds, int G) {
    LAS float* sc = (LAS float*)lds;
    LAS float* red = sc + 5 * 2048;
    const int tid = my_tid();
    float* MOD = (float*)(a.ws + WS_MOD); float* LB = (float*)(a.ws + WS_LB);
    for (int e = tid; e < 5 * 2048; e += NTHR) { const int r = e >> 11, k = e & 2047; const float v = r < 4 ? a.in[1][r * 2048 + k] : a.in[3][k]; sc[e] = silu_f(v); }
    __syncthreads();
    for (int item = blockIdx.x; item < 384; item += G) {
        const int layer = item / 96, n0 = (item % 96) * 64, ks = tid >> 6, nn = tid & 63;
        float acc0 = 0.f, acc1 = 0.f, acc2 = 0.f, acc3 = 0.f, acc4 = 0.f;
        const float* wp = a.in[4] + ((size_t)layer * 2048 + ks * 256) * 6144 + n0 + nn;
        const LAS float* sp = sc + ks * 256;
#pragma unroll 32
        for (int kk = 0; kk < 256; ++kk) {
            const float w = wp[(size_t)kk * 6144];
            acc0 += sp[kk] * w; acc1 += sp[2048 + kk] * w; acc2 += sp[4096 + kk] * w; acc3 += sp[6144 + kk] * w; acc4 += sp[8192 + kk] * w;
        }
        red[(ks * 5 + 0) * 64 + nn] = acc0; red[(ks * 5 + 1) * 64 + nn] = acc1; red[(ks * 5 + 2) * 64 + nn] = acc2; red[(ks * 5 + 3) * 64 + nn] = acc3; red[(ks * 5 + 4) * 64 + nn] = acc4;
        __syncthreads();
        if (tid < 320) {
            const int r = tid >> 6, n2 = tid & 63; float s = 0.f;
#pragma unroll
            for (int k8 = 0; k8 < 8; ++k8) s += red[(k8 * 5 + r) * 64 + n2];
            MOD[(size_t)(layer * 5 + r) * 6144 + n0 + n2] = s + a.in[5][layer * 6144 + n0 + n2];
        }
        __syncthreads();
    }
    const int gt = blockIdx.x * NTHR + tid;
    if (gt < 2 * 4096) {
        const int d = gt >> 12, f = gt & 4095; const float* p = a.in[16] + (size_t)d * 4 * 4096 + f;
        const float l0 = p[0], l1 = p[4096], l2 = p[8192], l3 = p[12288];
        const float mx = fmaxf(fmaxf(l0, l1), fmaxf(l2, l3));
        const float e0 = expf(l0 - mx), e1 = expf(l1 - mx), e2 = expf(l2 - mx), e3 = expf(l3 - mx);
        LB[gt] = (e1 + e2) / (e0 + e1 + e2 + e3);
    }
}

typedef float f32x16 __attribute__((ext_vector_type(16)));
__device__ __forceinline__ void attn_phase(const Args& a, int layer, LAS unsigned char* lds, int G, int need_ctx) {
    const int tid = my_tid(), wave = __builtin_amdgcn_readfirstlane(tid >> 6), lane = tid & 63, q = lane & 31, hh = lane >> 5;
    const bf16_t* Q = (const bf16_t*)(a.ws + WS_S0); const bf16_t* Kp = (const bf16_t*)(a.ws + WS_S0 + SLOT);
    const bf16_t* SZ = (const bf16_t*)(a.ws + WS_S0 + 2 * SLOT); const bf16_t* Vt = (const bf16_t*)(a.ws + WS_S0 + 3 * SLOT);
    bf16_t* GT = (bf16_t*)(a.ws + WS_S0 + 4 * SLOT);
    const float* rpb = a.in[9] + (size_t)(layer / 3) * 32 * 465;
    LAS float* rp = (LAS float*)(lds + wave * 2048);
    const int gw = blockIdx.x * NWAVES + wave, NGW = G * NWAVES;
    const int nlat = 8192, ntask = nlat + (need_ctx ? 1024 : 0);
    const int sig = (q & 19) | ((q & 8) >> 1) | ((q & 4) << 1);
    for (int task = gw; task < ntask; task += NGW) {
        const bool lat = task < nlat;
        int b, h, r = 0, j = 0, qtok;
        if (lat) { j = task & 3; r = 2 * ((task >> 2) & 15); h = (task >> 6) & 31; b = task >> 11; qtok = b * SEQ + (r + (q >> 4)) * 64 + 16 * j + (q & 15); }
        else { const int t2 = task - nlat; h = (t2 >> 3) & 31; b = t2 >> 8; qtok = MLAT + b * CTX + 32 * (t2 & 7) + q; }
        bf16x8 qf[8];
#pragma unroll
        for (int c = 0; c < 8; ++c) qf[c] = *(const bf16x8*)(Q + (size_t)qtok * DI + h * 128 + 16 * c + 8 * hh);
        if (lat) {
            LDS_WAIT();
            for (int e = lane; e < 465; e += 64) rp[e] = rpb[h * 465 + e];
            LDS_WAIT();
        }
        const int r0a = min(max(r - 4, 0), 24), r0b = min(max(r - 3, 0), 24), nband = lat ? (r0b + 8 - r0a) : 0;
        const int qr = r + (q >> 4), myr0 = (q >> 4) ? r0b : r0a;
        const int cw = min(max(16 * j - 8, 0), 32), qcol = 16 * j + (q & 15), c0 = min(max(qcol - 8, 0), 48);
        const int nst = nband + 8;
        const int kb_lat = b * SEQ + r0a * 64 + cw, kb_ctx = MLAT + b * CTX;
        const bf16_t* kbase = Kp + (size_t)h * 1024 + (size_t)(sig >> 3) * 32768 + (sig & 7) * 16 + 8 * hh;
        const bf16_t* vbase = Vt + (size_t)h * 1024 + (size_t)hh * 32768 + q * 8;
        float m_run = -1e30f, l_run = 0.f;
        f32x16 OT[4];
#pragma unroll
        for (int d = 0; d < 4; ++d)
#pragma unroll
            for (int t = 0; t < 16; ++t) OT[d][t] = 0.f;
        bf16x8 kreg[8], vreg[8];
        { const int kb0 = nband ? kb_lat : kb_ctx;
#pragma unroll
          for (int c = 0; c < 8; ++c) kreg[c] = *(const bf16x8*)(kbase + (size_t)(kb0 >> 3) * 32768 + 128 * c); }
        for (int st = 0; st < nst; ++st) {
            const bool isl = st < nband;
            const int keybase = isl ? kb_lat + st * 64 : kb_ctx + 32 * (st - nband);
#pragma unroll
            for (int d = 0; d < 4; ++d)
#pragma unroll
                for (int s2 = 0; s2 < 2; ++s2) vreg[d * 2 + s2] = *(const bf16x8*)(vbase + (size_t)(keybase >> 3) * 32768 + s2 * 65536 + d * 256);
            f32x16 sc;
#pragma unroll
            for (int t = 0; t < 16; ++t) sc[t] = 0.f;
#pragma unroll
            for (int c = 0; c < 8; ++c) sc = __builtin_amdgcn_mfma_f32_32x32x16_bf16(kreg[c], qf[c], sc, 0, 0, 0);
            if (st + 1 < nst) {
                const int kn = (st + 1 < nband) ? kb_lat + (st + 1) * 64 : kb_ctx + 32 * (st + 1 - nband);
#pragma unroll
                for (int c = 0; c < 8; ++c) kreg[c] = *(const bf16x8*)(kbase + (size_t)(kn >> 3) * 32768 + 128 * c);
            }
            if (isl) {
                const int kr = r0a + st; const bool rowok = (kr >= myr0) && (kr < myr0 + 8);
                const int brow = (kr - qr + 7) * 31 - qcol + 15;
#pragma unroll
                for (int t = 0; t < 16; ++t) {
                    const int kc = cw + 16 * (t >> 3) + 8 * hh + (t & 7); const bool valid = rowok && (kc >= c0) && (kc < c0 + 16);
                    const float bias = rp[valid ? (brow + kc) : 0];
                    sc[t] = valid ? sc[t] + bias : -3.0e38f;
                }
            }
            float mx = sc[0];
#pragma unroll
            for (int t = 1; t < 16; ++t) mx = fmaxf(mx, sc[t]);
            mx = fmaxf(mx, __shfl_xor(mx, 32));
            const float m_new = fmaxf(m_run, mx), alpha = __expf(m_run - m_new);
            float rs = 0.f;
#pragma unroll
            for (int t = 0; t < 16; ++t) { sc[t] = __expf(sc[t] - m_new); rs += sc[t]; }
            rs += __shfl_xor(rs, 32);
            l_run = l_run * alpha + rs; m_run = m_new;
            union { u32x4 u; bf16x8 v; } P0, P1;
            P0.u.x = pk2(sc[0], sc[1]); P0.u.y = pk2(sc[2], sc[3]); P0.u.z = pk2(sc[4], sc[5]); P0.u.w = pk2(sc[6], sc[7]);
            P1.u.x = pk2(sc[8], sc[9]); P1.u.y = pk2(sc[10], sc[11]); P1.u.z = pk2(sc[12], sc[13]); P1.u.w = pk2(sc[14], sc[15]);
#pragma unroll
            for (int d = 0; d < 4; ++d) {
#pragma unroll
                for (int t = 0; t < 16; ++t) OT[d][t] *= alpha;
                OT[d] = __builtin_amdgcn_mfma_f32_32x32x16_bf16(vreg[d * 2 + 0], P0.v, OT[d], 0, 0, 0);
                OT[d] = __builtin_amdgcn_mfma_f32_32x32x16_bf16(vreg[d * 2 + 1], P1.v, OT[d], 0, 0, 0);
            }
        }
        const float inv = 1.0f / l_run;
        const size_t obase = (size_t)qtok * DI + h * 128 + 4 * hh;
#pragma unroll
        for (int d = 0; d < 4; ++d)
#pragma unroll
            for (int g4 = 0; g4 < 4; ++g4) {
                const size_t o = obase + 32 * d + 8 * g4;
                const u32x2 z = *(const u32x2*)(SZ + o);
                u32x2 w; w.x = pk2(OT[d][4 * g4 + 0] * inv * bflo(z.x), OT[d][4 * g4 + 1] * inv * bfhi(z.x)); w.y = pk2(OT[d][4 * g4 + 2] * inv * bflo(z.y), OT[d][4 * g4 + 3] * inv * bfhi(z.y));
                *(u32x2*)(GT + o) = w;
            }
    }
}

template <int W> __device__ __forceinline__ void pool_item(const bf16_t* __restrict__ U, bf16_t* __restrict__ Pg, int row, int col, int g, int t, int T, int base) {
    constexpr int hw = W / 2;
    u32x4 v[W];
#pragma unroll
    for (int i = 0; i < W; ++i) { const int tt = min(max(t - hw + i, 0), T - 1); v[i] = *(const u32x4*)(U + (size_t)(base + tt) * DI + col); }
    float acc[8];
#pragma unroll
    for (int e = 0; e < 8; ++e) acc[e] = 0.f;
#pragma unroll
    for (int i = 0; i < W; ++i) {
        const int tt = t - hw + i; const float wgt = (tt >= 0 && tt < T) ? 1.0f : 0.0f;
        acc[0] += wgt * bflo(v[i].x); acc[1] += wgt * bfhi(v[i].x); acc[2] += wgt * bflo(v[i].y); acc[3] += wgt * bfhi(v[i].y);
        acc[4] += wgt * bflo(v[i].z); acc[5] += wgt * bfhi(v[i].z); acc[6] += wgt * bflo(v[i].w); acc[7] += wgt * bfhi(v[i].w);
    }
    const int lo = max(t - hw, 0), hi = min(t + hw, T);
    const float ic = 1.0f / (float)(hi - lo);
    const u32x4 c = v[hw];
    u32x4 o; o.x = pk2(acc[0] * ic - bflo(c.x), acc[1] * ic - bfhi(c.x)); o.y = pk2(acc[2] * ic - bflo(c.y), acc[3] * ic - bfhi(c.y));
    o.z = pk2(acc[4] * ic - bflo(c.z), acc[5] * ic - bfhi(c.z)); o.w = pk2(acc[6] * ic - bflo(c.w), acc[7] * ic - bfhi(c.w));
    *(u32x4*)(Pg + ((size_t)g * MTOT + row) * 1024 + (col & 1023)) = o;
}
__device__ __forceinline__ void pool_phase(const Args& a, int G) {
    const bf16_t* U = (const bf16_t*)(a.ws + WS_S0); bf16_t* Pg = (bf16_t*)(a.ws + WS_S0 + SLOT);
    const int gt = blockIdx.x * NTHR + my_tid(), gsz = G * NTHR;
    for (int idx = gt; idx < MTOT * 512; idx += gsz) {
        const int row = idx >> 9, cv = idx & 511, col = cv * 8, g = col >> 10;
        int t, T, base;
        if (row < MLAT) { t = row & 2047; T = SEQ; base = row - t; } else { const int r2 = row - MLAT; t = r2 & 255; T = CTX; base = row - t; }
        if (g == 0) pool_item<2>(U, Pg, row, col, g, t, T, base);
        else if (g == 1) pool_item<4>(U, Pg, row, col, g, t, T, base);
        else if (g == 2) pool_item<8>(U, Pg, row, col, g, t, T, base);
        else pool_item<16>(U, Pg, row, col, g, t, T, base);
    }
}

__device__ __forceinline__ void hgate_phase(const Args& a, int G) {
    const bf16_t* Of = (const bf16_t*)(a.ws + WS_S0 + SLOT); const bf16_t* Ob = (const bf16_t*)(a.ws + WS_S0 + 4 * SLOT);
    const bf16_t* SZ = (const bf16_t*)(a.ws + WS_S0 + 2 * SLOT); bf16_t* GT = (bf16_t*)(a.ws + WS_S0);
    const float* gn = a.in[17];
    const int gt = blockIdx.x * NTHR + my_tid(), gsz = G * NTHR;
    for (int idx = gt; idx < MTOT * 512; idx += gsz) {
        const int row = idx >> 9, col = (idx & 511) * 8; const size_t off = (size_t)row * DI + col;
        const u32x4 f = *(const u32x4*)(Of + off), bk = *(const u32x4*)(Ob + off), z = *(const u32x4*)(SZ + off);
        float o[8];
        o[0] = bflo(f.x) + bflo(bk.x); o[1] = bfhi(f.x) + bfhi(bk.x); o[2] = bflo(f.y) + bflo(bk.y); o[3] = bfhi(f.y) + bfhi(bk.y);
        o[4] = bflo(f.z) + bflo(bk.z); o[5] = bfhi(f.z) + bfhi(bk.z); o[6] = bflo(f.w) + bflo(bk.w); o[7] = bfhi(f.w) + bfhi(bk.w);
        float ss = 0.f;
#pragma unroll
        for (int e = 0; e < 8; ++e) ss += o[e] * o[e];
        ss += __shfl_xor(ss, 1); ss += __shfl_xor(ss, 2); ss += __shfl_xor(ss, 4); ss += __shfl_xor(ss, 8);
        const float rstd = rsqrtf(ss * (1.0f / 128.0f) + EPS);
        const f32x4 g0 = *(const f32x4*)(gn + col), g1 = *(const f32x4*)(gn + col + 4);
        u32x4 w;
        w.x = pk2(o[0] * rstd * g0.x * bflo(z.x), o[1] * rstd * g0.y * bfhi(z.x)); w.y = pk2(o[2] * rstd * g0.z * bflo(z.y), o[3] * rstd * g0.w * bfhi(z.y));
        w.z = pk2(o[4] * rstd * g1.x * bflo(z.z), o[5] * rstd * g1.y * bfhi(z.z)); w.w = pk2(o[6] * rstd * g1.z * bflo(z.w), o[7] * rstd * g1.w * bfhi(z.w));
        *(u32x4*)(GT + off) = w;
    }
}

constexpr int SC_QT = 0, SC_KT = 8704, SC_KH = 17408, SC_DEC = 27648, SC_BUF = 28160, SC_TOT = 2 * SC_BUF;
struct ScanRaw { float lf[8]; unsigned short qs[8]; };

__device__ __forceinline__ void scan_chunk_t0(int cj, int b, int dir, int& t0) {
    const bool isctx = cj < 8;
    const int cc = isctx ? (dir ? 7 - cj : cj) : (dir ? 71 - cj : cj - 8);
    t0 = isctx ? MLAT + b * CTX + 32 * cc : b * SEQ + 32 * cc;
}

#define SCAN_BAR() do { asm volatile("s_waitcnt lgkmcnt(0)" ::: "memory"); __builtin_amdgcn_s_barrier(); asm volatile("" ::: "memory"); } while (0)
__device__ __forceinline__ void scan_phase(const Args& a, LAS unsigned char* lds, int G) {
    const int tid = my_tid(), wave = tid >> 6, lane = tid & 63, fr = lane & 15, fq = lane >> 4;
    const bf16_t* QS = (const bf16_t*)(a.ws + WS_S0); const bf16_t* Vt = (const bf16_t*)(a.ws + WS_S0 + 3 * SLOT);
    const int kch = tid & 127, part = tid >> 7;
    for (int sidx = blockIdx.x; sidx < 256; sidx += G) {
        const int dir = sidx & 1, h = (sidx >> 1) & 31, b = sidx >> 6;
        const float* LF = (const float*)(a.ws + WS_S0 + (dir ? 7 : 5) * SLOT);
        bf16_t* O = (bf16_t*)(a.ws + WS_S0 + (dir ? 4 : 1) * SLOT);
        f32x4 S[8];
#pragma unroll
        for (int k = 0; k < 8; ++k) S[k] = (f32x4){0.f, 0.f, 0.f, 0.f};
        float rlf[8]; unsigned short rqs[8]; bf16x8 vfn;
#define SCAN_RAW(cj) do { int _t0; scan_chunk_t0((cj), b, dir, _t0); \
        _Pragma("unroll") for (int e = 0; e < 8; ++e) { const int tau = 8 * part + e; const int tok = dir ? _t0 + 31 - tau : _t0 + tau; \
            rlf[e] = LF[(size_t)tok * DI + h * 128 + kch]; rqs[e] = QS[(size_t)tok * DI + h * 128 + kch]; } \
        vfn = *(const bf16x8*)(Vt + (size_t)(h * 128 + 16 * wave + fr) * MTOT + (dir ? _t0 + 24 - 8 * fq : _t0 + 8 * fq)); } while (0)
#define SCAN_PREP(bufp) do { LAS unsigned char* _B = (bufp); LAS float* TOT = (LAS float*)(lds + SC_TOT); \
        float cs[8]; float run = 0.f; \
        _Pragma("unroll") for (int e = 0; e < 8; ++e) { run += rlf[e]; cs[e] = run; } \
        TOT[part * 128 + kch] = run; SCAN_BAR(); \
        float off = 0.f, bend = 0.f; \
        _Pragma("unroll") for (int p = 0; p < 4; ++p) { const float tv = TOT[p * 128 + kch]; off += (p < part) ? tv : 0.f; bend += tv; } \
        unsigned kh[8]; \
        _Pragma("unroll") for (int e = 0; e < 8; ++e) { const int tau = 8 * part + e; const float bt = off + cs[e]; const float kf = 1.0f - __expf(rlf[e]); \
            const float qv = __uint_as_float(((unsigned)rqs[e]) << 16) * __expf(bt); const float kt = kf * __expf(-bt); const float kk = kf * __expf(bend - bt); \
            ((LAS bf16_t*)(_B + SC_QT))[tau * 136 + kch] = (bf16_t)(pk2(qv, 0.f) & 0xffffu); ((LAS bf16_t*)(_B + SC_KT))[tau * 136 + kch] = (bf16_t)(pk2(kt, 0.f) & 0xffffu); kh[e] = pk2(kk, 0.f) & 0xffffu; } \
        u32x4 kw; kw.x = kh[0] | (kh[1] << 16); kw.y = kh[2] | (kh[3] << 16); kw.z = kh[4] | (kh[5] << 16); kw.w = kh[6] | (kh[7] << 16); \
        *(LAS u32x4*)(_B + SC_KH + kch * 80 + part * 16) = kw; \
        if (part == 0) ((LAS float*)(_B + SC_DEC))[kch] = __expf(bend); } while (0)

        SCAN_RAW(0);
        SCAN_PREP(lds);
        bf16x8 vf = vfn;
        SCAN_RAW(1);
        SCAN_BAR();
        for (int ci = 0; ci < 72; ++ci) {
            LAS unsigned char* B = lds + (ci & 1) * SC_BUF;
            bf16x8 vf_next = vfn;
            if (ci + 1 < 72) { SCAN_PREP(lds + ((ci + 1) & 1) * SC_BUF); }
            if (ci + 2 < 72) { SCAN_RAW(ci + 2); }
            int t0; scan_chunk_t0(ci, b, dir, t0);
            bf16x8 vcur = vf;
            if (dir) { bf16x8 t = vf; vcur[0] = t[7]; vcur[1] = t[6]; vcur[2] = t[5]; vcur[3] = t[4]; vcur[4] = t[3]; vcur[5] = t[2]; vcur[6] = t[1]; vcur[7] = t[0]; }
            bf16x8 qb[2][4];
#pragma unroll
            for (int tb = 0; tb < 2; ++tb)
#pragma unroll
                for (int c = 0; c < 4; ++c) qb[tb][c] = *(const LAS bf16x8*)(B + SC_QT + ((16 * tb + fr) * 136 + 32 * c + 8 * fq) * 2);
            f32x4 att[2][2];
#pragma unroll
            for (int sb = 0; sb < 2; ++sb) {
                att[sb][0] = (f32x4){0.f, 0.f, 0.f, 0.f}; att[sb][1] = (f32x4){0.f, 0.f, 0.f, 0.f};
                const int srow = 8 * (fr >> 2) + 4 * sb + (fr & 3);
#pragma unroll
                for (int c = 0; c < 4; ++c) {
                    const bf16x8 ka = *(const LAS bf16x8*)(B + SC_KT + (srow * 136 + 32 * c + 8 * fq) * 2);
                    att[sb][0] = __builtin_amdgcn_mfma_f32_16x16x32_bf16(ka, qb[0][c], att[sb][0], 0, 0, 0);
                    att[sb][1] = __builtin_amdgcn_mfma_f32_16x16x32_bf16(ka, qb[1][c], att[sb][1], 0, 0, 0);
                }
            }
            f32x4 OT[2];
#pragma unroll
            for (int tb = 0; tb < 2; ++tb) {
                const int t = 16 * tb + fr;
#pragma unroll
                for (int sb = 0; sb < 2; ++sb)
#pragma unroll
                    for (int i = 0; i < 4; ++i) { const int sa = 8 * fq + 4 * sb + i; att[sb][tb][i] = (sa <= t) ? att[sb][tb][i] : 0.f; }
                union { u32x4 u; bf16x8 v; } P; P.u.x = pk2(att[0][tb][0], att[0][tb][1]); P.u.y = pk2(att[0][tb][2], att[0][tb][3]); P.u.z = pk2(att[1][tb][0], att[1][tb][1]); P.u.w = pk2(att[1][tb][2], att[1][tb][3]);
                OT[tb] = __builtin_amdgcn_mfma_f32_16x16x32_bf16(vcur, P.v, (f32x4){0.f, 0.f, 0.f, 0.f}, 0, 0, 0);
            }
#pragma unroll
            for (int c = 0; c < 4; ++c) {
                union { u32x4 u; bf16x8 v; } SF; SF.u.x = pk2(S[2 * c][0], S[2 * c][1]); SF.u.y = pk2(S[2 * c][2], S[2 * c][3]); SF.u.z = pk2(S[2 * c + 1][0], S[2 * c + 1][1]); SF.u.w = pk2(S[2 * c + 1][2], S[2 * c + 1][3]);
                OT[0] = __builtin_amdgcn_mfma_f32_16x16x32_bf16(SF.v, qb[0][c], OT[0], 0, 0, 0);
                OT[1] = __builtin_amdgcn_mfma_f32_16x16x32_bf16(SF.v, qb[1][c], OT[1], 0, 0, 0);
            }
#pragma unroll
            for (int kb = 0; kb < 8; ++kb) {
                const int krow = 32 * (kb >> 1) + 8 * (fr >> 2) + 4 * (kb & 1) + (fr & 3);
                const bf16x8 ka = *(const LAS bf16x8*)(B + SC_KH + krow * 80 + fq * 16);
                const f32x4 dc = *(const LAS f32x4*)(B + SC_DEC + (32 * (kb >> 1) + 8 * fq + 4 * (kb & 1)) * 4);
                S[kb] = __builtin_amdgcn_mfma_f32_16x16x32_bf16(ka, vcur, S[kb] * dc, 0, 0, 0);
            }
#pragma unroll
            for (int tb = 0; tb < 2; ++tb) {
                const int tau = 16 * tb + fr; const int tok = dir ? t0 + 31 - tau : t0 + tau;
                u32x2 w; w.x = pk2(OT[tb][0], OT[tb][1]); w.y = pk2(OT[tb][2], OT[tb][3]);
                *(u32x2*)(O + (size_t)tok * DI + h * 128 + 16 * wave + 4 * fq) = w;
            }
            vf = vf_next;
            SCAN_BAR();
        }
#undef SCAN_RAW
#undef SCAN_PREP
    }
}

#define XB_TMO      128
#define XB_XCNT(j)  (256  + 64 * (j))
#define XB_XSUB(j)  (1280 + 64 * (j))
#define XB_XGEN(j)  (2304 + 64 * (j))
#define XB_TOP      3328
#define XB_TOPGEN   3392
#define XCD_BAR_WORDS 3456
#define XB_SPIN_CAP (1u << 18)

__device__ __forceinline__ unsigned xb_ld(unsigned* p)              { return __hip_atomic_load(p, __ATOMIC_RELAXED, __HIP_MEMORY_SCOPE_AGENT); }
__device__ __forceinline__ unsigned xb_add(unsigned* p, unsigned v) { return __hip_atomic_fetch_add(p, v, __ATOMIC_RELAXED, __HIP_MEMORY_SCOPE_AGENT); }
__device__ __forceinline__ unsigned xb_xcc_id() { return (unsigned)__builtin_amdgcn_s_getreg((3 << 11) | 20) & 0xFu; }
#define XB_SPIN(cond, bar) do { unsigned _sp = 0; while (cond) { __builtin_amdgcn_s_sleep(1); \
    if ((++_sp & 255u) == 0u) { if (xb_ld(&(bar)[XB_TMO])) break; if (_sp > XB_SPIN_CAP) { atomicAdd(&(bar)[XB_TMO], 1u); break; } } } } while (0)

struct XcdBarrier {
    unsigned* bar; unsigned x;
    volatile LAS unsigned* st;
};

__device__ __forceinline__ XcdBarrier xcd_barrier_post(unsigned* bar, volatile LAS unsigned* st) {
    XcdBarrier b; b.bar = bar; b.x = xb_xcc_id(); b.st = st;
    if (threadIdx.x == 0) (void)xb_add(&bar[XB_XCNT(b.x)], 1u);
    return b;
}
__device__ __forceinline__ void xcd_barrier_complete(unsigned* bar, unsigned x, unsigned& nloc, unsigned& nx) {
    const unsigned G = gridDim.x * gridDim.y * gridDim.z;
    unsigned sum, cnt, mine, sp = 0u;
    for (;;) {
        sum = 0u; cnt = 0u; mine = 0u;
#pragma unroll
        for (unsigned j = 0; j < 16; ++j) { const unsigned c = xb_ld(&bar[XB_XCNT(j)]); sum += c; cnt += (c > 0u) ? 1u : 0u; mine = (j == x) ? c : mine; }
        if (sum == G) break;
        __builtin_amdgcn_s_sleep(1);
        if ((++sp & 255u) == 0u) { if (xb_ld(&bar[XB_TMO])) break; if (sp > XB_SPIN_CAP) { atomicAdd(&bar[XB_TMO], 1u); break; } }
    }
    nloc = mine > 0u ? mine : 1u; nx = cnt > 0u ? cnt : 1u;
}

__device__ __forceinline__ void xcd_barrier(const XcdBarrier& b) {
    asm volatile("s_waitcnt vmcnt(0)" ::: "memory");
    __syncthreads();
    if (threadIdx.x == 0) {
        unsigned* bar = b.bar;
        __builtin_amdgcn_s_waitcnt(0);
        unsigned nloc = b.st[0], nx = b.st[1];
        if (nloc == 0u) { xcd_barrier_complete(bar, b.x, nloc, nx); b.st[0] = nloc; b.st[1] = nx; }
        const unsigned old = xb_add(&bar[XB_XSUB(b.x)], 1u);
        const unsigned gen = old / nloc;
        if (old + 1u == (gen + 1u) * nloc) {
            __builtin_amdgcn_fence(__ATOMIC_RELEASE, "agent");
            asm volatile("s_waitcnt vmcnt(0)" ::: "memory");
            const unsigned og = xb_add(&bar[XB_TOP], 1u);
            const unsigned tg = og / nx;
            if (og + 1u == (tg + 1u) * nx) xb_add(&bar[XB_TOPGEN], 1u);
            else XB_SPIN(xb_ld(&bar[XB_TOPGEN]) == tg, bar);
            __builtin_amdgcn_fence(__ATOMIC_ACQUIRE, "agent");
            xb_add(&bar[XB_XGEN(b.x)], 1u);
            asm volatile("s_waitcnt vmcnt(0)" ::: "memory");
        } else {
            XB_SPIN(xb_ld(&bar[XB_XGEN(b.x)]) == gen, bar);
            __builtin_amdgcn_fence(__ATOMIC_ACQUIRE, "agent");
            asm volatile("s_waitcnt vmcnt(0)" ::: "memory");
        }
    }
    __syncthreads();
}


enum { OP_INIT = 0, OP_ROW = 1, OP_G1 = 2, OP_ATT = 3, OP_POOL = 4, OP_GG = 5, OP_SCAN = 6, OP_GATE = 7, OP_G2 = 8, OP_FINAL = 9 };
constexpr int NPHASE = 20;
constexpr int JOB_OFF = LDS_BYTES - 4096;
constexpr int BAR_ST_OFF = LDS_BYTES - 16;

__global__ void __launch_bounds__(NTHR, 2) fwd_mega(Args a0) {
    extern __shared__ __attribute__((aligned(16))) unsigned char lds_raw[];
    LAS unsigned char* lds = (LAS unsigned char*)lds_raw;
    cg::grid_group grid = cg::this_grid();
    const int G = gridDim.x, bid = blockIdx.x;
    if (a0.ws == nullptr) grid.sync();
    if (threadIdx.x == 0) {
        unsigned char* ws = a0.ws;
        bf16_t* H = (bf16_t*)(ws + WS_H); bf16_t* WIN = (bf16_t*)(ws + WS_WIN); bf16_t* WOUT = (bf16_t*)(ws + WS_WOUT); bf16_t* WG = (bf16_t*)(ws + WS_WG);
        const float* LB = (const float*)(ws + WS_LB);
        const int BIG = 1 << 30;
#define SLW(i) (ws + WS_S0 + (size_t)(i) * SLOT)
#define JW(gi, J0, J1, K, n0, n1) do { LAS unsigned char* p_ = lds + JOB_OFF + (gi) * 256; pg8::job_write(p_, J0); pg8::job_write(p_ + 128, J1); *(LAS int*)(p_ + 96) = (K); *(LAS int*)(p_ + 100) = (n0); *(LAS int*)(p_ + 104) = (n1); } while (0)
        const pg8::Job na0{H, WIN, 36, 48, BIG, 0, 4096, 0x271, SLW(0), SLW(1), SLW(2), nullptr, DI, nullptr, nullptr};
        const pg8::Job na1{WIN + (size_t)12288 * DM, H, 16, 36, BIG, 0, BIG, 0x8, SLW(3), nullptr, nullptr, nullptr, MTOT, nullptr, nullptr};
        const pg8::Job g2a{(const bf16_t*)SLW(4), WOUT, 36, 8, BIG, 0, BIG, 0x0, SLW(5), nullptr, nullptr, nullptr, DM, nullptr, nullptr};
        const pg8::Job g2c{(const bf16_t*)SLW(0), WOUT, 36, 8, BIG, 0, BIG, 0x0, SLW(5), nullptr, nullptr, nullptr, DM, nullptr, nullptr};
        const pg8::Job g2l{(const bf16_t*)SLW(4), WOUT, 32, 8, BIG, 0, BIG, 0x0, SLW(5), nullptr, nullptr, nullptr, DM, nullptr, nullptr};
        const pg8::Job p0{H, WIN, 36, 32, BIG, 0, 4096, 0x20, SLW(0), SLW(2), nullptr, nullptr, DI, nullptr, nullptr};
        const pg8::Job pg{(const bf16_t*)SLW(1), WG, 36, 16, 4, (size_t)MTOT * 1024, BIG, 0x6, SLW(4), nullptr, nullptr, nullptr, DI, a0.in[13], (const bf16_t*)SLW(2)};
        const pg8::Job h0{H, WIN, 36, 64, BIG, 0, 4096, 0x2432, SLW(0), SLW(5), SLW(7), SLW(2), DI, LB, nullptr};
        const pg8::Job h1{WIN + (size_t)16384 * DM, H, 16, 36, BIG, 0, BIG, 0x0, SLW(3), nullptr, nullptr, nullptr, MTOT, nullptr, nullptr};
        JW(0, na0, na1, DM, 36 * 48, 16 * 36); JW(1, g2a, g2a, DI, 36 * 8, 0);
        JW(2, p0, p0, DM, 36 * 32, 0); JW(3, pg, pg, 1024, 36 * 16, 0); JW(4, g2a, g2a, DI, 36 * 8, 0);
        JW(5, h0, h1, DM, 36 * 64, 16 * 36); JW(6, g2c, g2c, DI, 36 * 8, 0);
        JW(7, na0, na1, DM, 36 * 48, 16 * 36); JW(8, g2l, g2l, DI, 32 * 8, 0);
#undef JW
#undef SLW
    }
    {
        volatile LAS unsigned* st0 = (volatile LAS unsigned*)(lds + BAR_ST_OFF);
        if (threadIdx.x < 2) st0[threadIdx.x] = 0u;
        __syncthreads();
    }
    const XcdBarrier xbar = xcd_barrier_post((unsigned*)a0.ws, (volatile LAS unsigned*)(lds + BAR_ST_OFF));
#define SL(i) (ws + WS_S0 + (size_t)(i) * SLOT)
    const int BIG = 1 << 30;

    for (int ph = 0; ph < NPHASE; ++ph) {
        int li, op;
        if (ph == 0) { li = 0; op = OP_INIT; }
        else if (ph < 5) { li = 0; const int k = ph - 1; op = k == 0 ? OP_ROW : (k == 1 ? OP_G1 : (k == 2 ? OP_ATT : OP_G2)); }
        else if (ph < 10) { li = 1; const int k = ph - 5; op = k == 0 ? OP_ROW : (k == 1 ? OP_G1 : (k == 2 ? OP_POOL : (k == 3 ? OP_GG : OP_G2))); }
        else if (ph < 15) { li = 2; const int k = ph - 10; op = k == 0 ? OP_ROW : (k == 1 ? OP_G1 : (k == 2 ? OP_SCAN : (k == 3 ? OP_GATE : OP_G2))); }
        else if (ph < 19) { li = 3; const int k = ph - 15; op = k == 0 ? OP_ROW : (k == 1 ? OP_G1 : (k == 2 ? OP_ATT : OP_G2)); }
        else { li = 4; op = OP_FINAL; }
        const int kind = li % 3; const bool need_ctx = li < 3;
#if DBG_NL < 4
        if (li > DBG_NL || (li == DBG_NL && op != OP_ROW)) continue;
#endif
        int zero_ = 0; LAUNDER_S(zero_);
        Args a = a0;
#pragma unroll
        for (int i = 0; i < 19; ++i) a.in[i] = a0.in[i] + zero_;
        a.out = a0.out + zero_; a.ws = a0.ws + zero_;
        unsigned char* ws = a.ws;
        int tid_ = threadIdx.x; asm volatile("" : "+v"(tid_));
        const int tid = tid_, wave = __builtin_amdgcn_readfirstlane(tid >> 6), lane = tid & 63;
        const int gw = bid * NWAVES + wave, NGW = G * NWAVES;
        int gK = 0, gn0 = 0, gn1 = 0; const LAS unsigned char* jt = lds + JOB_OFF;
        if (op == OP_INIT) {
#ifdef ZERO_WS
            {
                u32x4* p = (u32x4*)(ws + WS_MOD); const size_t n16 = (WS_END - WS_MOD) / 16;
                for (size_t i = (size_t)bid * NTHR + tid; i < n16; i += (size_t)G * NTHR) p[i] = (u32x4){0u, 0u, 0u, 0u};
            }
#endif
#ifndef NO_MISC
            init_phase(a, lds, G);
            __syncthreads();
            transpose_layer(a, 0, lds, gw, NGW, wave, lane);
#ifdef PROBE_TR
            transpose_layer(a, 0, lds, gw, NGW, wave, lane);
#endif
#endif
        } else if (op == OP_ROW || op == OP_FINAL) {
#ifndef NO_MISC
            row_phase(a, li, lds, G, tid, wave, lane);
            __syncthreads();
            if (li > 0 && li < 4) transpose_layer(a, li, lds, gw, NGW, wave, lane);
#ifdef PROBE_TR
            if (li > 0 && li < 4) transpose_layer(a, li, lds, gw, NGW, wave, lane);
#endif
#endif
        } else if (op == OP_ATT) {
#ifndef NO_ATTN
            attn_phase(a, li, lds, G, need_ctx ? 1 : 0);
#ifdef PROBE_ATT
            attn_phase(a, li, lds, G, need_ctx ? 1 : 0);
#endif
#endif
        } else if (op == OP_POOL) {
#ifndef NO_MISC
            pool_phase(a, G);
#endif
        } else if (op == OP_SCAN) {
#ifndef NO_SCAN
            scan_phase(a, lds, G);
#ifdef PROBE_SCAN
            scan_phase(a, lds, G);
#endif
#endif
        } else if (op == OP_GATE) {
#ifndef NO_MISC
            hgate_phase(a, G);
#endif
        } else {
            const int gi = li == 0 ? (op == OP_G1 ? 0 : 1) : (li == 1 ? (op == OP_G1 ? 2 : (op == OP_GG ? 3 : 4)) : (li == 2 ? (op == OP_G1 ? 5 : 6) : (op == OP_G1 ? 7 : 8)));
            jt = lds + JOB_OFF + gi * 256;
            gK = pg8::jl_i(jt + 96); gn0 = pg8::jl_i(jt + 100); gn1 = pg8::jl_i(jt + 104);
        }
#ifndef NO_GEMM
        if (gK) pg8::gemm_phase(lds, jt, gK, gn0, gn1, G, bid);
#ifdef PROBE_G2
        if (gK && op == OP_G2) { __syncthreads(); pg8::gemm_phase(lds, jt, gK, gn0, gn1, G, bid); }
#endif
#endif
        if (ph + 1 < NPHASE) xcd_barrier(xbar);
    }
#undef SL
}

extern "C" void kernel_launch(void* const* d_in, const int* in_sizes, int n_in, void* d_out, int out_size, void* d_ws, size_t ws_size, hipStream_t stream) {
    static int grid = 0;
    if (grid == 0) {
        if (n_in != 19 || out_size != MLAT * DM || ws_size < WS_END) { fprintf(stderr, "kernel_launch: unexpected shapes n_in %d out %d ws %zu (need %zu)\n", n_in, out_size, ws_size, (size_t)WS_END); grid = -1; return; }
        int dev = 0, cus = 0, per_cu = 0;
        (void)hipGetDevice(&dev);
        (void)hipDeviceGetAttribute(&cus, hipDeviceAttributeMultiprocessorCount, dev);
        (void)hipFuncSetAttribute((const void*)fwd_mega, hipFuncAttributeMaxDynamicSharedMemorySize, LDS_BYTES);
        (void)hipOccupancyMaxActiveBlocksPerMultiprocessor(&per_cu, (const void*)fwd_mega, NTHR, LDS_BYTES);
        fprintf(stderr, "cus %d per_cu %d ws %zu\n", cus, per_cu, ws_size);
        grid = cus > 0 ? cus : 256;
    }
    if (grid < 0) return;
    (void)hipMemsetAsync(d_ws, 0, 65536, stream);
    Args a{};
    for (int i = 0; i < 19; ++i) a.in[i] = (const float*)d_in[i];
    a.out = (float*)d_out; a.ws = (unsigned char*)d_ws;
    void* args[] = {&a};
    hipError_t e = hipLaunchCooperativeKernel((const void*)fwd_mega, dim3(grid), dim3(NTHR), args, LDS_BYTES, stream);
    if (e != hipSuccess) fprintf(stderr, "cooperative launch failed: %s (grid %d)\n", hipGetErrorString(e), grid);
}
```

```cpp
#ifndef DBG_NL
#define DBG_NL 4
#endif
#include <hip/hip_runtime.h>
#include <hip/hip_cooperative_groups.h>
#include <cstdio>
#include <cstdint>
namespace cg = cooperative_groups;

#define LAS __attribute__((address_space(3)))
#define GAS __attribute__((address_space(1)))
typedef unsigned short bf16_t;
typedef short bf16x8 __attribute__((ext_vector_type(8)));
typedef float f32x4 __attribute__((ext_vector_type(4)));
typedef unsigned u32x4 __attribute__((ext_vector_type(4)));
typedef unsigned u32x2 __attribute__((ext_vector_type(2)));

constexpr int DM = 2048, NB = 4, SEQ = 2048, CTX = 256, DI = 4096;
constexpr int MLAT = NB * SEQ, MCTX = NB * CTX, MTOT = MLAT + MCTX;
constexpr float EPS = 1e-6f;
constexpr int NTHR = 512, NWAVES = 8;
constexpr int LDS_BYTES = 147456;

constexpr size_t MiB = 1u << 20;
constexpr size_t WS_MOD = 1 * MiB;
constexpr size_t WS_LB = WS_MOD + 512 * 1024;
constexpr size_t WS_XC = 2 * MiB;
constexpr size_t WS_H = 10 * MiB;
constexpr size_t WS_WIN = 46 * MiB;
constexpr size_t WS_WOUT = 126 * MiB;
constexpr size_t WS_WG = 142 * MiB;
constexpr size_t WS_S0 = 150 * MiB;
constexpr size_t SLOT = 72 * MiB;
constexpr size_t WS_END = WS_S0 + 9 * SLOT;

typedef __bf16 bf2_t __attribute__((ext_vector_type(2)));
__device__ __forceinline__ unsigned pk2(float lo, float hi) { bf2_t v; v.x = (__bf16)lo; v.y = (__bf16)hi; return __builtin_bit_cast(unsigned, v); }
__device__ __forceinline__ float bflo(unsigned w) { return __uint_as_float(w << 16); }
__device__ __forceinline__ float bfhi(unsigned w) { return __uint_as_float(w & 0xffff0000u); }
__device__ __forceinline__ float fast_exp(float x) { return __expf(x); }
__device__ __forceinline__ float silu_f(float x) { return x * __builtin_amdgcn_rcpf(1.0f + __expf(-x)); }
__device__ __forceinline__ float wave_sum(float v) {
#pragma unroll
    for (int o = 1; o < 64; o <<= 1) v += __shfl_xor(v, o);
    return v;
}
#define LDS_WAIT() asm volatile("s_waitcnt lgkmcnt(0)" ::: "memory")
#define LAUNDER_V(x) asm volatile("" : "+v"(x))
#define LAUNDER_S(x) asm volatile("" : "+s"(x))
__device__ __forceinline__ int my_tid() { int t = threadIdx.x; LAUNDER_V(t); return t; }

namespace pg8 {
constexpr int BM = 256, BK = 64, HALF = 128, HTB = HALF * BK * 2, STAGE_BYTES = 8 * HTB, NXCD = 8, WGM = 8;
__device__ __forceinline__ int lds_byte(int r, int c) { const int st = (r >> 4) * 2 + (c >> 5), rr = r & 15, cc = c & 31, ob = rr * 64 + cc * 2; return st * 1024 + (ob ^ (((ob >> 9) & 1) << 5)); }
__device__ __forceinline__ void stage_rc(int b, int& R, int& C) { const int st = b / 1024, sb = b % 1024, swz = sb ^ (((sb >> 9) & 1) << 5); R = (st >> 1) * 16 + swz / 64; C = (st & 1) * 32 + (swz % 64) / 2; }
__device__ __forceinline__ int perm32(int rho) { const int n = rho >> 4, i = rho & 15; return 8 * (i >> 2) + 4 * n + (i & 3); }

struct Job {
    const bf16_t* A; const bf16_t* Bt; int nM, nN; int agdiv; size_t agstride;
    int segw; int acts; void* o0; void* o1; void* o2; void* o3; int ldo;
    const float* aux_f; const bf16_t* aux_b;
};
__device__ __forceinline__ void job_write(LAS unsigned char* p, const Job& J) {
    *(LAS unsigned long long*)(p + 0) = (unsigned long long)J.A; *(LAS unsigned long long*)(p + 8) = (unsigned long long)J.Bt;
    *(LAS int*)(p + 16) = J.nM; *(LAS int*)(p + 20) = J.nN; *(LAS int*)(p + 24) = J.agdiv; *(LAS int*)(p + 28) = J.ldo;
    *(LAS unsigned long long*)(p + 32) = (unsigned long long)J.agstride; *(LAS int*)(p + 40) = J.segw; *(LAS int*)(p + 44) = J.acts;
    *(LAS unsigned long long*)(p + 48) = (unsigned long long)J.o0; *(LAS unsigned long long*)(p + 56) = (unsigned long long)J.o1;
    *(LAS unsigned long long*)(p + 64) = (unsigned long long)J.o2; *(LAS unsigned long long*)(p + 72) = (unsigned long long)J.o3;
    *(LAS unsigned long long*)(p + 80) = (unsigned long long)J.aux_f; *(LAS unsigned long long*)(p + 88) = (unsigned long long)J.aux_b;
}
__device__ __forceinline__ int jl_i(const LAS unsigned char* p) { return __builtin_amdgcn_readfirstlane(*(const LAS int*)p); }
__device__ __forceinline__ unsigned long long jl_p(const LAS unsigned char* p) {
    const unsigned lo = (unsigned)__builtin_amdgcn_readfirstlane(*(const LAS int*)p), hi = (unsigned)__builtin_amdgcn_readfirstlane(*(const LAS int*)(p + 4));
    return ((unsigned long long)hi << 32) | lo;
}
struct Unit { int job, pm, pn; };

__device__ __forceinline__ void decode_tile(int l, int nM, int nN, int& pm, int& pn) {
    const int nwg = nM * nN; int wgid = l;
    { const int q = nwg / NXCD, r = nwg % NXCD, xcd = wgid % NXCD, off = wgid / NXCD; wgid = (xcd < r ? xcd * (q + 1) : r * (q + 1) + (xcd - r) * q) + off; }
    const int nig = WGM * nN, gid = wgid / nig, fm = gid * WGM, gsz = (nM - fm) < WGM ? (nM - fm) : WGM;
    pm = fm + ((wgid % nig) % gsz); pn = (wgid % nig) / gsz;
}

__device__ __forceinline__ void store_bf8(GAS bf16_t* p, const f32x4& v0, const f32x4& v1) {
    u32x4 w; w.x = pk2(v0[0], v0[1]); w.y = pk2(v0[2], v0[3]); w.z = pk2(v1[0], v1[1]); w.w = pk2(v1[2], v1[3]);
    *(GAS u32x4*)p = w;
}

__device__ __forceinline__ void epilogue(const f32x4 (&acc)[2][2][4][2], const LAS unsigned char* jt, const Unit& u, int wr, int wc, int fr_, int fq_) {
    int fr = fr_, fq = fq_; asm volatile("" : "+v"(fr), "+v"(fq));
    const LAS unsigned char* jp = jt + u.job * 128;
    const int segw = jl_i(jp + 40), acts = jl_i(jp + 44);
    const int colt = u.pn * BM; const int seg = colt / segw; const int act = (acts >> (4 * seg)) & 15;
    GAS unsigned char* op = (GAS unsigned char*)jl_p(jp + 48 + 8 * seg);
    const int col0 = colt - seg * segw + wc * 32 + 8 * fq;
    const int row0 = u.pm * BM + wr * 64 + fr;
    const int ldo = jl_i(jp + 28);
    const GAS float* aux_f = (const GAS float*)jl_p(jp + 80); const GAS bf16_t* aux_b = (const GAS bf16_t*)jl_p(jp + 88);
    if (act <= 2) {
        GAS bf16_t* O = (GAS bf16_t*)op;
#pragma unroll
        for (int ai = 0; ai < 2; ++ai)
#pragma unroll
            for (int m = 0; m < 4; ++m) {
                GAS bf16_t* rowp = O + (size_t)(row0 + ai * HALF + m * 16) * ldo + col0;
#pragma unroll
                for (int bj = 0; bj < 2; ++bj) {
                    f32x4 v0 = acc[ai][bj][m][0], v1 = acc[ai][bj][m][1];
                    if (act == 1) { v0 *= 0.08838834764831845f; v1 *= 0.08838834764831845f; }
                    if (act == 2) {
#pragma unroll
                        for (int j = 0; j < 4; ++j) { v0[j] = silu_f(v0[j]); v1[j] = silu_f(v1[j]); }
                    }
                    store_bf8(rowp + bj * HALF, v0, v1);
                }
            }
    } else if (act == 7) {
        GAS bf16_t* O = (GAS bf16_t*)op;
#pragma unroll
        for (int ai = 0; ai < 2; ++ai)
#pragma unroll
            for (int m = 0; m < 4; ++m) {
                const int token = row0 + ai * HALF + m * 16;
#pragma unroll
                for (int bj = 0; bj < 2; ++bj) {
                    const int col = col0 + bj * HALF, hd = col >> 7, d0 = col & 127;
                    store_bf8(O + ((size_t)(token >> 3) * 32 + hd) * 1024 + (d0 >> 4) * 128 + (token & 7) * 16 + ((d0 >> 3) & 1) * 8, acc[ai][bj][m][0], acc[ai][bj][m][1]);
                }
            }
    } else if (act == 8) {
        GAS bf16_t* O = (GAS bf16_t*)op;
#pragma unroll
        for (int ai = 0; ai < 2; ++ai)
#pragma unroll
            for (int m = 0; m < 4; ++m) {
                const int rr = row0 + ai * HALF + m * 16;
#pragma unroll
                for (int bj = 0; bj < 2; ++bj) {
                    const int t0 = col0 + bj * HALF;
                    store_bf8(O + ((size_t)(t0 >> 3) * 32 + (rr >> 7)) * 1024 + (rr & 127) * 8, acc[ai][bj][m][0], acc[ai][bj][m][1]);
                }
            }
    } else if (act == 3 || act == 4) {
        GAS float* O = (GAS float*)op;
        const GAS float* lbp = aux_f + (act - 3) * 4096 + col0;
#pragma unroll
        for (int bj = 0; bj < 2; ++bj) {
            const f32x4 l0 = *(const GAS f32x4*)(lbp + bj * HALF), l1 = *(const GAS f32x4*)(lbp + bj * HALF + 4);
#pragma unroll
            for (int ai = 0; ai < 2; ++ai)
#pragma unroll
                for (int m = 0; m < 4; ++m) {
                    GAS float* rowp = O + (size_t)(row0 + ai * HALF + m * 16) * ldo + col0 + bj * HALF;
                    f32x4 v0 = acc[ai][bj][m][0], v1 = acc[ai][bj][m][1];
#pragma unroll
                    for (int j = 0; j < 4; ++j) {
                        const float s0 = __builtin_amdgcn_rcpf(1.0f + __expf(-v0[j])), s1 = __builtin_amdgcn_rcpf(1.0f + __expf(-v1[j]));
                        v0[j] = __logf(l0[j] + (1.0f - l0[j]) * s0); v1[j] = __logf(l1[j] + (1.0f - l1[j]) * s1);
                    }
                    *(GAS f32x4*)rowp = v0; *(GAS f32x4*)(rowp + 4) = v1;
                }
        }
    } else if (act == 5) {
        GAS float* O = (GAS float*)op;
#pragma unroll
        for (int ai = 0; ai < 2; ++ai)
#pragma unroll
            for (int m = 0; m < 4; ++m) {
                GAS float* rowp = O + (size_t)(row0 + ai * HALF + m * 16) * ldo + col0;
#pragma unroll
                for (int bj = 0; bj < 2; ++bj) { *(GAS f32x4*)(rowp + bj * HALF) = acc[ai][bj][m][0]; *(GAS f32x4*)(rowp + bj * HALF + 4) = acc[ai][bj][m][1]; }
            }
    } else {
        GAS bf16_t* O = (GAS bf16_t*)op;
#pragma unroll
        for (int bj = 0; bj < 2; ++bj) {
            const f32x4 s0 = *(const GAS f32x4*)(aux_f + col0 + bj * HALF), s1 = *(const GAS f32x4*)(aux_f + col0 + bj * HALF + 4);
#pragma unroll
            for (int ai = 0; ai < 2; ++ai)
#pragma unroll
                for (int m = 0; m < 4; ++m) {
                    const size_t off = (size_t)(row0 + ai * HALF + m * 16) * ldo + col0 + bj * HALF;
                    const u32x4 z = *(const GAS u32x4*)(aux_b + off);
                    f32x4 v0 = acc[ai][bj][m][0] * s0, v1 = acc[ai][bj][m][1] * s1;
                    v0[0] *= bflo(z.x); v0[1] *= bfhi(z.x); v0[2] *= bflo(z.y); v0[3] *= bfhi(z.y);
                    v1[0] *= bflo(z.z); v1[1] *= bfhi(z.z); v1[2] *= bflo(z.w); v1[3] *= bfhi(z.w);
                    store_bf8(O + off, v0, v1);
                }
        }
    }
}

__device__ __forceinline__ bool next_unit(int i, int G, int c, const LAS unsigned char* jt, int n0, int n1, Unit& u) {
    const int L = i * G + c; if (L >= n0 + n1) return false;
    const int job = L < n0 ? 0 : 1; const LAS unsigned char* jp = jt + job * 128;
    u.job = job; decode_tile(job ? L - n0 : L, jl_i(jp + 16), jl_i(jp + 20), u.pm, u.pn);
    return true;
}
__device__ __forceinline__ const char* unit_a(const LAS unsigned char* jt, const Unit& u, size_t tstep) {
    const LAS unsigned char* jp = jt + u.job * 128;
    return (const char*)jl_p(jp + 0) + (size_t)(u.pn / jl_i(jp + 24)) * jl_p(jp + 32) * 2 + (size_t)u.pm * tstep;
}
__device__ __forceinline__ const char* unit_b(const LAS unsigned char* jt, const Unit& u, size_t tstep) {
    const LAS unsigned char* jp = jt + u.job * 128;
    return (const char*)jl_p(jp + 8) + (size_t)u.pn * tstep;
}

__device__ __forceinline__ void gemm_phase(LAS unsigned char* lds, const LAS unsigned char* jt, const int K, const int n0, const int n1, const int G, const int c) {
    int tid_ = threadIdx.x; asm volatile("" : "+v"(tid_));
    const int tid = tid_, wid = __builtin_amdgcn_readfirstlane(tid >> 6), lane = tid & 63, wr = wid >> 2, wc = wid & 3, fr = lane & 15, fq = lane >> 4;
    const int nt = K / BK;
    unsigned voffA[2], voffB[2];
#pragma unroll
    for (int i = 0; i < 2; ++i) { int R, C; stage_rc(tid * 16 + i * 8192, R, C); const int Rb = (R & ~31) + perm32(R & 31);
        voffA[i] = (unsigned)(R * K + C) * 2u; voffB[i] = (unsigned)(Rb * K + C) * 2u; }
    const size_t kstep = (size_t)(BK * 2);
    const size_t hstep = (size_t)HALF * K * 2;
    const size_t tstep = 2 * hstep;
    const unsigned ldsw = (unsigned)wid * 1024u;
    const int aoff = lds_byte(wr * 64 + fr, fq * 8), boff = lds_byte(wc * 32 + fr, fq * 8);
#define PG8_SA(b, h) (((b) * 2 + (h)) * HTB)
#define PG8_SB(b, h) ((4 + (b) * 2 + (h)) * HTB)
#define PG8_STAGE(bufoff, gbase, voff) do { _Pragma("unroll") for (int _i = 0; _i < 2; ++_i) \
        __builtin_amdgcn_global_load_lds((const unsigned*)((const char*)(gbase) + (voff)[_i]), (LAS unsigned*)(lds + (bufoff) + ldsw + _i * 8192), 16, 0, 0); } while (0)
#define PG8_LDA(dst, b, h) do { _Pragma("unroll") for (int m = 0; m < 4; ++m) _Pragma("unroll") for (int k = 0; k < 2; ++k) dst[m][k] = *(const LAS bf16x8*)(lds + PG8_SA(b, h) + aoff + m * 2048 + k * 1024); } while (0)
#define PG8_LDB(dst, b, h) do { _Pragma("unroll") for (int n = 0; n < 2; ++n) _Pragma("unroll") for (int k = 0; k < 2; ++k) dst[n][k] = *(const LAS bf16x8*)(lds + PG8_SB(b, h) + boff + n * 2048 + k * 1024); } while (0)
#define PG8_MMA(ai, bj, At, Bt) do { __builtin_amdgcn_s_setprio(1); _Pragma("unroll") for (int m = 0; m < 4; ++m) _Pragma("unroll") for (int n = 0; n < 2; ++n) _Pragma("unroll") for (int k = 0; k < 2; ++k) \
        acc[ai][bj][m][n] = __builtin_amdgcn_mfma_f32_16x16x32_bf16(Bt[n][k], At[m][k], acc[ai][bj][m][n], 0, 0, 0); __builtin_amdgcn_s_setprio(0); } while (0)
#define PG8_WAIT_V(n) asm volatile("s_waitcnt vmcnt(" #n ")" ::: "memory")
#define PG8_WAIT_L(n) asm volatile("s_waitcnt lgkmcnt(" #n ")" ::: "memory")
#define PG8_BAR __builtin_amdgcn_s_barrier()
#define PG8_SCHED __builtin_amdgcn_sched_barrier(0)
#define PG8_UA(u) unit_a(jt, (u), tstep)
#define PG8_UB(u) unit_b(jt, (u), tstep)
    Unit cur, nxt; int ui = 0;
    if (!next_unit(0, G, c, jt, n0, n1, cur)) return;
    f32x4 acc[2][2][4][2];
#pragma unroll
    for (int a = 0; a < 2; ++a)
#pragma unroll
        for (int b = 0; b < 2; ++b)
#pragma unroll
            for (int m = 0; m < 4; ++m)
#pragma unroll
                for (int n = 0; n < 2; ++n) acc[a][b][m][n] = (f32x4){0.f, 0.f, 0.f, 0.f};
    bf16x8 At[4][2], B0[2][2], B1[2][2];
    const char* cA = PG8_UA(cur); const char* cB = PG8_UB(cur);
    PG8_STAGE(PG8_SB(0, 0), cB, voffB); PG8_STAGE(PG8_SB(0, 1), cB + hstep, voffB); PG8_STAGE(PG8_SA(0, 0), cA, voffA); PG8_STAGE(PG8_SA(0, 1), cA + hstep, voffA);
    if (wr == 1) PG8_BAR;
    PG8_WAIT_V(2); PG8_BAR;
    PG8_STAGE(PG8_SB(1, 0), cB + kstep, voffB); PG8_STAGE(PG8_SA(1, 0), cA + kstep, voffA); PG8_STAGE(PG8_SB(1, 1), cB + hstep + kstep, voffB);
    PG8_WAIT_V(6); PG8_BAR;
    for (;;) {
        const bool has_next = next_unit(ui + 1, G, c, jt, n0, n1, nxt);
        const char* nA = cA; const char* nB = cB;
        if (has_next) { nA = PG8_UA(nxt); nB = PG8_UB(nxt); }
        for (int t = 0; t < nt; t += 2) {
            const bool last = (t == nt - 2);
            const char* a1 = cA + (size_t)(t + 1) * kstep;
            const char* a2 = last ? nA : cA + (size_t)(t + 2) * kstep; const char* b2 = last ? nB : cB + (size_t)(t + 2) * kstep;
            const char* a3 = a2 + kstep; const char* b3 = b2 + kstep;
            PG8_LDB(B0, 0, 0); PG8_LDB(B1, 0, 1); PG8_SCHED; PG8_LDA(At, 0, 0); PG8_STAGE(PG8_SA(1, 1), a1 + hstep, voffA);
            PG8_WAIT_V(8); PG8_WAIT_L(0); PG8_BAR; PG8_MMA(0, 0, At, B0); PG8_MMA(0, 1, At, B1); PG8_BAR; PG8_SCHED;
            PG8_LDA(At, 0, 1); PG8_STAGE(PG8_SB(0, 0), b2, voffB); PG8_STAGE(PG8_SB(0, 1), b2 + hstep, voffB); PG8_STAGE(PG8_SA(0, 0), a2, voffA);
            PG8_WAIT_V(8); PG8_WAIT_L(0); PG8_BAR; PG8_MMA(1, 0, At, B0); PG8_MMA(1, 1, At, B1); PG8_BAR; PG8_SCHED;
            PG8_LDB(B0, 1, 0); PG8_LDB(B1, 1, 1); PG8_SCHED; PG8_LDA(At, 1, 0); PG8_STAGE(PG8_SA(0, 1), a2 + hstep, voffA);
            PG8_WAIT_V(8); PG8_WAIT_L(0); PG8_BAR; PG8_MMA(0, 0, At, B0); PG8_MMA(0, 1, At, B1); PG8_BAR; PG8_SCHED;
            PG8_LDA(At, 1, 1); PG8_STAGE(PG8_SB(1, 0), b3, voffB); PG8_STAGE(PG8_SB(1, 1), b3 + hstep, voffB); PG8_STAGE(PG8_SA(1, 0), a3, voffA);
            PG8_WAIT_V(8); PG8_WAIT_L(0); PG8_BAR; PG8_MMA(1, 0, At, B0); PG8_MMA(1, 1, At, B1); PG8_BAR; PG8_SCHED;
        }
        if (wr == 0) PG8_BAR;
        epilogue(acc, jt, cur, wr, wc, fr, fq);
        if (!has_next) break;
#pragma unroll
        for (int a = 0; a < 2; ++a)
#pragma unroll
            for (int b = 0; b < 2; ++b)
#pragma unroll
                for (int m = 0; m < 4; ++m)
#pragma unroll
                    for (int n = 0; n < 2; ++n) acc[a][b][m][n] = (f32x4){0.f, 0.f, 0.f, 0.f};
        cur = nxt; cA = nA; cB = nB; ++ui;
        if (wr == 1) PG8_BAR;
    }
    PG8_WAIT_V(0);
    PG8_BAR;
#undef PG8_SA
#undef PG8_SB
#undef PG8_STAGE
#undef PG8_LDA
#undef PG8_LDB
#undef PG8_MMA
#undef PG8_WAIT_V
#undef PG8_WAIT_L
#undef PG8_BAR
#undef PG8_SCHED
#undef PG8_UA
#undef PG8_UB
}
}

struct Args {
    const float* in[19]; float* out; unsigned char* ws;
};

__device__ __forceinline__ void tr_item(const float* __restrict__ W, int K, int N, bf16_t* WT, int segperm, LAS float* scr, int item, int lane) {
    const int nblk = N >> 6, kb = item / nblk, nb = item - kb * nblk, k0 = kb << 6, n0 = nb << 6;
    const float* src = W + (size_t)k0 * N + n0 + lane;
    float tv[64];
#pragma unroll
    for (int i = 0; i < 64; ++i) tv[i] = src[(size_t)i * N];
#pragma unroll
    for (int i = 0; i < 64; ++i) scr[i * 65 + lane] = tv[i];
    LDS_WAIT();
    const int seg = n0 >> 12, dseg = (segperm >> (4 * seg)) & 15, drow0 = n0 + (dseg - seg) * 4096;
    const int c = lane & 7;
#pragma unroll
    for (int j = 0; j < 8; ++j) {
        const int n = (lane >> 3) + 8 * j; const LAS float* s = scr + (8 * c) * 65 + n;
        u32x4 o; o.x = pk2(s[0], s[65]); o.y = pk2(s[130], s[195]); o.z = pk2(s[260], s[325]); o.w = pk2(s[390], s[455]);
        *(u32x4*)(WT + (size_t)(drow0 + n) * K + k0 + 8 * c) = o;
    }
    LDS_WAIT();
}

__device__ __forceinline__ void transpose_layer(const Args& a, int layer, LAS unsigned char* lds, int gw, int NGW, int wave, int lane) {
    LAS float* scr = (LAS float*)(lds + wave * 16640);
    bf16_t* WIN = (bf16_t*)(a.ws + WS_WIN); bf16_t* WOUT = (bf16_t*)(a.ws + WS_WOUT); bf16_t* WG = (bf16_t*)(a.ws + WS_WG);
    const int kind = layer % 3, j = layer / 3;
    if (kind == 0) {
        const float* win = a.in[8] + (size_t)j * DM * 16384; const float* wout = a.in[10] + (size_t)j * DI * DM;
        const int n_in = (DM / 64) * (16384 / 64), n_out = (DI / 64) * (DM / 64);
        for (int it = gw; it < n_in + n_out; it += NGW) {
            if (it < n_in) tr_item(win, DM, 16384, WIN, 0x2310, scr, it, lane);
            else tr_item(wout, DI, DM, WOUT, 0x43210, scr, it - n_in, lane);
        }
    } else if (kind == 1) {
        const float* win = a.in[11]; const float* wg = a.in[12]; const float* wout = a.in[14];
        const int n_in = (DM / 64) * (8192 / 64), n_g = 16 * 16, n_out = (DI / 64) * (DM / 64);
        for (int it = gw; it < n_in + 4 * n_g + n_out; it += NGW) {
            if (it < n_in) tr_item(win, DM, 8192, WIN, 0x43210, scr, it, lane);
            else if (it < n_in + 4 * n_g) { const int g = (it - n_in) / n_g, r = (it - n_in) % n_g; tr_item(wg + (size_t)g * 1024 * 1024, 1024, 1024, WG + (size_t)g * 1024 * 1024, 0x43210, scr, r, lane); }
            else tr_item(wout, DI, DM, WOUT, 0x43210, scr, it - n_in - 4 * n_g, lane);
        }
    } else {
        const float* win = a.in[15]; const float* wout = a.in[18];
        const int n_in = (DM / 64) * (20480 / 64), n_out = (DI / 64) * (DM / 64);
        for (int it = gw; it < n_in + n_out; it += NGW) {
            if (it < n_in) tr_item(win, DM, 20480, WIN, 0x34210, scr, it, lane);
            else tr_item(wout, DI, DM, WOUT, 0x43210, scr, it - n_in, lane);
        }
    }
}

__device__ __forceinline__ void row_phase(const Args& a, int li, LAS unsigned char* lds, int G, int tid, int wave, int lane) {
    LAS f32x4* V = (LAS f32x4*)lds;
    const float* MOD = (const float*)(a.ws + WS_MOD);
    float* XC = (float*)(a.ws + WS_XC); bf16_t* H = (bf16_t*)(a.ws + WS_H);
    const bf16_t* Y = (const bf16_t*)(a.ws + WS_S0 + 5 * SLOT);
    for (int rb = blockIdx.x; rb < 256; rb += G) {
        const int mrl = rb >> 6;
        __syncthreads();
        {
            const int c4 = 4 * tid;
            if (li > 0) {
                const f32x4 gp = *(const f32x4*)(a.in[7] + (size_t)(li - 1) * DM + c4);
                const f32x4 gl = *(const f32x4*)(MOD + (size_t)((li - 1) * 5 + mrl) * 6144 + 4096 + c4), gc = *(const f32x4*)(MOD + (size_t)((li - 1) * 5 + 4) * 6144 + 4096 + c4);
                V[0 * 512 + tid] = gl * gp; V[1 * 512 + tid] = gc * gp;
            }
            if (li < 4) {
                const f32x4 gpre = *(const f32x4*)(a.in[6] + (size_t)li * DM + c4);
                const float* ml = MOD + (size_t)(li * 5 + mrl) * 6144 + c4; const float* mc = MOD + (size_t)(li * 5 + 4) * 6144 + c4;
                V[2 * 512 + tid] = gpre * (1.0f + *(const f32x4*)(ml + 2048)); V[3 * 512 + tid] = gpre * (1.0f + *(const f32x4*)(mc + 2048));
                V[4 * 512 + tid] = *(const f32x4*)ml; V[5 * 512 + tid] = *(const f32x4*)mc;
            }
        }
        __syncthreads();
        const int nr = (li == 4) ? 4 : (wave < 4 ? 5 : 4);
        for (int k = 0; k < nr; ++k) {
            const bool lat = k < 4;
            const int row = lat ? rb * 32 + wave * 4 + k : MLAT + rb * 4 + wave;
            const LAS f32x4* Vr = V + (lat ? 0 : 512) + lane;
            float* xrow = lat ? a.out + (size_t)row * DM : XC + (size_t)(row - MLAT) * DM;
            f32x4 xv[8];
            if (li == 0) {
                const float* src = lat ? a.in[0] + (size_t)row * DM : a.in[2] + (size_t)(row - MLAT) * DM;
#pragma unroll
                for (int j = 0; j < 8; ++j) xv[j] = *(const f32x4*)(src + 4 * lane + 256 * j);
#pragma unroll
                for (int j = 0; j < 8; ++j) *(f32x4*)(xrow + 4 * lane + 256 * j) = xv[j];
            } else {
                const bf16_t* yrow = Y + (size_t)row * DM;
                u32x2 yw[8];
#pragma unroll
                for (int j = 0; j < 8; ++j) xv[j] = *(const f32x4*)(xrow + 4 * lane + 256 * j);
#pragma unroll
                for (int j = 0; j < 8; ++j) yw[j] = *(const u32x2*)(yrow + 4 * lane + 256 * j);
                f32x4 yv[8]; float ss = 0.f;
#pragma unroll
                for (int j = 0; j < 8; ++j) { yv[j] = (f32x4){bflo(yw[j].x), bfhi(yw[j].x), bflo(yw[j].y), bfhi(yw[j].y)}; ss += (yv[j].x * yv[j].x + yv[j].y * yv[j].y) + (yv[j].z * yv[j].z + yv[j].w * yv[j].w); }
                const float rstd = rsqrtf(wave_sum(ss) * (1.0f / DM) + EPS);
#pragma unroll
                for (int j = 0; j < 8; ++j) {
                    xv[j] += Vr[0 * 512 + 64 * j] * (yv[j] * rstd);
                    *(f32x4*)(xrow + 4 * lane + 256 * j) = xv[j];
                }
            }
            if (li < 4) {
                float ss = 0.f;
#pragma unroll
                for (int j = 0; j < 8; ++j) ss += (xv[j].x * xv[j].x + xv[j].y * xv[j].y) + (xv[j].z * xv[j].z + xv[j].w * xv[j].w);
                const float rstd = rsqrtf(wave_sum(ss) * (1.0f / DM) + EPS);
                bf16_t* hrow = H + (size_t)row * DM;
#pragma unroll
                for (int j = 0; j < 8; ++j) {
                    const f32x4 hv = (xv[j] * rstd) * Vr[2 * 512 + 64 * j] + Vr[4 * 512 + 64 * j];
                    u32x2 w; w.x = pk2(hv.x, hv.y); w.y = pk2(hv.z, hv.w);
                    *(u32x2*)(hrow + 4 * lane + 256 * j) = w;
                }
            }
        }
    }
}

__device__ __forceinline__ void init_phase(const Args& a, LAS unsigned char* lds, int G) {
    LAS float* sc = (LAS float*)lds;
    LAS float* red = sc + 5 * 2048;
    const int tid = my_tid();
    float* MOD = (float*)(a.ws + WS_MOD); float* LB = (float*)(a.ws + WS_LB);
    for (int e = tid; e < 5 * 2048; e += NTHR) { const int r = e >> 11, k = e & 2047; const float v = r < 4 ? a.in[1][r * 2048 + k] : a.in[3][k]; sc[e] = silu_f(v); }
    __syncthreads();
    for (int item = blockIdx.x; item < 384; item += G) {
        const int layer = item / 96, n0 = (item % 96) * 64, ks = tid >> 6, nn = tid & 63;
        float acc0 = 0.f, acc1 = 0.f, acc2 = 0.f, acc3 = 0.f, acc4 = 0.f;
        const float* wp = a.in[4] + ((size_t)layer * 2048 + ks * 256) * 6144 + n0 + nn;
        const LAS float* sp = sc + ks * 256;
#pragma unroll 32
        for (int kk = 0; kk < 256; ++kk) {
            const float w = wp[(size_t)kk * 6144];
            acc0 += sp[kk] * w; acc1 += sp[2048 + kk] * w; acc2 += sp[4096 + kk] * w; acc3 += sp[6144 + kk] * w; acc4 += sp[8192 + kk] * w;
        }
        red[(ks * 5 + 0) * 64 + nn] = acc0; red[(ks * 5 + 1) * 64 + nn] = acc1; red[(ks * 5 + 2) * 64 + nn] = acc2; red[(ks * 5 + 3) * 64 + nn] = acc3; red[(ks * 5 + 4) * 64 + nn] = acc4;
        __syncthreads();
        if (tid < 320) {
            const int r = tid >> 6, n2 = tid & 63; float s = 0.f;
#pragma unroll
            for (int k8 = 0; k8 < 8; ++k8) s += red[(k8 * 5 + r) * 64 + n2];
            MOD[(size_t)(layer * 5 + r) * 6144 + n0 + n2] = s + a.in[5][layer * 6144 + n0 + n2];
        }
        __syncthreads();
    }
    const int gt = blockIdx.x * NTHR + tid;
    if (gt < 2 * 4096) {
        const int d = gt >> 12, f = gt & 4095; const float* p = a.in[16] + (size_t)d * 4 * 4096 + f;
        const float l0 = p[0], l1 = p[4096], l2 = p[8192], l3 = p[12288];
        const float mx = fmaxf(fmaxf(l0, l1), fmaxf(l2, l3));
        const float e0 = expf(l0 - mx), e1 = expf(l1 - mx), e2 = expf(l2 - mx), e3 = expf(l3 - mx);
        LB[gt] = (e1 + e2) / (e0 + e1 + e2 + e3);
    }
}

typedef float f32x16 __attribute__((ext_vector_type(16)));
__device__ __forceinline__ void attn_phase(const Args& a, int layer, LAS unsigned char* lds, int G, int need_ctx) {
    const int tid = my_tid(), wave = __builtin_amdgcn_readfirstlane(tid >> 6), lane = tid & 63, q = lane & 31, hh = lane >> 5;
    const bf16_t* Q = (const bf16_t*)(a.ws + WS_S0); const bf16_t* Kp = (const bf16_t*)(a.ws + WS_S0 + SLOT);
    const bf16_t* SZ = (const bf16_t*)(a.ws + WS_S0 + 2 * SLOT); const bf16_t* Vt = (const bf16_t*)(a.ws + WS_S0 + 3 * SLOT);
    bf16_t* GT = (bf16_t*)(a.ws + WS_S0 + 4 * SLOT);
    const float* rpb = a.in[9] + (size_t)(layer / 3) * 32 * 465;
    LAS float* rp = (LAS float*)(lds + wave * 2048);
    const int gw = blockIdx.x * NWAVES + wave, NGW = G * NWAVES;
    const int nlat = 8192, ntask = nlat + (need_ctx ? 1024 : 0);
    const int sig = (q & 19) | ((q & 8) >> 1) | ((q & 4) << 1);
    for (int task = gw; task < ntask; task += NGW) {
        const bool lat = task < nlat;
        int b, h, r = 0, j = 0, qtok;
        if (lat) { j = task & 3; r = 2 * ((task >> 2) & 15); h = (task >> 6) & 31; b = task >> 11; qtok = b * SEQ + (r + (q >> 4)) * 64 + 16 * j + (q & 15); }
        else { const int t2 = task - nlat; h = (t2 >> 3) & 31; b = t2 >> 8; qtok = MLAT + b * CTX + 32 * (t2 & 7) + q; }
        bf16x8 qf[8];
#pragma unroll
        for (int c = 0; c < 8; ++c) qf[c] = *(const bf16x8*)(Q + (size_t)qtok * DI + h * 128 + 16 * c + 8 * hh);
        if (lat) {
            LDS_WAIT();
            for (int e = lane; e < 465; e += 64) rp[e] = rpb[h * 465 + e];
            LDS_WAIT();
        }
        const int r0a = min(max(r - 4, 0), 24), r0b = min(max(r - 3, 0), 24), nband = lat ? (r0b + 8 - r0a) : 0;
        const int qr = r + (q >> 4), myr0 = (q >> 4) ? r0b : r0a;
        const int cw = min(max(16 * j - 8, 0), 32), qcol = 16 * j + (q & 15), c0 = min(max(qcol - 8, 0), 48);
        const int nst = nband + 8;
        const int kb_lat = b * SEQ + r0a * 64 + cw, kb_ctx = MLAT + b * CTX;
        const bf16_t* kbase = Kp + (size_t)h * 1024 + (size_t)(sig >> 3) * 32768 + (sig & 7) * 16 + 8 * hh;
        const bf16_t* vbase = Vt + (size_t)h * 1024 + (size_t)hh * 32768 + q * 8;
        float m_run = -1e30f, l_run = 0.f;
        f32x16 OT[4];
#pragma unroll
        for (int d = 0; d < 4; ++d)
#pragma unroll
            for (int t = 0; t < 16; ++t) OT[d][t] = 0.f;
        bf16x8 kreg[8], vreg[8];
        { const int kb0 = nband ? kb_lat : kb_ctx;
#pragma unroll
          for (int c = 0; c < 8; ++c) kreg[c] = *(const bf16x8*)(kbase + (size_t)(kb0 >> 3) * 32768 + 128 * c); }
        for (int st = 0; st < nst; ++st) {
            const bool isl = st < nband;
            const int keybase = isl ? kb_lat + st * 64 : kb_ctx + 32 * (st - nband);
#pragma unroll
            for (int d = 0; d < 4; ++d)
#pragma unroll
                for (int s2 = 0; s2 < 2; ++s2) vreg[d * 2 + s2] = *(const bf16x8*)(vbase + (size_t)(keybase >> 3) * 32768 + s2 * 65536 + d * 256);
            f32x16 sc;
#pragma unroll
            for (int t = 0; t < 16; ++t) sc[t] = 0.f;
#pragma unroll
            for (int c = 0; c < 8; ++c) sc = __builtin_amdgcn_mfma_f32_32x32x16_bf16(kreg[c], qf[c], sc, 0, 0, 0);
            if (st + 1 < nst) {
                const int kn = (st + 1 < nband) ? kb_lat + (st + 1) * 64 : kb_ctx + 32 * (st + 1 - nband);
#pragma unroll
                for (int c = 0; c < 8; ++c) kreg[c] = *(const bf16x8*)(kbase + (size_t)(kn >> 3) * 32768 + 128 * c);
            }
            if (isl) {
                const int kr = r0a + st; const bool rowok = (kr >= myr0) && (kr < myr0 + 8);
                const int brow = (kr - qr + 7) * 31 - qcol + 15;
#pragma unroll
                for (int t = 0; t < 16; ++t) {
                    const int kc = cw + 16 * (t >> 3) + 8 * hh + (t & 7); const bool valid = rowok && (kc >= c0) && (kc < c0 + 16);
                    const float bias = rp[valid ? (brow + kc) : 0];
                    sc[t] = valid ? sc[t] + bias : -3.0e38f;
                }
            }
            float mx = sc[0];
#pragma unroll
            for (int t = 1; t < 16; ++t) mx = fmaxf(mx, sc[t]);
            mx = fmaxf(mx, __shfl_xor(mx, 32));
            const float m_new = fmaxf(m_run, mx), alpha = __expf(m_run - m_new);
            float rs = 0.f;
#pragma unroll
            for (int t = 0; t < 16; ++t) { sc[t] = __expf(sc[t] - m_new); rs += sc[t]; }
            rs += __shfl_xor(rs, 32);
            l_run = l_run * alpha + rs; m_run = m_new;
            union { u32x4 u; bf16x8 v; } P0, P1;
            P0.u.x = pk2(sc[0], sc[1]); P0.u.y = pk2(sc[2], sc[3]); P0.u.z = pk2(sc[4], sc[5]); P0.u.w = pk2(sc[6], sc[7]);
            P1.u.x = pk2(sc[8], sc[9]); P1.u.y = pk2(sc[10], sc[11]); P1.u.z = pk2(sc[12], sc[13]); P1.u.w = pk2(sc[14], sc[15]);
#pragma unroll
            for (int d = 0; d < 4; ++d) {
#pragma unroll
                for (int t = 0; t < 16; ++t) OT[d][t] *= alpha;
                OT[d] = __builtin_amdgcn_mfma_f32_32x32x16_bf16(vreg[d * 2 + 0], P0.v, OT[d], 0, 0, 0);
                OT[d] = __builtin_amdgcn_mfma_f32_32x32x16_bf16(vreg[d * 2 + 1], P1.v, OT[d], 0, 0, 0);
            }
        }
        const float inv = 1.0f / l_run;
        const size_t obase = (size_t)qtok * DI + h * 128 + 4 * hh;
#pragma unroll
        for (int d = 0; d < 4; ++d)
#pragma unroll
            for (int g4 = 0; g4 < 4; ++g4) {
                const size_t o = obase + 32 * d + 8 * g4;
                const u32x2 z = *(const u32x2*)(SZ + o);
                u32x2 w; w.x = pk2(OT[d][4 * g4 + 0] * inv * bflo(z.x), OT[d][4 * g4 + 1] * inv * bfhi(z.x)); w.y = pk2(OT[d][4 * g4 + 2] * inv * bflo(z.y), OT[d][4 * g4 + 3] * inv * bfhi(z.y));
                *(u32x2*)(GT + o) = w;
            }
    }
}

template <int W> __device__ __forceinline__ void pool_item(const bf16_t* __restrict__ U, bf16_t* __restrict__ Pg, int row, int col, int g, int t, int T, int base) {
    constexpr int hw = W / 2;
    u32x4 v[W];
#pragma unroll
    for (int i = 0; i < W; ++i) { const int tt = min(max(t - hw + i, 0), T - 1); v[i] = *(const u32x4*)(U + (size_t)(base + tt) * DI + col); }
    float acc[8];
#pragma unroll
    for (int e = 0; e < 8; ++e) acc[e] = 0.f;
#pragma unroll
    for (int i = 0; i < W; ++i) {
        const int tt = t - hw + i; const float wgt = (tt >= 0 && tt < T) ? 1.0f : 0.0f;
        acc[0] += wgt * bflo(v[i].x); acc[1] += wgt * bfhi(v[i].x); acc[2] += wgt * bflo(v[i].y); acc[3] += wgt * bfhi(v[i].y);
        acc[4] += wgt * bflo(v[i].z); acc[5] += wgt * bfhi(v[i].z); acc[6] += wgt * bflo(v[i].w); acc[7] += wgt * bfhi(v[i].w);
    }
    const int lo = max(t - hw, 0), hi = min(t + hw, T);
    const float ic = 1.0f / (float)(hi - lo);
    const u32x4 c = v[hw];
    u32x4 o; o.x = pk2(acc[0] * ic - bflo(c.x), acc[1] * ic - bfhi(c.x)); o.y = pk2(acc[2] * ic - bflo(c.y), acc[3] * ic - bfhi(c.y));
    o.z = pk2(acc[4] * ic - bflo(c.z), acc[5] * ic - bfhi(c.z)); o.w = pk2(acc[6] * ic - bflo(c.w), acc[7] * ic - bfhi(c.w));
    *(u32x4*)(Pg + ((size_t)g * MTOT + row) * 1024 + (col & 1023)) = o;
}
__device__ __forceinline__ void pool_phase(const Args& a, int G) {
    const bf16_t* U = (const bf16_t*)(a.ws + WS_S0); bf16_t* Pg = (bf16_t*)(a.ws + WS_S0 + SLOT);
    const int gt = blockIdx.x * NTHR + my_tid(), gsz = G * NTHR;
    for (int idx = gt; idx < MTOT * 512; idx += gsz) {
        const int row = idx >> 9, cv = idx & 511, col = cv * 8, g = col >> 10;
        int t, T, base;
        if (row < MLAT) { t = row & 2047; T = SEQ; base = row - t; } else { const int r2 = row - MLAT; t = r2 & 255; T = CTX; base = row - t; }
        if (g == 0) pool_item<2>(U, Pg, row, col, g, t, T, base);
        else if (g == 1) pool_item<4>(U, Pg, row, col, g, t, T, base);
        else if (g == 2) pool_item<8>(U, Pg, row, col, g, t, T, base);
        else pool_item<16>(U, Pg, row, col, g, t, T, base);
    }
}

__device__ __forceinline__ void hgate_phase(const Args& a, int G) {
    const bf16_t* Of = (const bf16_t*)(a.ws + WS_S0 + SLOT); const bf16_t* Ob = (const bf16_t*)(a.ws + WS_S0 + 4 * SLOT);
    const bf16_t* SZ = (const bf16_t*)(a.ws + WS_S0 + 2 * SLOT); bf16_t* GT = (bf16_t*)(a.ws + WS_S0);
    const float* gn = a.in[17];
    const int gt = blockIdx.x * NTHR + my_tid(), gsz = G * NTHR;
    for (int idx = gt; idx < MTOT * 512; idx += gsz) {
        const int row = idx >> 9, col = (idx & 511) * 8; const size_t off = (size_t)row * DI + col;
        const u32x4 f = *(const u32x4*)(Of + off), bk = *(const u32x4*)(Ob + off), z = *(const u32x4*)(SZ + off);
        float o[8];
        o[0] = bflo(f.x) + bflo(bk.x); o[1] = bfhi(f.x) + bfhi(bk.x); o[2] = bflo(f.y) + bflo(bk.y); o[3] = bfhi(f.y) + bfhi(bk.y);
        o[4] = bflo(f.z) + bflo(bk.z); o[5] = bfhi(f.z) + bfhi(bk.z); o[6] = bflo(f.w) + bflo(bk.w); o[7] = bfhi(f.w) + bfhi(bk.w);
        float ss = 0.f;
#pragma unroll
        for (int e = 0; e < 8; ++e) ss += o[e] * o[e];
        ss += __shfl_xor(ss, 1); ss += __shfl_xor(ss, 2); ss += __shfl_xor(ss, 4); ss += __shfl_xor(ss, 8);
        const float rstd = rsqrtf(ss * (1.0f / 128.0f) + EPS);
        const f32x4 g0 = *(const f32x4*)(gn + col), g1 = *(const f32x4*)(gn + col + 4);
        u32x4 w;
        w.x = pk2(o[0] * rstd * g0.x * bflo(z.x), o[1] * rstd * g0.y * bfhi(z.x)); w.y = pk2(o[2] * rstd * g0.z * bflo(z.y), o[3] * rstd * g0.w * bfhi(z.y));
        w.z = pk2(o[4] * rstd * g1.x * bflo(z.z), o[5] * rstd * g1.y * bfhi(z.z)); w.w = pk2(o[6] * rstd * g1.z * bflo(z.w), o[7] * rstd * g1.w * bfhi(z.w));
        *(u32x4*)(GT + off) = w;
    }
}

constexpr int SC_QT = 0, SC_KT = 8704, SC_KH = 17408, SC_DEC = 27648, SC_BUF = 28160, SC_TOT = 2 * SC_BUF;
struct ScanRaw { float lf[8]; unsigned short qs[8]; };

__device__ __forceinline__ void scan_chunk_t0(int cj, int b, int dir, int& t0) {
    const bool isctx = cj < 8;
    const int cc = isctx ? (dir ? 7 - cj : cj) : (dir ? 71 - cj : cj - 8);
    t0 = isctx ? MLAT + b * CTX + 32 * cc : b * SEQ + 32 * cc;
}

#define SCAN_BAR() do { asm volatile("s_waitcnt lgkmcnt(0)" ::: "memory"); __builtin_amdgcn_s_barrier(); asm volatile("" ::: "memory"); } while (0)
__device__ __forceinline__ void scan_phase(const Args& a, LAS unsigned char* lds, int G) {
    const int tid = my_tid(), wave = tid >> 6, lane = tid & 63, fr = lane & 15, fq = lane >> 4;
    const bf16_t* QS = (const bf16_t*)(a.ws + WS_S0); const bf16_t* Vt = (const bf16_t*)(a.ws + WS_S0 + 3 * SLOT);
    const int kch = tid & 127, part = tid >> 7;
    for (int sidx = blockIdx.x; sidx < 256; sidx += G) {
        const int dir = sidx & 1, h = (sidx >> 1) & 31, b = sidx >> 6;
        const float* LF = (const float*)(a.ws + WS_S0 + (dir ? 7 : 5) * SLOT);
        bf16_t* O = (bf16_t*)(a.ws + WS_S0 + (dir ? 4 : 1) * SLOT);
        f32x4 S[8];
#pragma unroll
        for (int k = 0; k < 8; ++k) S[k] = (f32x4){0.f, 0.f, 0.f, 0.f};
        float rlf[8]; unsigned short rqs[8]; bf16x8 vfn;
#define SCAN_RAW(cj) do { int _t0; scan_chunk_t0((cj), b, dir, _t0); \
        _Pragma("unroll") for (int e = 0; e < 8; ++e) { const int tau = 8 * part + e; const int tok = dir ? _t0 + 31 - tau : _t0 + tau; \
            rlf[e] = LF[(size_t)tok * DI + h * 128 + kch]; rqs[e] = QS[(size_t)tok * DI + h * 128 + kch]; } \
        vfn = *(const bf16x8*)(Vt + (size_t)(h * 128 + 16 * wave + fr) * MTOT + (dir ? _t0 + 24 - 8 * fq : _t0 + 8 * fq)); } while (0)
#define SCAN_PREP(bufp) do { LAS unsigned char* _B = (bufp); LAS float* TOT = (LAS float*)(lds + SC_TOT); \
        float cs[8]; float run = 0.f; \
        _Pragma("unroll") for (int e = 0; e < 8; ++e) { run += rlf[e]; cs[e] = run; } \
        TOT[part * 128 + kch] = run; SCAN_BAR(); \
        float off = 0.f, bend = 0.f; \
        _Pragma("unroll") for (int p = 0; p < 4; ++p) { const float tv = TOT[p * 128 + kch]; off += (p < part) ? tv : 0.f; bend += tv; } \
        unsigned kh[8]; \
        _Pragma("unroll") for (int e = 0; e < 8; ++e) { const int tau = 8 * part + e; const float bt = off + cs[e]; const float kf = 1.0f - __expf(rlf[e]); \
            const float qv = __uint_as_float(((unsigned)rqs[e]) << 16) * __expf(bt); const float kt = kf * __expf(-bt); const float kk = kf * __expf(bend - bt); \
            ((LAS bf16_t*)(_B + SC_QT))[tau * 136 + kch] = (bf16_t)(pk2(qv, 0.f) & 0xffffu); ((LAS bf16_t*)(_B + SC_KT))[tau * 136 + kch] = (bf16_t)(pk2(kt, 0.f) & 0xffffu); kh[e] = pk2(kk, 0.f) & 0xffffu; } \
        u32x4 kw; kw.x = kh[0] | (kh[1] << 16); kw.y = kh[2] | (kh[3] << 16); kw.z = kh[4] | (kh[5] << 16); kw.w = kh[6] | (kh[7] << 16); \
        *(LAS u32x4*)(_B + SC_KH + kch * 80 + part * 16) = kw; \
        if (part == 0) ((LAS float*)(_B + SC_DEC))[kch] = __expf(bend); } while (0)

        SCAN_RAW(0);
        SCAN_PREP(lds);
        bf16x8 vf = vfn;
        SCAN_RAW(1);
        SCAN_BAR();
        for (int ci = 0; ci < 72; ++ci) {
            LAS unsigned char* B = lds + (ci & 1) * SC_BUF;
            bf16x8 vf_next = vfn;
            if (ci + 1 < 72) { SCAN_PREP(lds + ((ci + 1) & 1) * SC_BUF); }
            if (ci + 2 < 72) { SCAN_RAW(ci + 2); }
            int t0; scan_chunk_t0(ci, b, dir, t0);
            bf16x8 vcur = vf;
            if (dir) { bf16x8 t = vf; vcur[0] = t[7]; vcur[1] = t[6]; vcur[2] = t[5]; vcur[3] = t[4]; vcur[4] = t[3]; vcur[5] = t[2]; vcur[6] = t[1]; vcur[7] = t[0]; }
            bf16x8 qb[2][4];
#pragma unroll
            for (int tb = 0; tb < 2; ++tb)
#pragma unroll
                for (int c = 0; c < 4; ++c) qb[tb][c] = *(const LAS bf16x8*)(B + SC_QT + ((16 * tb + fr) * 136 + 32 * c + 8 * fq) * 2);
            f32x4 att[2][2];
#pragma unroll
            for (int sb = 0; sb < 2; ++sb) {
                att[sb][0] = (f32x4){0.f, 0.f, 0.f, 0.f}; att[sb][1] = (f32x4){0.f, 0.f, 0.f, 0.f};
                const int srow = 8 * (fr >> 2) + 4 * sb + (fr & 3);
#pragma unroll
                for (int c = 0; c < 4; ++c) {
                    const bf16x8 ka = *(const LAS bf16x8*)(B + SC_KT + (srow * 136 + 32 * c + 8 * fq) * 2);
                    att[sb][0] = __builtin_amdgcn_mfma_f32_16x16x32_bf16(ka, qb[0][c], att[sb][0], 0, 0, 0);
                    att[sb][1] = __builtin_amdgcn_mfma_f32_16x16x32_bf16(ka, qb[1][c], att[sb][1], 0, 0, 0);
                }
            }
            f32x4 OT[2];
#pragma unroll
            for (int tb = 0; tb < 2; ++tb) {
                const int t = 16 * tb + fr;
#pragma unroll
                for (int sb = 0; sb < 2; ++sb)
#pragma unroll
                    for (int i = 0; i < 4; ++i) { const int sa = 8 * fq + 4 * sb + i; att[sb][tb][i] = (sa <= t) ? att[sb][tb][i] : 0.f; }
                union { u32x4 u; bf16x8 v; } P; P.u.x = pk2(att[0][tb][0], att[0][tb][1]); P.u.y = pk2(att[0][tb][2], att[0][tb][3]); P.u.z = pk2(att[1][tb][0], att[1][tb][1]); P.u.w = pk2(att[1][tb][2], att[1][tb][3]);
                OT[tb] = __builtin_amdgcn_mfma_f32_16x16x32_bf16(vcur, P.v, (f32x4){0.f, 0.f, 0.f, 0.f}, 0, 0, 0);
            }
#pragma unroll
            for (int c = 0; c < 4; ++c) {
                union { u32x4 u; bf16x8 v; } SF; SF.u.x = pk2(S[2 * c][0], S[2 * c][1]); SF.u.y = pk2(S[2 * c][2], S[2 * c][3]); SF.u.z = pk2(S[2 * c + 1][0], S[2 * c + 1][1]); SF.u.w = pk2(S[2 * c + 1][2], S[2 * c + 1][3]);
                OT[0] = __builtin_amdgcn_mfma_f32_16x16x32_bf16(SF.v, qb[0][c], OT[0], 0, 0, 0);
                OT[1] = __builtin_amdgcn_mfma_f32_16x16x32_bf16(SF.v, qb[1][c], OT[1], 0, 0, 0);
            }
#pragma unroll
            for (int kb = 0; kb < 8; ++kb) {
                const int krow = 32 * (kb >> 1) + 8 * (fr >> 2) + 4 * (kb & 1) + (fr & 3);
                const bf16x8 ka = *(const LAS bf16x8*)(B + SC_KH + krow * 80 + fq * 16);
                const f32x4 dc = *(const LAS f32x4*)(B + SC_DEC + (32 * (kb >> 1) + 8 * fq + 4 * (kb & 1)) * 4);
                S[kb] = __builtin_amdgcn_mfma_f32_16x16x32_bf16(ka, vcur, S[kb] * dc, 0, 0, 0);
            }
#pragma unroll
            for (int tb = 0; tb < 2; ++tb) {
                const int tau = 16 * tb + fr; const int tok = dir ? t0 + 31 - tau : t0 + tau;
                u32x2 w; w.x = pk2(OT[tb][0], OT[tb][1]); w.y = pk2(OT[tb][2], OT[tb][3]);
                *(u32x2*)(O + (size_t)tok * DI + h * 128 + 16 * wave + 4 * fq) = w;
            }
            vf = vf_next;
            SCAN_BAR();
        }
#undef SCAN_RAW
#undef SCAN_PREP
    }
}

#define XB_TMO      128
#define XB_XCNT(j)  (256  + 64 * (j))
#define XB_XSUB(j)  (1280 + 64 * (j))
#define XB_XGEN(j)  (2304 + 64 * (j))
#define XB_TOP      3328
#define XB_TOPGEN   3392
#define XCD_BAR_WORDS 3456
#define XB_SPIN_CAP (1u << 18)

__device__ __forceinline__ unsigned xb_ld(unsigned* p)              { return __hip_atomic_load(p, __ATOMIC_RELAXED, __HIP_MEMORY_SCOPE_AGENT); }
__device__ __forceinline__ unsigned xb_add(unsigned* p, unsigned v) { return __hip_atomic_fetch_add(p, v, __ATOMIC_RELAXED, __HIP_MEMORY_SCOPE_AGENT); }
__device__ __forceinline__ unsigned xb_xcc_id() { return (unsigned)__builtin_amdgcn_s_getreg((3 << 11) | 20) & 0xFu; }
#define XB_SPIN(cond, bar) do { unsigned _sp = 0; while (cond) { __builtin_amdgcn_s_sleep(1); \
    if ((++_sp & 255u) == 0u) { if (xb_ld(&(bar)[XB_TMO])) break; if (_sp > XB_SPIN_CAP) { atomicAdd(&(bar)[XB_TMO], 1u); break; } } } } while (0)

struct XcdBarrier {
    unsigned* bar; unsigned x;
    volatile LAS unsigned* st;
};

__device__ __forceinline__ XcdBarrier xcd_barrier_post(unsigned* bar, volatile LAS unsigned* st) {
    XcdBarrier b; b.bar = bar; b.x = xb_xcc_id(); b.st = st;
    if (threadIdx.x == 0) (void)xb_add(&bar[XB_XCNT(b.x)], 1u);
    return b;
}
__device__ __forceinline__ void xcd_barrier_complete(unsigned* bar, unsigned x, unsigned& nloc, unsigned& nx) {
    const unsigned G = gridDim.x * gridDim.y * gridDim.z;
    unsigned sum, cnt, mine, sp = 0u;
    for (;;) {
        sum = 0u; cnt = 0u; mine = 0u;
#pragma unroll
        for (unsigned j = 0; j < 16; ++j) { const unsigned c = xb_ld(&bar[XB_XCNT(j)]); sum += c; cnt += (c > 0u) ? 1u : 0u; mine = (j == x) ? c : mine; }
        if (sum == G) break;
        __builtin_amdgcn_s_sleep(1);
        if ((++sp & 255u) == 0u) { if (xb_ld(&bar[XB_TMO])) break; if (sp > XB_SPIN_CAP) { atomicAdd(&bar[XB_TMO], 1u); break; } }
    }
    nloc = mine > 0u ? mine : 1u; nx = cnt > 0u ? cnt : 1u;
}

__device__ __forceinline__ void xcd_barrier(const XcdBarrier& b) {
    asm volatile("s_waitcnt vmcnt(0)" ::: "memory");
    __syncthreads();
    if (threadIdx.x == 0) {
        unsigned* bar = b.bar;
        __builtin_amdgcn_s_waitcnt(0);
        unsigned nloc = b.st[0], nx = b.st[1];
        if (nloc == 0u) { xcd_barrier_complete(bar, b.x, nloc, nx); b.st[0] = nloc; b.st[1] = nx; }
        const unsigned old = xb_add(&bar[XB_XSUB(b.x)], 1u);
        const unsigned gen = old / nloc;
        if (old + 1u == (gen + 1u) * nloc) {
            __builtin_amdgcn_fence(__ATOMIC_RELEASE, "agent");
            asm volatile("s_waitcnt vmcnt(0)" ::: "memory");
            const unsigned og = xb_add(&bar[XB_TOP], 1u);
            const unsigned tg = og / nx;
            if (og + 1u == (tg + 1u) * nx) xb_add(&bar[XB_TOPGEN], 1u);
            else XB_SPIN(xb_ld(&bar[XB_TOPGEN]) == tg, bar);
            __builtin_amdgcn_fence(__ATOMIC_ACQUIRE, "agent");
            xb_add(&bar[XB_XGEN(b.x)], 1u);
            asm volatile("s_waitcnt vmcnt(0)" ::: "memory");
        } else {
            XB_SPIN(xb_ld(&bar[XB_XGEN(b.x)]) == gen, bar);
            __builtin_amdgcn_fence(__ATOMIC_ACQUIRE, "agent");
            asm volatile("s_waitcnt vmcnt(0)" ::: "memory");
        }
    }
    __syncthreads();
}


enum { OP_INIT = 0, OP_ROW = 1, OP_G1 = 2, OP_ATT = 3, OP_POOL = 4, OP_GG = 5, OP_SCAN = 6, OP_GATE = 7, OP_G2 = 8, OP_FINAL = 9 };
constexpr int NPHASE = 20;
constexpr int JOB_OFF = LDS_BYTES - 4096;
constexpr int BAR_ST_OFF = LDS_BYTES - 16;

__global__ void __launch_bounds__(NTHR, 2) fwd_mega(Args a0) {
    extern __shared__ __attribute__((aligned(16))) unsigned char lds_raw[];
    LAS unsigned char* lds = (LAS unsigned char*)lds_raw;
    cg::grid_group grid = cg::this_grid();
    const int G = gridDim.x, bid = blockIdx.x;
    if (a0.ws == nullptr) grid.sync();
    if (threadIdx.x == 0) {
        unsigned char* ws = a0.ws;
        bf16_t* H = (bf16_t*)(ws + WS_H); bf16_t* WIN = (bf16_t*)(ws + WS_WIN); bf16_t* WOUT = (bf16_t*)(ws + WS_WOUT); bf16_t* WG = (bf16_t*)(ws + WS_WG);
        const float* LB = (const float*)(ws + WS_LB);
        const int BIG = 1 << 30;
#define SLW(i) (ws + WS_S0 + (size_t)(i) * SLOT)
#define JW(gi, J0, J1, K, n0, n1) do { LAS unsigned char* p_ = lds + JOB_OFF + (gi) * 256; pg8::job_write(p_, J0); pg8::job_write(p_ + 128, J1); *(LAS int*)(p_ + 96) = (K); *(LAS int*)(p_ + 100) = (n0); *(LAS int*)(p_ + 104) = (n1); } while (0)
        const pg8::Job na0{H, WIN, 36, 48, BIG, 0, 4096, 0x271, SLW(0), SLW(1), SLW(2), nullptr, DI, nullptr, nullptr};
        const pg8::Job na1{WIN + (size_t)12288 * DM, H, 16, 36, BIG, 0, BIG, 0x8, SLW(3), nullptr, nullptr, nullptr, MTOT, nullptr, nullptr};
        const pg8::Job g2a{(const bf16_t*)SLW(4), WOUT, 36, 8, BIG, 0, BIG, 0x0, SLW(5), nullptr, nullptr, nullptr, DM, nullptr, nullptr};
        const pg8::Job g2c{(const bf16_t*)SLW(0), WOUT, 36, 8, BIG, 0, BIG, 0x0, SLW(5), nullptr, nullptr, nullptr, DM, nullptr, nullptr};
        const pg8::Job g2l{(const bf16_t*)SLW(4), WOUT, 32, 8, BIG, 0, BIG, 0x0, SLW(5), nullptr, nullptr, nullptr, DM, nullptr, nullptr};
        const pg8::Job p0{H, WIN, 36, 32, BIG, 0, 4096, 0x20, SLW(0), SLW(2), nullptr, nullptr, DI, nullptr, nullptr};
        const pg8::Job pg{(const bf16_t*)SLW(1), WG, 36, 16, 4, (size_t)MTOT * 1024, BIG, 0x6, SLW(4), nullptr, nullptr, nullptr, DI, a0.in[13], (const bf16_t*)SLW(2)};
        const pg8::Job h0{H, WIN, 36, 64, BIG, 0, 4096, 0x2432, SLW(0), SLW(5), SLW(7), SLW(2), DI, LB, nullptr};
        const pg8::Job h1{WIN + (size_t)16384 * DM, H, 16, 36, BIG, 0, BIG, 0x0, SLW(3), nullptr, nullptr, nullptr, MTOT, nullptr, nullptr};
        JW(0, na0, na1, DM, 36 * 48, 16 * 36); JW(1, g2a, g2a, DI, 36 * 8, 0);
        JW(2, p0, p0, DM, 36 * 32, 0); JW(3, pg, pg, 1024, 36 * 16, 0); JW(4, g2a, g2a, DI, 36 * 8, 0);
        JW(5, h0, h1, DM, 36 * 64, 16 * 36); JW(6, g2c, g2c, DI, 36 * 8, 0);
        JW(7, na0, na1, DM, 36 * 48, 16 * 36); JW(8, g2l, g2l, DI, 32 * 8, 0);
#undef JW
#undef SLW
    }
    {
        volatile LAS unsigned* st0 = (volatile LAS unsigned*)(lds + BAR_ST_OFF);
        if (threadIdx.x < 2) st0[threadIdx.x] = 0u;
        __syncthreads();
    }
    const XcdBarrier xbar = xcd_barrier_post((unsigned*)a0.ws, (volatile LAS unsigned*)(lds + BAR_ST_OFF));
#define SL(i) (ws + WS_S0 + (size_t)(i) * SLOT)
    const int BIG = 1 << 30;

    for (int ph = 0; ph < NPHASE; ++ph) {
        int li, op;
        if (ph == 0) { li = 0; op = OP_INIT; }
        else if (ph < 5) { li = 0; const int k = ph - 1; op = k == 0 ? OP_ROW : (k == 1 ? OP_G1 : (k == 2 ? OP_ATT : OP_G2)); }
        else if (ph < 10) { li = 1; const int k = ph - 5; op = k == 0 ? OP_ROW : (k == 1 ? OP_G1 : (k == 2 ? OP_POOL : (k == 3 ? OP_GG : OP_G2))); }
        else if (ph < 15) { li = 2; const int k = ph - 10; op = k == 0 ? OP_ROW : (k == 1 ? OP_G1 : (k == 2 ? OP_SCAN : (k == 3 ? OP_GATE : OP_G2))); }
        else if (ph < 19) { li = 3; const int k = ph - 15; op = k == 0 ? OP_ROW : (k == 1 ? OP_G1 : (k == 2 ? OP_ATT : OP_G2)); }
        else { li = 4; op = OP_FINAL; }
        const int kind = li % 3; const bool need_ctx = li < 3;
#if DBG_NL < 4
        if (li > DBG_NL || (li == DBG_NL && op != OP_ROW)) continue;
#endif
        int zero_ = 0; LAUNDER_S(zero_);
        Args a = a0;
#pragma unroll
        for (int i = 0; i < 19; ++i) a.in[i] = a0.in[i] + zero_;
        a.out = a0.out + zero_; a.ws = a0.ws + zero_;
        unsigned char* ws = a.ws;
        int tid_ = threadIdx.x; asm volatile("" : "+v"(tid_));
        const int tid = tid_, wave = __builtin_amdgcn_readfirstlane(tid >> 6), lane = tid & 63;
        const int gw = bid * NWAVES + wave, NGW = G * NWAVES;
        int gK = 0, gn0 = 0, gn1 = 0; const LAS unsigned char* jt = lds + JOB_OFF;
        if (op == OP_INIT) {
#ifdef ZERO_WS
            {
                u32x4* p = (u32x4*)(ws + WS_MOD); const size_t n16 = (WS_END - WS_MOD) / 16;
                for (size_t i = (size_t)bid * NTHR + tid; i < n16; i += (size_t)G * NTHR) p[i] = (u32x4){0u, 0u, 0u, 0u};
            }
#endif
#ifndef NO_MISC
            init_phase(a, lds, G);
            __syncthreads();
            transpose_layer(a, 0, lds, gw, NGW, wave, lane);
#ifdef PROBE_TR
            transpose_layer(a, 0, lds, gw, NGW, wave, lane);
#endif
#endif
        } else if (op == OP_ROW || op == OP_FINAL) {
#ifndef NO_MISC
            row_phase(a, li, lds, G, tid, wave, lane);
            __syncthreads();
            if (li > 0 && li < 4) transpose_layer(a, li, lds, gw, NGW, wave, lane);
#ifdef PROBE_TR
            if (li > 0 && li < 4) transpose_layer(a, li, lds, gw, NGW, wave, lane);
#endif
#endif
        } else if (op == OP_ATT) {
#ifndef NO_ATTN
            attn_phase(a, li, lds, G, need_ctx ? 1 : 0);
#ifdef PROBE_ATT
            attn_phase(a, li, lds, G, need_ctx ? 1 : 0);
#endif
#endif
        } else if (op == OP_POOL) {
#ifndef NO_MISC
            pool_phase(a, G);
#endif
        } else if (op == OP_SCAN) {
#ifndef NO_SCAN
            scan_phase(a, lds, G);
#ifdef PROBE_SCAN
            scan_phase(a, lds, G);
#endif
#endif
        } else if (op == OP_GATE) {
#ifndef NO_MISC
            hgate_phase(a, G);
#endif
        } else {
            const int gi = li == 0 ? (op == OP_G1 ? 0 : 1) : (li == 1 ? (op == OP_G1 ? 2 : (op == OP_GG ? 3 : 4)) : (li == 2 ? (op == OP_G1 ? 5 : 6) : (op == OP_G1 ? 7 : 8)));
            jt = lds + JOB_OFF + gi * 256;
            gK = pg8::jl_i(jt + 96); gn0 = pg8::jl_i(jt + 100); gn1 = pg8::jl_i(jt + 104);
        }
#ifndef NO_GEMM
        if (gK) pg8::gemm_phase(lds, jt, gK, gn0, gn1, G, bid);
#ifdef PROBE_G2
        if (gK && op == OP_G2) { __syncthreads(); pg8::gemm_phase(lds, jt, gK, gn0, gn1, G, bid); }
#endif
#endif
        if (ph + 1 < NPHASE) xcd_barrier(xbar);
    }
#undef SL
}

extern "C" void kernel_launch(void* const* d_in, const int* in_sizes, int n_in, void* d_out, int out_size, void* d_ws, size_t ws_size, hipStream_t stream) {
    static int grid = 0;
    if (grid == 0) {
        if (n_in != 19 || out_size != MLAT * DM || ws_size < WS_END) { fprintf(stderr, "kernel_launch: unexpected shapes n_in %d out %d ws %zu (need %zu)\n", n_in, out_size, ws_size, (size_t)WS_END); grid = -1; return; }
        int dev = 0, cus = 0, per_cu = 0;
        (void)hipGetDevice(&dev);
        (void)hipDeviceGetAttribute(&cus, hipDeviceAttributeMultiprocessorCount, dev);
        (void)hipFuncSetAttribute((const void*)fwd_mega, hipFuncAttributeMaxDynamicSharedMemorySize, LDS_BYTES);
        (void)hipOccupancyMaxActiveBlocksPerMultiprocessor(&per_cu, (const void*)fwd_mega, NTHR, LDS_BYTES);
        fprintf(stderr, "cus %d per_cu %d ws %zu\n", cus, per_cu, ws_size);
        grid = cus > 0 ? cus : 256;
    }
    if (grid < 0) return;
    (void)hipMemsetAsync(d_ws, 0, 65536, stream);
    Args a{};
    for (int i = 0; i < 19; ++i) a.in[i] = (const float*)d_in[i];
    a.out = (float*)d_out; a.ws = (unsigned char*)d_ws;
    void* args[] = {&a};
    hipError_t e = hipLaunchCooperativeKernel((const void*)fwd_mega, dim3(grid), dim3(NTHR), args, LDS_BYTES, stream);
    if (e != hipSuccess) fprintf(stderr, "cooperative launch failed: %s (grid %d)\n", hipGetErrorString(e), grid);
}
```
